# Optimizing an MI355X kernel written in HIP

```python
import functools
import jax, jax.numpy as jnp
from jax import lax
import numpy as np

D_MODEL = 1024
BATCH = 1
SEQ = 16384
DEPTH = 1

NSA_HEADS = 8
NSA_KV_GROUPS = 2
NSA_HEAD_DIM = 64
NSA_WIDTH = NSA_HEADS * NSA_HEAD_DIM
NSA_KV_WIDTH = NSA_KV_GROUPS * NSA_HEAD_DIM
CMP_LEN = 32
CMP_STRIDE = 16
CMP_HIDDEN = 256
SEL_BLOCK = 64
SEL_TOPN = 16
WINDOW = 512
Q_BLOCK = 128
ROPE_THETA = 500000.0
ROPE_DIM = NSA_HEAD_DIM // 4

RET_HEADS = 4
RET_QK_DIM = 128
RET_V_DIM = 256
RET_QK_WIDTH = RET_HEADS * RET_QK_DIM
RET_V_WIDTH = RET_HEADS * RET_V_DIM
RET_CHUNK = 128
RET_ROPE_BASE = 10000.0

RMS_EPS = 1e-6
GN_EPS = 1e-6

PROJ_SIZES = (
    NSA_WIDTH,
    NSA_KV_WIDTH,
    NSA_KV_WIDTH,
    NSA_KV_WIDTH,
    NSA_KV_WIDTH,
    NSA_KV_WIDTH,
    NSA_KV_WIDTH,
    NSA_HEADS * 3,
    NSA_WIDTH,
    RET_QK_WIDTH,
    RET_QK_WIDTH,
    RET_V_WIDTH,
    RET_V_WIDTH,
    D_MODEL,
    D_MODEL,
)
PROJ_TOTAL = sum(PROJ_SIZES)

kernel_name = "hybrid_nsa_retention_gated_block"


def rms_norm(x, g):
    x32 = x.astype(jnp.float32)
    y = x32 * lax.rsqrt(jnp.mean(x32 * x32, axis=-1, keepdims=True) + RMS_EPS)
    return (y * g.astype(jnp.float32)).astype(x.dtype)


def split_points():
    pts, acc = [], 0
    for s in PROJ_SIZES[:-1]:
        acc += s
        pts.append(acc)
    return pts


def apply_rotary(x, ang):
    half = ang.shape[-1]
    r = 2 * half
    cos = jnp.cos(ang)[:, None, :].astype(x.dtype)
    sin = jnp.sin(ang)[:, None, :].astype(x.dtype)
    x1 = x[..., :half]
    x2 = x[..., half:r]
    return jnp.concatenate([x1 * cos - x2 * sin, x2 * cos + x1 * sin, x[..., r:]], axis=-1)


def masked_softmax(s, mask):
    s = jnp.where(mask, s.astype(jnp.float32), -jnp.inf)
    m = jnp.max(s, axis=-1, keepdims=True)
    m = jnp.where(jnp.isfinite(m), m, 0.0)
    p = jnp.where(mask, jnp.exp(s - m), 0.0)
    return p / jnp.maximum(jnp.sum(p, axis=-1, keepdims=True), jnp.finfo(jnp.float32).tiny)


def compress_blocks(kv, pe, w1, w2):
    S, G, dh = kv.shape
    n_cmp = (S - CMP_LEN) // CMP_STRIDE + 1
    tok_idx = jnp.arange(n_cmp)[:, None] * CMP_STRIDE + jnp.arange(CMP_LEN)[None, :]
    blocks = kv[tok_idx] + pe[None, :, None, :]
    flat = blocks.transpose(0, 2, 1, 3).reshape(n_cmp, G, CMP_LEN * dh)
    return jax.nn.gelu(flat @ w1) @ w2


def nsa_sequence(q, k_cmp_raw, v_cmp_raw, k_sel, v_sel, k_win, v_win, gate,
                 cmp_pe_k, cmp_w1_k, cmp_w2_k, cmp_pe_v, cmp_w1_v, cmp_w2_v):
    S = q.shape[0]
    G, H, dh = NSA_KV_GROUPS, NSA_HEADS, NSA_HEAD_DIM
    hpg = H // G
    scale = dh ** -0.5

    kc = compress_blocks(k_cmp_raw, cmp_pe_k, cmp_w1_k, cmp_w2_k)
    vc = compress_blocks(v_cmp_raw, cmp_pe_v, cmp_w1_v, cmp_w2_v)
    n_cmp = kc.shape[0]
    cmp_start = jnp.arange(n_cmp) * CMP_STRIDE
    cmp_end = cmp_start + CMP_LEN - 1

    n_sel = S // SEL_BLOCK
    n_top = min(SEL_TOPN, n_sel)
    sel_start = jnp.arange(n_sel) * SEL_BLOCK
    overlap = ((cmp_start[:, None] < sel_start[None, :] + SEL_BLOCK)
               & (cmp_start[:, None] + CMP_LEN > sel_start[None, :])).astype(jnp.float32)
    kb = k_sel.reshape(n_sel, SEL_BLOCK, G, dh).transpose(2, 0, 1, 3)
    vb = v_sel.reshape(n_sel, SEL_BLOCK, G, dh).transpose(2, 0, 1, 3)

    k_pad = jnp.pad(k_win, ((WINDOW, 0), (0, 0), (0, 0)))
    v_pad = jnp.pad(v_win, ((WINDOW, 0), (0, 0), (0, 0)))

    n_qb = S // Q_BLOCK
    qb = q.reshape(n_qb, Q_BLOCK, G, hpg, dh)
    gb = gate.reshape(n_qb, Q_BLOCK, G, hpg, 3)
    blk_ids = jnp.arange(n_sel)
    g_idx = jnp.arange(G)[None, :, None]

    def block(args):
        qi, gi, b = args
        t = b * Q_BLOCK + jnp.arange(Q_BLOCK)
        s = jnp.einsum('qghd,cgd->qghc', qi, kc) * scale
        mask_c = (cmp_end[None, :] <= t[:, None])[:, None, None, :]
        p_c = masked_softmax(s, mask_c)
        o_c = jnp.einsum('qghc,cgd->qghd', p_c.astype(vc.dtype), vc)
        imp = jnp.einsum('qgc,cn->qgn', jnp.sum(p_c, axis=2), overlap)
        cur = t // SEL_BLOCK
        valid = blk_ids[None, :] <= cur[:, None]
        forced = ((blk_ids[None, :] == 0) | (blk_ids[None, :] == cur[:, None])
                  | (blk_ids[None, :] == cur[:, None] - 1))
        score = jnp.where(forced[:, None, :], jnp.inf,
                          jnp.where(valid[:, None, :], imp, -jnp.inf))
        _, idx = lax.top_k(score, n_top)
        sel_valid = jnp.take_along_axis(
            jnp.broadcast_to(valid[:, None, :], score.shape), idx, axis=-1)
        ks = kb[g_idx, idx]
        vs = vb[g_idx, idx]
        s = jnp.einsum('qghd,qgnbd->qghnb', qi, ks) * scale
        kpos = idx[..., None] * SEL_BLOCK + jnp.arange(SEL_BLOCK)
        mask_s = sel_valid[..., None] & (kpos <= t[:, None, None, None])
        nk = n_top * SEL_BLOCK
        p_s = masked_softmax(s.reshape(Q_BLOCK, G, hpg, nk),
                             mask_s.reshape(Q_BLOCK, G, 1, nk))
        o_s = jnp.einsum('qghk,qgkd->qghd', p_s.astype(vs.dtype),
                         vs.reshape(Q_BLOCK, G, nk, dh))
        kw = lax.dynamic_slice_in_dim(k_pad, b * Q_BLOCK, Q_BLOCK + WINDOW, axis=0)
        vw = lax.dynamic_slice_in_dim(v_pad, b * Q_BLOCK, Q_BLOCK + WINDOW, axis=0)
        wpos = b * Q_BLOCK - WINDOW + jnp.arange(Q_BLOCK + WINDOW)
        diff = t[:, None] - wpos[None, :]
        mask_w = ((wpos[None, :] >= 0) & (diff >= 0) & (diff < WINDOW))[:, None, None, :]
        s = jnp.einsum('qghd,kgd->qghk', qi, kw) * scale
        p_w = masked_softmax(s, mask_w)
        o_w = jnp.einsum('qghk,kgd->qghd', p_w.astype(vw.dtype), vw)
        g = jax.nn.sigmoid(gi.astype(jnp.float32))
        o = g[..., 0:1] * o_c + g[..., 1:2] * o_s + g[..., 2:3] * o_w
        return o.reshape(Q_BLOCK, H * dh).astype(q.dtype)

    out = lax.map(block, (qb, gb, jnp.arange(n_qb)))
    return out.reshape(S, H * dh)


def retention_sequence(q, k, v):
    S = q.shape[0]
    H, dk, dv, C = RET_HEADS, RET_QK_DIM, RET_V_DIM, RET_CHUNK
    nc = S // C
    log_g = jnp.log(1.0 - 2.0 ** (-5.0 - jnp.arange(H, dtype=jnp.float32)))
    n = jnp.arange(C, dtype=jnp.float32)
    diff = n[:, None] - n[None, :]
    decay_mask = jnp.where(diff >= 0, jnp.exp(jnp.maximum(diff, 0.0)[None] * log_g[:, None, None]), 0.0)
    q_dec = jnp.exp((n[None, :] + 1.0) * log_g[:, None])
    k_dec = jnp.exp((C - 1.0 - n[None, :]) * log_g[:, None])
    chunk_dec = jnp.exp(C * log_g)

    qc = q.reshape(nc, C, H, dk)
    kc = k.reshape(nc, C, H, dk)
    vc = v.reshape(nc, C, H, dv)
    att = jnp.einsum('nihd,njhd->nhij', qc, kc) * decay_mask[None]
    o_inner = jnp.einsum('nhij,njhe->nihe', att, vc)
    kv = jnp.einsum('njhd,hj,njhe->nhde', kc, k_dec, vc).astype(jnp.float32)

    def step(R, kv_i):
        return chunk_dec[:, None, None] * R + kv_i, R

    _, R_prev = lax.scan(step, jnp.zeros((H, dk, dv), jnp.float32), kv)
    o_cross = jnp.einsum('nihd,hi,nhde->nihe', qc, q_dec, R_prev)
    o = (o_inner + o_cross).reshape(S, H, dv).astype(jnp.float32)
    mu = jnp.mean(o, axis=-1, keepdims=True)
    var = jnp.mean(jnp.square(o - mu), axis=-1, keepdims=True)
    o = (o - mu) * lax.rsqrt(var + GN_EPS)
    return o.reshape(S, H * dv).astype(q.dtype)


def setup_inputs(seed: int = 0) -> dict:
    key = jax.random.key(seed)
    ks = jax.random.split(key, 16)
    f32 = jnp.float32
    nrm = lambda k, shape, fan_in: jax.random.normal(k, shape, f32) * (fan_in ** -0.5)
    cmp_in = CMP_LEN * NSA_HEAD_DIM
    return {
        "x": jax.random.normal(ks[0], (BATCH, SEQ, D_MODEL), f32),
        "norm_pre": 1.0 + 0.05 * jax.random.normal(ks[1], (D_MODEL,), f32),
        "w_in": nrm(ks[2], (D_MODEL, PROJ_TOTAL), D_MODEL),
        "b_nsa_gate": 0.1 * jax.random.normal(ks[3], (NSA_HEADS * 3,), f32),
        "cmp_pe_k": 0.02 * jax.random.normal(ks[4], (CMP_LEN, NSA_HEAD_DIM), f32),
        "cmp_w1_k": nrm(ks[5], (cmp_in, CMP_HIDDEN), cmp_in),
        "cmp_w2_k": nrm(ks[6], (CMP_HIDDEN, NSA_HEAD_DIM), CMP_HIDDEN),
        "cmp_pe_v": 0.02 * jax.random.normal(ks[7], (CMP_LEN, NSA_HEAD_DIM), f32),
        "cmp_w1_v": nrm(ks[8], (cmp_in, CMP_HIDDEN), cmp_in),
        "cmp_w2_v": nrm(ks[9], (CMP_HIDDEN, NSA_HEAD_DIM), CMP_HIDDEN),
        "w_nsa_o": nrm(ks[10], (NSA_WIDTH, D_MODEL), NSA_WIDTH),
        "w_ret_o": nrm(ks[11], (RET_V_WIDTH, D_MODEL), RET_V_WIDTH),
        "w_out": nrm(ks[12], (D_MODEL, D_MODEL), D_MODEL),
        "norm_post": 1.0 + 0.05 * jax.random.normal(ks[13], (D_MODEL,), f32),
    }


def reference(x, norm_pre, w_in, b_nsa_gate, cmp_pe_k, cmp_w1_k, cmp_w2_k,
              cmp_pe_v, cmp_w1_v, cmp_w2_v, w_nsa_o, w_ret_o, w_out, norm_post):
    B, S, _ = x.shape
    pos = jnp.arange(S, dtype=jnp.float32)
    nsa_inv = 1.0 / (ROPE_THETA ** (jnp.arange(0, ROPE_DIM, 2, dtype=jnp.float32) / ROPE_DIM))
    nsa_ang = pos[:, None] * nsa_inv[None, :]
    ret_inv = 1.0 / (RET_ROPE_BASE ** jnp.linspace(0.0, 1.0, RET_QK_DIM // 2, dtype=jnp.float32))
    ret_ang = pos[:, None] * ret_inv[None, :]

    for _ in range(DEPTH):
        h = rms_norm(x, norm_pre)
        proj = h @ w_in
        (q_n, k_c, v_c, k_s, v_s, k_w, v_w, g_n, z_n,
         q_r, k_r, v_r, z_r, m_a, m_b) = jnp.split(proj, split_points(), axis=-1)

        kvshape = (B, S, NSA_KV_GROUPS, NSA_HEAD_DIM)
        q_n = apply_rotary(q_n.reshape(B, S, NSA_HEADS, NSA_HEAD_DIM), nsa_ang)
        k_c = apply_rotary(k_c.reshape(kvshape), nsa_ang)
        k_s = apply_rotary(k_s.reshape(kvshape), nsa_ang)
        k_w = apply_rotary(k_w.reshape(kvshape), nsa_ang)
        gate_n = (g_n + b_nsa_gate).reshape(B, S, NSA_HEADS, 3)
        nsa_fn = lambda a, b_, c, d, e, f, g, gt: nsa_sequence(
            a, b_, c, d, e, f, g, gt,
            cmp_pe_k, cmp_w1_k, cmp_w2_k, cmp_pe_v, cmp_w1_v, cmp_w2_v)
        o_a = jax.vmap(nsa_fn)(q_n, k_c, v_c.reshape(kvshape), k_s, v_s.reshape(kvshape),
                               k_w, v_w.reshape(kvshape), gate_n)
        y_a = (o_a * jax.nn.silu(z_n)) @ w_nsa_o

        q_r = apply_rotary(q_r.reshape(B, S, RET_HEADS, RET_QK_DIM), ret_ang)
        k_r = apply_rotary(k_r.reshape(B, S, RET_HEADS, RET_QK_DIM), ret_ang) * (RET_QK_DIM ** -0.5)
        o_b = jax.vmap(retention_sequence)(q_r, k_r, v_r.reshape(B, S, RET_HEADS, RET_V_DIM))
        y_b = (o_b * jax.nn.silu(z_r)) @ w_ret_o

        merged = jax.nn.sigmoid(m_a) * y_a + jax.nn.sigmoid(m_b) * y_b
        x = x + rms_norm(merged @ w_out, norm_post)
    return x
```

```cpp
#include <hip/hip_runtime.h>
#include <hip/hip_cooperative_groups.h>
#include <cstdio>
namespace cg = cooperative_groups;

#define DI __device__ __forceinline__
#define LAS __attribute__((address_space(3)))

#define XB_TMO      128
#define XB_XCNT(j)  (256  + 64 * (j))
#define XB_XSUB(j)  (1280 + 64 * (j))
#define XB_XGEN(j)  (2304 + 64 * (j))
#define XB_TOP      3328
#define XB_TOPGEN   3392
#define XCD_BAR_WORDS 3456
#define XB_SPIN_CAP (1u << 22)

DI unsigned xb_ld(unsigned* p)              { return __hip_atomic_load(p, __ATOMIC_RELAXED, __HIP_MEMORY_SCOPE_AGENT); }
DI unsigned xb_add(unsigned* p, unsigned v) { return __hip_atomic_fetch_add(p, v, __ATOMIC_RELAXED, __HIP_MEMORY_SCOPE_AGENT); }
DI unsigned xb_xcc_id() { return (unsigned)__builtin_amdgcn_s_getreg((3 << 11) | 20) & 0xFu; }
#define XB_SPIN(cond, bar) do { unsigned _sp = 0; while (cond) { __builtin_amdgcn_s_sleep(1); \
    if ((++_sp & 255u) == 0u) { if (xb_ld(&(bar)[XB_TMO])) break; if (_sp > XB_SPIN_CAP) { atomicAdd(&(bar)[XB_TMO], 1u); break; } } } } while (0)

struct XcdBarrier { unsigned* bar; unsigned x; volatile LAS unsigned* st; };

DI XcdBarrier xcd_barrier_post(unsigned* bar, volatile LAS unsigned* st) {
    XcdBarrier b; b.bar = bar; b.x = xb_xcc_id(); b.st = st;
    if (threadIdx.x == 0) (void)xb_add(&bar[XB_XCNT(b.x)], 1u);
    return b;
}
DI void xcd_barrier_complete(unsigned* bar, unsigned x, unsigned& nloc, unsigned& nx) {
    const unsigned G = gridDim.x * gridDim.y * gridDim.z;
    unsigned sum, cnt, mine, sp = 0u;
    for (;;) {
        sum = 0u; cnt = 0u; mine = 0u;
#pragma unroll
        for (unsigned j = 0; j < 16; ++j) { const unsigned c = xb_ld(&bar[XB_XCNT(j)]); sum += c; cnt += (c > 0u) ? 1u : 0u; mine = (j == x) ? c : mine; }
        if (sum == G) break;
        __builtin_amdgcn_s_sleep(1);
        if ((++sp & 255u) == 0u) { if (xb_ld(&bar[XB_TMO])) break; if (sp > XB_SPIN_CAP) { atomicAdd(&bar[XB_TMO], 1u); break; } }
    }
    nloc = mine > 0u ? mine : 1u; nx = cnt > 0u ? cnt : 1u;
}
DI void xcd_barrier(const XcdBarrier& b) {
    asm volatile("s_waitcnt vmcnt(0)" ::: "memory");
    __syncthreads();
    if (threadIdx.x == 0) {
        unsigned* bar = b.bar;
        __builtin_amdgcn_s_waitcnt(0);
        unsigned nloc = b.st[0], nx = b.st[1];
        if (nloc == 0u) { xcd_barrier_complete(bar, b.x, nloc, nx); b.st[0] = nloc; b.st[1] = nx; }
        const unsigned old = xb_add(&bar[XB_XSUB(b.x)], 1u);
        const unsigned gen = old / nloc;
        if (old + 1u == (gen + 1u) * nloc) {
            __builtin_amdgcn_fence(__ATOMIC_RELEASE, "agent");
            asm volatile("s_waitcnt vmcnt(0)" ::: "memory");
            const unsigned og = xb_add(&bar[XB_TOP], 1u);
            const unsigned tg = og / nx;
            if (og + 1u == (tg + 1u) * nx) xb_add(&bar[XB_TOPGEN], 1u);
            else XB_SPIN(xb_ld(&bar[XB_TOPGEN]) == tg, bar);
            __builtin_amdgcn_fence(__ATOMIC_ACQUIRE, "agent");
            xb_add(&bar[XB_XGEN(b.x)], 1u);
            asm volatile("s_waitcnt vmcnt(0)" ::: "memory");
        } else {
            XB_SPIN(xb_ld(&bar[XB_XGEN(b.x)]) == gen, bar);
            __builtin_amdgcn_fence(__ATOMIC_ACQUIRE, "agent");
            asm volatile("s_waitcnt vmcnt(0)" ::: "memory");
        }
    }
    __syncthreads();
}


typedef unsigned short u16;
using bf16x8 = __attribute__((ext_vector_type(8))) short;
using f32x4  = __attribute__((ext_vector_type(4))) float;
using u32x4  = __attribute__((ext_vector_type(4))) unsigned;
using u32x2  = __attribute__((ext_vector_type(2))) unsigned;
typedef __attribute__((ext_vector_type(2))) __bf16 bf2_t;
#define MFMA16(a, b, c) __builtin_amdgcn_mfma_f32_16x16x32_bf16((a), (b), (c), 0, 0, 0)

constexpr int S_ = 16384, DM_ = 1024, NPAD_ = 7040;
constexpr int LDT = 72;
constexpr int TILE_ELEMS = 128 * LDT;
constexpr int CST = 132;
constexpr float LOG2E = 1.4426950408889634f;

DI unsigned pack2(float a, float b) { bf2_t v = {(__bf16)a, (__bf16)b}; return __builtin_bit_cast(unsigned, v); }
DI float bflo(unsigned u) { return __uint_as_float(u << 16); }
DI float bfhi(unsigned u) { return __uint_as_float(u & 0xffff0000u); }
DI u32x4 ld16(const u16* p) { return *(const u32x4*)p; }
DI bf16x8 ldf(const u16* p) { return *(const bf16x8*)p; }
DI u32x4 pack8(const float* v) { u32x4 r; r[0] = pack2(v[0], v[1]); r[1] = pack2(v[2], v[3]); r[2] = pack2(v[4], v[5]); r[3] = pack2(v[6], v[7]); return r; }
DI bf16x8 packf(f32x4 a, f32x4 b) { u32x4 r; r[0] = pack2(a[0], a[1]); r[1] = pack2(a[2], a[3]); r[2] = pack2(b[0], b[1]); r[3] = pack2(b[2], b[3]); return __builtin_bit_cast(bf16x8, r); }
DI float sigmoidf_(float x) { return 1.f / (1.f + __expf(-x)); }
DI float wave_max(float v) {
#pragma unroll
    for (int o = 32; o >= 1; o >>= 1) v = fmaxf(v, __shfl_xor(v, o));
    return v;
}
DI float wave_sum(float v) {
#pragma unroll
    for (int o = 32; o >= 1; o >>= 1) v += __shfl_xor(v, o);
    return v;
}

struct Params {
    const float *x, *norm_pre, *w_in, *b_gate, *pe_k, *w1_k, *w2_k, *pe_v, *w1_v, *w2_v, *w_nsa_o, *w_ret_o, *w_out, *norm_post;
    float* out;
    unsigned* bar;
    u16 *WinT, *WnoT, *WroT, *WoutT, *W1T[2], *W2T[2];
    float* bpart;
    float2 *ropeN, *ropeR;
    u16 *H;
    u16 *Qn;
    u16 *Raw[2];
    u16 *Ks, *VsT, *Kw, *VwT;
    u16 *SZn;
    u16 *Qr, *Kr;
    u16 *KrT;
    u16 *VrT;
    u16 *SZr;
    u16 *Ma, *Mb;
    float* Gn;
    float* slab;
    u16 *Kc, *VcT;
    float* rowss;
    int use_cg; int pad0;
};

DI void gemm128_main(const u16* a0, size_t a_r32, int astep, const u16* b0, size_t b_r32, int bstep, int nk,
                     u16* lds, f32x4 (&acc)[4][4]) {
    const int tid = threadIdx.x, lane = tid & 63, w = tid >> 6;
    const int wr = w >> 1, wc = w & 1, lr = lane & 15, q = lane >> 4;
    u32x4 ra[4], rb[4];
#pragma unroll
    for (int i = 0; i < 4; ++i) { ra[i] = ld16(a0 + i * a_r32); rb[i] = ld16(b0 + i * b_r32); }
    const int wofs = (tid >> 3) * LDT + (tid & 7) * 8;
#pragma unroll
    for (int i = 0; i < 4; ++i) {
        *(u32x4*)(lds + wofs + i * 32 * LDT) = ra[i];
        *(u32x4*)(lds + TILE_ELEMS + wofs + i * 32 * LDT) = rb[i];
    }
    __syncthreads();
    for (int kt = 0; kt < nk; ++kt) {
        const u16* As = lds + (kt & 1) * 2 * TILE_ELEMS;
        const u16* Bs = As + TILE_ELEMS;
        const bool more = (kt + 1 < nk);
        if (more) {
            a0 += astep; b0 += bstep;
#pragma unroll
            for (int i = 0; i < 4; ++i) { ra[i] = ld16(a0 + i * a_r32); rb[i] = ld16(b0 + i * b_r32); }
        }
#pragma unroll
        for (int ks = 0; ks < 2; ++ks) {
            bf16x8 af[4], bfr[4];
#pragma unroll
            for (int t = 0; t < 4; ++t) {
                af[t]  = ldf(As + (64 * wr + 16 * t + lr) * LDT + ks * 32 + q * 8);
                bfr[t] = ldf(Bs + (64 * wc + 16 * t + lr) * LDT + ks * 32 + q * 8);
            }
#pragma unroll
            for (int ti = 0; ti < 4; ++ti)
#pragma unroll
                for (int tj = 0; tj < 4; ++tj) acc[ti][tj] = MFMA16(af[ti], bfr[tj], acc[ti][tj]);
        }
        if (more) {
            u16* Aw = lds + ((kt + 1) & 1) * 2 * TILE_ELEMS;
#pragma unroll
            for (int i = 0; i < 4; ++i) {
                *(u32x4*)(Aw + wofs + i * 32 * LDT) = ra[i];
                *(u32x4*)(Aw + TILE_ELEMS + wofs + i * 32 * LDT) = rb[i];
            }
        }
        __syncthreads();
    }
}
DI void zero_acc(f32x4 (&acc)[4][4]) {
#pragma unroll
    for (int i = 0; i < 4; ++i)
#pragma unroll
        for (int j = 0; j < 4; ++j) acc[i][j] = f32x4{0.f, 0.f, 0.f, 0.f};
}
DI void stage_acc(float* cst, const f32x4 (&acc)[4][4]) {
    const int lane = threadIdx.x & 63, w = threadIdx.x >> 6;
    const int wr = w >> 1, wc = w & 1, lr = lane & 15, q = lane >> 4;
#pragma unroll
    for (int ti = 0; ti < 4; ++ti)
#pragma unroll
        for (int tj = 0; tj < 4; ++tj)
#pragma unroll
            for (int r = 0; r < 4; ++r)
                cst[(64 * wr + 16 * ti + 4 * q + r) * CST + 64 * wc + 16 * tj + lr] = acc[ti][tj][r];
}
template <typename F> DI void emit_rows(const float* cst, F f) {
#pragma unroll 2
    for (int i = 0; i < 8; ++i) {
        const int item = threadIdx.x + 256 * i, row = item >> 4, c8 = item & 15;
        const float4 a = *(const float4*)(cst + row * CST + c8 * 8);
        const float4 b = *(const float4*)(cst + row * CST + c8 * 8 + 4);
        float v[8] = {a.x, a.y, a.z, a.w, b.x, b.y, b.z, b.w};
        f(row, c8, v);
    }
}
template <typename F> DI void emit_cols(const float* cst, F f) {
#pragma unroll 2
    for (int i = 0; i < 8; ++i) {
        const int item = threadIdx.x + 256 * i, rest = item >> 6;
        const int col = (item & 15) + 16 * (rest & 7), r8 = ((item >> 4) & 3) + 4 * (rest >> 3);
        float v[8];
#pragma unroll
        for (int k = 0; k < 8; ++k) v[k] = cst[(r8 * 8 + k) * CST + col];
        f(col, r8, v);
    }
}

DI void transpose_tile(const float* src, int ldsrc, int k0, int n0, u16* dst, int lddst, int map_in, float* tl) {
    const int tid = threadIdx.x;
    const int c = tid & 63;
    int oc = n0 + c;
    if (map_in) oc = (oc < 1280) ? oc : (oc < 6912 ? oc + 24 : (oc < 6936 ? oc - 6912 + 1280 : -1));
#pragma unroll
    for (int i = 0; i < 16; ++i) {
        const int r = (tid >> 6) + 4 * i;
        tl[r * 65 + c] = (oc >= 0) ? src[(size_t)(k0 + r) * ldsrc + oc] : 0.f;
    }
    __syncthreads();
    const int nl = tid >> 2, kc = (tid & 3) * 16;
    float v[16];
#pragma unroll
    for (int i = 0; i < 16; ++i) v[i] = tl[(kc + i) * 65 + nl];
    u16* d = dst + (size_t)(n0 + nl) * lddst + k0 + kc;
    *(u32x4*)d = pack8(v);
    *(u32x4*)(d + 8) = pack8(v + 8);
    __syncthreads();
}

DI void p0_unit(const Params& p, int u, unsigned char* smem) {
    const int tid = threadIdx.x, lane = tid & 63, w = tid >> 6;
    float* tl = (float*)smem;
    if (u < 2664) {
        int t = u;
        if (t < 1760) { transpose_tile(p.w_in, 6936, (t & 15) * 64, (t >> 4) * 64, p.WinT, 1024, 1, tl); return; }
        t -= 1760;
        if (t < 128) { transpose_tile(p.w_nsa_o, 1024, (t & 7) * 64, (t >> 3) * 64, p.WnoT, 512, 0, tl); return; }
        t -= 128;
        if (t < 256) { transpose_tile(p.w_ret_o, 1024, (t & 15) * 64, (t >> 4) * 64, p.WroT, 1024, 0, tl); return; }
        t -= 256;
        if (t < 256) { transpose_tile(p.w_out, 1024, (t & 15) * 64, (t >> 4) * 64, p.WoutT, 1024, 0, tl); return; }
        t -= 256;
        if (t < 128) { transpose_tile(p.w1_k, 256, (t & 31) * 64, (t >> 5) * 64, p.W1T[0], 2048, 0, tl); return; }
        t -= 128;
        if (t < 128) { transpose_tile(p.w1_v, 256, (t & 31) * 64, (t >> 5) * 64, p.W1T[1], 2048, 0, tl); return; }
        t -= 128;
        if (t < 4) { transpose_tile(p.w2_k, 64, t * 64, 0, p.W2T[0], 256, 0, tl); return; }
        t -= 4;
        transpose_tile(p.w2_v, 64, t * 64, 0, p.W2T[1], 256, 0, tl);
        return;
    }
    u -= 2664;
    if (u < 4096) {
        const int row = u * 4 + w;
        const float* xr = p.x + (size_t)row * 1024;
        float4 v[4]; float ss = 0.f;
#pragma unroll
        for (int i = 0; i < 4; ++i) { v[i] = *(const float4*)(xr + lane * 4 + 256 * i); ss += v[i].x * v[i].x + v[i].y * v[i].y + v[i].z * v[i].z + v[i].w * v[i].w; }
        ss = wave_sum(ss);
        const float rs = rsqrtf(ss * (1.f / 1024.f) + 1e-6f);
#pragma unroll
        for (int i = 0; i < 4; ++i) {
            const float4 g = *(const float4*)(p.norm_pre + lane * 4 + 256 * i);
            u32x2 o; o[0] = pack2(v[i].x * rs * g.x, v[i].y * rs * g.y); o[1] = pack2(v[i].z * rs * g.z, v[i].w * rs * g.w);
            *(u32x2*)(p.H + (size_t)row * 1024 + lane * 4 + 256 * i) = o;
        }
        return;
    }
    u -= 4096;
    if (u < 4096) {
        const int e = u * 256 + tid, pos = e >> 6, i = e & 63;
        const float inv = 1.0f / powf(10000.0f, (float)i / 63.0f);
        const float ang = (float)pos * inv;
        float sn, cs; sincosf(ang, &sn, &cs);
        p.ropeR[e] = make_float2(cs, sn);
        return;
    }
    u -= 4096;
    if (u < 512) {
        const int e = u * 256 + tid, pos = e >> 3, i = e & 7;
        const float inv = 1.0f / powf(500000.0f, (float)(2 * i) / 16.0f);
        const float ang = (float)pos * inv;
        float sn, cs; sincosf(ang, &sn, &cs);
        p.ropeN[e] = make_float2(cs, sn);
        return;
    }
    u -= 512;
    {
        const int kv = u >> 4, ch = u & 15;
        const float* pe = kv ? p.pe_v : p.pe_k;
        const float* w1 = kv ? p.w1_v : p.w1_k;
        float s = 0.f;
        for (int k = ch * 128; k < ch * 128 + 128; ++k) s += pe[k] * w1[(size_t)k * 256 + tid];
        p.bpart[(kv * 16 + ch) * 256 + tid] = s;
    }
}
constexpr int P0_UNITS = 2664 + 4096 + 4096 + 512 + 32;

DI void p1_tile(const Params& p, int t, unsigned char* smem) {
    const int tid = threadIdx.x;
    const int nt = t >> 7, mt = t & 127, tok0 = mt * 128;
    u16* lds = (u16*)smem; float* cst = (float*)smem;
    f32x4 acc[4][4]; zero_acc(acc);
    gemm128_main(p.H + (size_t)(tok0 + (tid >> 3)) * 1024 + (tid & 7) * 8, (size_t)32 * 1024, 64,
                 p.WinT + (size_t)(nt * 128 + (tid >> 3)) * 1024 + (tid & 7) * 8, (size_t)32 * 1024, 64, 16, lds, acc);
    stage_acc(cst, acc);
    __syncthreads();
    if (nt <= 4 || nt == 6 || nt == 8) {
#pragma unroll 2
        for (int i = 0; i < 8; ++i) {
            const int item = tid + 256 * i, row = item >> 4, hh = (item >> 3) & 1, ii = item & 7;
            float* px = cst + row * CST + hh * 64 + ii;
            const float x1 = px[0], x2 = px[8];
            const float2 cs = p.ropeN[(size_t)(tok0 + row) * 8 + ii];
            px[0] = x1 * cs.x - x2 * cs.y; px[8] = x2 * cs.x + x1 * cs.y;
        }
        __syncthreads();
    } else if (nt >= 14 && nt <= 21) {
        const float sc = (nt >= 18) ? 0.08838834764831845f : 1.0f;
#pragma unroll 2
        for (int i = 0; i < 32; ++i) {
            const int item = tid + 256 * i, row = item >> 6, ii = item & 63;
            float* px = cst + row * CST + ii;
            const float x1 = px[0], x2 = px[64];
            const float2 cs = p.ropeR[(size_t)(tok0 + row) * 64 + ii];
            px[0] = (x1 * cs.x - x2 * cs.y) * sc; px[64] = (x2 * cs.x + x1 * cs.y) * sc;
        }
        __syncthreads();
    }
    if (nt <= 3) {
        emit_rows(cst, [&](int row, int c8, const float* v) { *(u32x4*)(p.Qn + (size_t)(tok0 + row) * 512 + nt * 128 + c8 * 8) = pack8(v); });
    } else if (nt == 4 || nt == 5) {
        u16* dst = (nt == 4) ? p.Raw[0] : p.Raw[1];
        emit_rows(cst, [&](int row, int c8, const float* v) { *(u32x4*)(dst + (size_t)(tok0 + row) * 128 + c8 * 8) = pack8(v); });
    } else if (nt == 6 || nt == 8) {
        u16* dst = (nt == 6) ? p.Ks : p.Kw;
        emit_rows(cst, [&](int row, int c8, const float* v) { *(u32x4*)(dst + ((size_t)(c8 >> 3) * S_ + tok0 + row) * 64 + (c8 & 7) * 8) = pack8(v); });
    } else if (nt == 7 || nt == 9) {
        u16* dst = (nt == 7) ? p.VsT : p.VwT;
        emit_cols(cst, [&](int col, int r8, const float* v) {
            const int g = col >> 6, d = col & 63, tk = tok0 + r8 * 8;
            *(u32x4*)(dst + (((size_t)g * 256 + (tk >> 6)) * 64 + d) * 64 + (tk & 63)) = pack8(v); });
    } else if (nt <= 13) {
        emit_rows(cst, [&](int row, int c8, const float* v) {
            float o[8];
#pragma unroll
            for (int k = 0; k < 8; ++k) o[k] = v[k] * sigmoidf_(v[k]);
            *(u32x4*)(p.SZn + (size_t)(tok0 + row) * 512 + (nt - 10) * 128 + c8 * 8) = pack8(o); });
    } else if (nt <= 17) {
        const int h = nt - 14;
        emit_rows(cst, [&](int row, int c8, const float* v) { *(u32x4*)(p.Qr + ((size_t)h * S_ + tok0 + row) * 128 + c8 * 8) = pack8(v); });
    } else if (nt <= 21) {
        const int h = nt - 18;
        emit_rows(cst, [&](int row, int c8, const float* v) { *(u32x4*)(p.Kr + ((size_t)h * S_ + tok0 + row) * 128 + c8 * 8) = pack8(v); });
        const float lg = logf(1.0f - exp2f(-5.0f - (float)h));
        emit_cols(cst, [&](int col, int r8, const float* v) {
            float o[8];
#pragma unroll
            for (int k = 0; k < 8; ++k) o[k] = v[k] * __expf((float)(127 - (r8 * 8 + k)) * lg);
            *(u32x4*)(p.KrT + (((size_t)h * 128 + mt) * 128 + col) * 128 + r8 * 8) = pack8(o); });
    } else if (nt <= 29) {
        const int h = (nt - 22) >> 1, e0 = ((nt - 22) & 1) * 128;
        emit_cols(cst, [&](int col, int r8, const float* v) {
            *(u32x4*)(p.VrT + (((size_t)h * 128 + mt) * 256 + e0 + col) * 128 + r8 * 8) = pack8(v); });
    } else if (nt <= 37) {
        emit_rows(cst, [&](int row, int c8, const float* v) {
            float o[8];
#pragma unroll
            for (int k = 0; k < 8; ++k) o[k] = v[k] * sigmoidf_(v[k]);
            *(u32x4*)(p.SZr + (size_t)(tok0 + row) * 1024 + (nt - 30) * 128 + c8 * 8) = pack8(o); });
    } else if (nt <= 53) {
        u16* dst = (nt <= 45) ? p.Ma : p.Mb;
        const int c0 = ((nt <= 45) ? (nt - 38) : (nt - 46)) * 128;
        emit_rows(cst, [&](int row, int c8, const float* v) {
            float o[8];
#pragma unroll
            for (int k = 0; k < 8; ++k) o[k] = sigmoidf_(v[k]);
            *(u32x4*)(dst + (size_t)(tok0 + row) * 1024 + c0 + c8 * 8) = pack8(o); });
    } else {
#pragma unroll 2
        for (int i = 0; i < 12; ++i) {
            const int item = tid + 256 * i, row = item / 24, c = item - row * 24;
            p.Gn[(size_t)(tok0 + row) * 24 + c] = sigmoidf_(cst[row * CST + c] + p.b_gate[c]);
        }
    }
    __syncthreads();
}

DI void p2_unit(const Params& p, int u, unsigned char* smem) {
    const int tid = threadIdx.x, lane = tid & 63, w = tid >> 6;
    u16* lds = (u16*)smem; float* cst = (float*)smem;
    f32x4 acc[4][4]; zero_acc(acc);
    if (u < 256) {
        const int nt = u & 1, mt = (u >> 1) & 15, ks = (u >> 5) & 3, kv = u >> 7;
        const int R = mt * 128 + (tid >> 3), c = R >> 1, g = R & 1;
        const u16* a0 = (kv ? p.Raw[1] : p.Raw[0]) + (size_t)(16 * c + ks * 8) * 128 + g * 64 + (tid & 7) * 8;
        const u16* b0 = (kv ? p.W1T[1] : p.W1T[0]) + (size_t)(nt * 128 + (tid >> 3)) * 2048 + ks * 512 + (tid & 7) * 8;
        gemm128_main(a0, (size_t)16 * 16 * 128, 128, b0, (size_t)32 * 2048, 64, 8, lds, acc);
        const int wr = w >> 1, wc = w & 1, lr = lane & 15, q = lane >> 4;
        float* dst = p.slab + ((size_t)(ks * 2 + kv) * 2048 + mt * 128) * 256 + nt * 128;
#pragma unroll
        for (int ti = 0; ti < 4; ++ti)
#pragma unroll
            for (int tj = 0; tj < 4; ++tj)
#pragma unroll
                for (int r = 0; r < 4; ++r)
                    dst[(size_t)(64 * wr + 16 * ti + 4 * q + r) * 256 + 64 * wc + 16 * tj + lr] = acc[ti][tj][r];
        return;
    }
    const int v = u - 256, half = v & 1, ch = v >> 1, n = ch >> 2, h = ch & 3;
    const u16* a0 = p.VrT + (((size_t)h * 128 + n) * 256 + half * 128 + (tid >> 3)) * 128 + (tid & 7) * 8;
    const u16* b0 = p.KrT + (((size_t)h * 128 + n) * 128 + (tid >> 3)) * 128 + (tid & 7) * 8;
    gemm128_main(a0, (size_t)32 * 128, 64, b0, (size_t)32 * 128, 64, 2, lds, acc);
    stage_acc(cst, acc);
    __syncthreads();
    u16* dst = p.H + (((size_t)n * 4 + h) * 256 + half * 128) * 128;
    emit_rows(cst, [&](int row, int c8, const float* vv) { *(u32x4*)(dst + (size_t)row * 128 + c8 * 8) = pack8(vv); });
    __syncthreads();
}
constexpr int P2_UNITS = 256 + 1024;

DI float gelu_tanh(float x) {
    const float u = 0.7978845608028654f * (x + 0.044715f * x * x * x);
    const float t = 1.f - 2.f / (1.f + __expf(2.f * u));
    return 0.5f * x * (1.f + t);
}
DI void p3_unit(const Params& p, int u, unsigned char* smem) {
    const int tid = threadIdx.x, lane = tid & 63, w = tid >> 6;
    if (u < 256) {
        const int idx = (u * 256 + tid) * 2, h = idx >> 15;
        const float dec = __expf(128.0f * logf(1.0f - exp2f(-5.0f - (float)h)));
        unsigned* base = (unsigned*)(p.H + idx);
        float r0 = 0.f, r1 = 0.f;
#pragma unroll 8
        for (int n = 0; n < 128; ++n) {
            unsigned* pp = base + (size_t)n * 65536;
            const unsigned kv = *pp;
            *pp = pack2(r0, r1);
            r0 = dec * r0 + bflo(kv); r1 = dec * r1 + bfhi(kv);
        }
        return;
    }
    const int v = u - 256, kv = v & 1, rt = v >> 1;
    float* bias = (float*)smem;
    {
        float s = 0.f;
#pragma unroll
        for (int i = 0; i < 16; ++i) s += p.bpart[(kv * 16 + i) * 256 + tid];
        bias[tid] = s;
    }
    __syncthreads();
    const int lr = lane & 15, q = lane >> 4;
    const int R = rt * 16 + lr;
    f32x4 acc = {0.f, 0.f, 0.f, 0.f};
#pragma unroll
    for (int ks = 0; ks < 8; ++ks) {
        const int k0 = ks * 32 + q * 8;
        float hv[8];
#pragma unroll
        for (int k = 0; k < 8; ++k) hv[k] = bias[k0 + k];
#pragma unroll
        for (int s = 0; s < 4; ++s) {
            const float* sp = p.slab + ((size_t)(s * 2 + kv) * 2048 + R) * 256 + k0;
            const float4 a = *(const float4*)sp, b = *(const float4*)(sp + 4);
            hv[0] += a.x; hv[1] += a.y; hv[2] += a.z; hv[3] += a.w; hv[4] += b.x; hv[5] += b.y; hv[6] += b.z; hv[7] += b.w;
        }
#pragma unroll
        for (int k = 0; k < 8; ++k) hv[k] = gelu_tanh(hv[k]);
        const bf16x8 af = __builtin_bit_cast(bf16x8, pack8(hv));
        const bf16x8 bfr = ldf((kv ? p.W2T[1] : p.W2T[0]) + (size_t)(16 * w + lr) * 256 + k0);
        acc = MFMA16(af, bfr, acc);
    }
    const int d = 16 * w + lr;
#pragma unroll
    for (int r = 0; r < 4; ++r) {
        const int Ro = rt * 16 + 4 * q + r, c = Ro >> 1, g = Ro & 1;
        const float val = (c < 1023) ? acc[r] : 0.f;
        const u16 bv = (u16)(pack2(val, 0.f) & 0xffffu);
        if (kv == 0) p.Kc[((size_t)g * 1024 + c) * 64 + d] = bv;
        else p.VcT[(((size_t)g * 16 + (c >> 6)) * 64 + d) * 64 + (c & 63)] = bv;
    }
    __syncthreads();
}
constexpr int P3_UNITS = 512;

constexpr int IMPS = 260;
DI void nsa_load_tile(const u16* src, u32x4 (&r)[2]) {
    r[0] = ld16(src + threadIdx.x * 8); r[1] = ld16(src + (threadIdx.x + 256) * 8);
}
DI void nsa_store_tile(u16* dst, const u32x4 (&r)[2]) {
    const int c0 = threadIdx.x, c1 = threadIdx.x + 256;
    *(u32x4*)(dst + (c0 >> 3) * LDT + (c0 & 7) * 8) = r[0];
    *(u32x4*)(dst + (c1 >> 3) * LDT + (c1 & 7) * 8) = r[1];
}
DI void nsa_scores(const u16* Kt, const bf16x8 (&qf)[2][2], f32x4 (&s)[4][2]) {
    const int lane = threadIdx.x & 63, lr = lane & 15, q = lane >> 4;
#pragma unroll
    for (int kt = 0; kt < 4; ++kt) {
        const int krow = 32 * (kt >> 1) + 8 * (lr >> 2) + 4 * (kt & 1) + (lr & 3);
        s[kt][0] = f32x4{0.f, 0.f, 0.f, 0.f}; s[kt][1] = f32x4{0.f, 0.f, 0.f, 0.f};
#pragma unroll
        for (int ks = 0; ks < 2; ++ks) {
            const bf16x8 kf = ldf(Kt + krow * LDT + ks * 32 + q * 8);
            s[kt][0] = MFMA16(kf, qf[0][ks], s[kt][0]);
            s[kt][1] = MFMA16(kf, qf[1][ks], s[kt][1]);
        }
    }
}
DI void nsa_pv(const u16* Vt, const f32x4 (&s)[4][2], f32x4 (&o)[4][2]) {
    const int lane = threadIdx.x & 63, lr = lane & 15, q = lane >> 4;
#pragma unroll
    for (int ks2 = 0; ks2 < 2; ++ks2) {
        const bf16x8 pb0 = packf(s[2 * ks2][0], s[2 * ks2 + 1][0]);
        const bf16x8 pb1 = packf(s[2 * ks2][1], s[2 * ks2 + 1][1]);
#pragma unroll
        for (int dt = 0; dt < 4; ++dt) {
            const bf16x8 vf = ldf(Vt + (16 * dt + lr) * LDT + ks2 * 32 + q * 8);
            o[dt][0] = MFMA16(vf, pb0, o[dt][0]);
            o[dt][1] = MFMA16(vf, pb1, o[dt][1]);
        }
    }
}

DI void nsa_item(const Params& p, int tb, int g, unsigned char* smem) {
    u16* Kt = (u16*)smem;
    u16* Vt = Kt + 64 * LDT;
    float* imp = (float*)(smem + 2 * 64 * LDT * 2);
    int* sel = (int*)(imp + 32 * IMPS);
    const int tid = threadIdx.x, lane = tid & 63, w = tid >> 6, lr = lane & 15, q = lane >> 4;
    const int t0 = tb * 32, cur = t0 >> 6;
    const float SC = 0.125f * LOG2E;
    const float NEG = -1e30f;

    bf16x8 qf[2][2];
    int tokL[2]; float gc[2], gs[2], gw[2];
#pragma unroll
    for (int rt = 0; rt < 2; ++rt) {
        tokL[rt] = t0 + 8 * w + 4 * rt + (lr >> 2);
        const int head = 4 * g + (lr & 3);
#pragma unroll
        for (int ks = 0; ks < 2; ++ks) qf[rt][ks] = ldf(p.Qn + (size_t)tokL[rt] * 512 + head * 64 + 32 * ks + 8 * q);
        const float* gp = p.Gn + (size_t)tokL[rt] * 24 + head * 3;
        gc[rt] = gp[0]; gs[rt] = gp[1]; gw[rt] = gp[2];
    }
    f32x4 tot[4][2];
#pragma unroll
    for (int dt = 0; dt < 4; ++dt) { tot[dt][0] = f32x4{0.f, 0.f, 0.f, 0.f}; tot[dt][1] = f32x4{0.f, 0.f, 0.f, 0.f}; }

    {
        float m[2] = {NEG, NEG}, l[2] = {0.f, 0.f};
        f32x4 o[4][2];
#pragma unroll
        for (int dt = 0; dt < 4; ++dt) { o[dt][0] = f32x4{0.f, 0.f, 0.f, 0.f}; o[dt][1] = f32x4{0.f, 0.f, 0.f, 0.f}; }
        const int kb_lo = (t0 > 511 ? t0 - 511 : 0) >> 6, kb_hi = cur;
        u32x4 rk[2], rv[2];
        nsa_load_tile(p.Kw + ((size_t)g * S_ + kb_lo * 64) * 64, rk);
        nsa_load_tile(p.VwT + ((size_t)g * 256 + kb_lo) * 4096, rv);
        for (int kb = kb_lo; kb <= kb_hi; ++kb) {
            __syncthreads();
            nsa_store_tile(Kt, rk); nsa_store_tile(Vt, rv);
            __syncthreads();
            if (kb < kb_hi) {
                nsa_load_tile(p.Kw + ((size_t)g * S_ + (kb + 1) * 64) * 64, rk);
                nsa_load_tile(p.VwT + ((size_t)g * 256 + kb + 1) * 4096, rv);
            }
            f32x4 s[4][2];
            nsa_scores(Kt, qf, s);
#pragma unroll
            for (int rt = 0; rt < 2; ++rt) {
                const int t = tokL[rt];
                float mx = NEG;
#pragma unroll
                for (int kt = 0; kt < 4; ++kt)
#pragma unroll
                    for (int r = 0; r < 4; ++r) {
                        const int key = kb * 64 + 32 * (kt >> 1) + 8 * q + 4 * (kt & 1) + r;
                        const bool ok = (key <= t) && (key > t - 512);
                        const float v = ok ? s[kt][rt][r] * SC : NEG;
                        s[kt][rt][r] = v; mx = fmaxf(mx, v);
                    }
                mx = fmaxf(mx, __shfl_xor(mx, 16)); mx = fmaxf(mx, __shfl_xor(mx, 32));
                const float mn = fmaxf(m[rt], mx), alpha = exp2f(m[rt] - mn);
                float rs = 0.f;
#pragma unroll
                for (int kt = 0; kt < 4; ++kt)
#pragma unroll
                    for (int r = 0; r < 4; ++r) {
                        const float v = s[kt][rt][r];
                        const float pv = (v > -1e29f) ? exp2f(v - mn) : 0.f;
                        s[kt][rt][r] = pv; rs += pv;
                    }
                l[rt] = l[rt] * alpha + rs; m[rt] = mn;
#pragma unroll
                for (int dt = 0; dt < 4; ++dt) o[dt][rt] *= alpha;
            }
            nsa_pv(Vt, s, o);
        }
#pragma unroll
        for (int rt = 0; rt < 2; ++rt) {
            float lt = l[rt]; lt += __shfl_xor(lt, 16); lt += __shfl_xor(lt, 32);
            const float f = gw[rt] / fmaxf(lt, 1e-37f);
#pragma unroll
            for (int dt = 0; dt < 4; ++dt) tot[dt][rt] += o[dt][rt] * f;
        }
    }

    {
        const int nct = ((t0 >> 4) >> 6) + 1;
        int cmaxv[2]; cmaxv[0] = (tokL[0] - 31) >> 4; cmaxv[1] = (tokL[1] - 31) >> 4;
        float m[2] = {NEG, NEG}, l[2] = {0.f, 0.f};
        u32x4 rk[2], rv[2];
        nsa_load_tile(p.Kc + ((size_t)g * 1024) * 64, rk);
        for (int ct = 0; ct < nct; ++ct) {
            __syncthreads();
            nsa_store_tile(Kt, rk);
            __syncthreads();
            if (ct + 1 < nct) nsa_load_tile(p.Kc + ((size_t)g * 1024 + (ct + 1) * 64) * 64, rk);
            f32x4 s[4][2];
            nsa_scores(Kt, qf, s);
#pragma unroll
            for (int rt = 0; rt < 2; ++rt) {
                float mx = NEG;
#pragma unroll
                for (int kt = 0; kt < 4; ++kt)
#pragma unroll
                    for (int r = 0; r < 4; ++r) {
                        const int c = ct * 64 + 32 * (kt >> 1) + 8 * q + 4 * (kt & 1) + r;
                        const float v = (c <= cmaxv[rt]) ? s[kt][rt][r] * SC : NEG;
                        s[kt][rt][r] = v; mx = fmaxf(mx, v);
                    }
                mx = fmaxf(mx, __shfl_xor(mx, 16)); mx = fmaxf(mx, __shfl_xor(mx, 32));
                const float mn = fmaxf(m[rt], mx), alpha = exp2f(m[rt] - mn);
                float rs = 0.f;
#pragma unroll
                for (int kt = 0; kt < 4; ++kt)
#pragma unroll
                    for (int r = 0; r < 4; ++r) { const float v = s[kt][rt][r]; rs += (v > -1e29f) ? exp2f(v - mn) : 0.f; }
                l[rt] = l[rt] * alpha + rs; m[rt] = mn;
            }
        }
        float linv[2];
#pragma unroll
        for (int rt = 0; rt < 2; ++rt) {
            float lt = l[rt]; lt += __shfl_xor(lt, 16); lt += __shfl_xor(lt, 32);
            linv[rt] = 1.f / fmaxf(lt, 1e-37f);
        }
        f32x4 o[4][2];
#pragma unroll
        for (int dt = 0; dt < 4; ++dt) { o[dt][0] = f32x4{0.f, 0.f, 0.f, 0.f}; o[dt][1] = f32x4{0.f, 0.f, 0.f, 0.f}; }
        float carry[2] = {0.f, 0.f};
        nsa_load_tile(p.Kc + ((size_t)g * 1024) * 64, rk);
        nsa_load_tile(p.VcT + ((size_t)g * 16) * 4096, rv);
        for (int ct = 0; ct < nct; ++ct) {
            __syncthreads();
            nsa_store_tile(Kt, rk); nsa_store_tile(Vt, rv);
            __syncthreads();
            if (ct + 1 < nct) {
                nsa_load_tile(p.Kc + ((size_t)g * 1024 + (ct + 1) * 64) * 64, rk);
                nsa_load_tile(p.VcT + ((size_t)g * 16 + ct + 1) * 4096, rv);
            }
            f32x4 s[4][2];
            nsa_scores(Kt, qf, s);
#pragma unroll
            for (int rt = 0; rt < 2; ++rt) {
#pragma unroll
                for (int kt = 0; kt < 4; ++kt)
#pragma unroll
                    for (int r = 0; r < 4; ++r) {
                        const int c = ct * 64 + 32 * (kt >> 1) + 8 * q + 4 * (kt & 1) + r;
                        s[kt][rt][r] = (c <= cmaxv[rt]) ? exp2f(s[kt][rt][r] * SC - m[rt]) * linv[rt] : 0.f;
                    }
                const float up1 = __shfl_up(s[1][rt][3], 16), up3 = __shfl_up(s[3][rt][3], 16);
                const float w1 = __shfl(s[1][rt][3], lr + 48), w3 = __shfl(s[3][rt][3], lr + 48);
                float e[4];
                e[0] = s[0][rt][0] + s[0][rt][1] + s[0][rt][2] + s[0][rt][3] + (q > 0 ? up1 : carry[rt]);
                e[1] = s[1][rt][0] + s[1][rt][1] + s[1][rt][2] + s[1][rt][3] + s[0][rt][3];
                e[2] = s[2][rt][0] + s[2][rt][1] + s[2][rt][2] + s[2][rt][3] + (q > 0 ? up3 : w1);
                e[3] = s[3][rt][0] + s[3][rt][1] + s[3][rt][2] + s[3][rt][3] + s[2][rt][3];
                carry[rt] = w3;
#pragma unroll
                for (int kt = 0; kt < 4; ++kt) {
                    float ev = e[kt];
                    ev += __shfl_xor(ev, 1); ev += __shfl_xor(ev, 2);
                    if ((lr & 3) == 0) imp[(8 * w + 4 * rt + (lr >> 2)) * IMPS + ct * 16 + 8 * (kt >> 1) + 2 * q + (kt & 1)] = ev;
                }
            }
            nsa_pv(Vt, s, o);
        }
#pragma unroll
        for (int rt = 0; rt < 2; ++rt)
#pragma unroll
            for (int dt = 0; dt < 4; ++dt) tot[dt][rt] += o[dt][rt] * gc[rt];
    }
    __syncthreads();

    for (int tk = 0; tk < 8; ++tk) {
        const int tl = 8 * w + tk;
        float v[4];
#pragma unroll
        for (int i = 0; i < 4; ++i) {
            const int j = lane + 64 * i;
            const bool cand = (j <= cur) && (j != 0) && (j != cur) && (j != cur - 1);
            v[i] = cand ? imp[tl * IMPS + j] : -1.f;
        }
        int selv = -1;
        if (lane == 0) selv = 0;
        if (cur > 0 && lane == 1) selv = cur;
        if (cur > 1 && lane == 2) selv = cur - 1;
        const int nforced = 1 + (cur > 0 ? 1 : 0) + (cur > 1 ? 1 : 0);
        for (int it = nforced; it < 16; ++it) {
            const float lm = fmaxf(fmaxf(v[0], v[1]), fmaxf(v[2], v[3]));
            const float wm = wave_max(lm);
            if (wm < 0.f) break;
            int jstar;
            const unsigned long long b0 = __ballot(v[0] == wm);
            if (b0) { const int ow = __builtin_ctzll(b0); jstar = ow; if (lane == ow) v[0] = -1.f; }
            else {
                const unsigned long long b1 = __ballot(v[1] == wm);
                if (b1) { const int ow = __builtin_ctzll(b1); jstar = ow + 64; if (lane == ow) v[1] = -1.f; }
                else {
                    const unsigned long long b2 = __ballot(v[2] == wm);
                    if (b2) { const int ow = __builtin_ctzll(b2); jstar = ow + 128; if (lane == ow) v[2] = -1.f; }
                    else { const unsigned long long b3 = __ballot(v[3] == wm); if (!b3) break; const int ow = __builtin_ctzll(b3); jstar = ow + 192; if (lane == ow) v[3] = -1.f; }
                }
            }
            if (lane == it) selv = jstar;
        }
        if (lane < 16) sel[tl * 16 + lane] = selv;
    }
    __syncthreads();

    float* stash = imp;
#pragma unroll
    for (int dt = 0; dt < 4; ++dt)
#pragma unroll
        for (int rt = 0; rt < 2; ++rt)
#pragma unroll
            for (int r = 0; r < 4; ++r) stash[((dt * 2 + rt) * 4 + r) * 256 + tid] = tot[dt][rt][r];
#pragma unroll 1
    for (int rt2 = 0; rt2 < 2; ++rt2) {
        f32x4 tsel[4];
#pragma unroll
        for (int dt = 0; dt < 4; ++dt) tsel[dt] = f32x4{0.f, 0.f, 0.f, 0.f};
        const float gsel = rt2 ? gs[1] : gs[0];
        const int tokSel = rt2 ? tokL[1] : tokL[0];
#pragma unroll 1
        for (int tq = 0; tq < 4; ++tq) {
            const int tl = 8 * w + 4 * rt2 + tq, t = t0 + tl;
            bf16x8 qs[2];
#pragma unroll
            for (int ks = 0; ks < 2; ++ks) qs[ks] = ldf(p.Qn + (size_t)t * 512 + (4 * g + (lr & 3)) * 64 + 32 * ks + 8 * q);
            float m = NEG, l = 0.f;
            f32x4 os[4];
#pragma unroll
            for (int dt = 0; dt < 4; ++dt) os[dt] = f32x4{0.f, 0.f, 0.f, 0.f};
            int nv = 0;
#pragma unroll
            for (int i = 0; i < 16; ++i) nv += (sel[tl * 16 + i] >= 0) ? 1 : 0;
            bf16x8 kA[4][2];
            auto load_k = [&](int j, bf16x8 (&kf)[4][2]) {
                const u16* kbase = p.Ks + ((size_t)g * S_ + (size_t)j * 64) * 64;
#pragma unroll
                for (int kt = 0; kt < 4; ++kt) {
                    const int krow = 32 * (kt >> 1) + 8 * (lr >> 2) + 4 * (kt & 1) + (lr & 3);
#pragma unroll
                    for (int ks = 0; ks < 2; ++ks) kf[kt][ks] = ldf(kbase + krow * 64 + ks * 32 + q * 8);
                }
            };
            load_k(sel[tl * 16], kA);
            for (int slot = 0; slot < nv; ++slot) {
                const int j = sel[tl * 16 + slot];
                const u16* vbase = p.VsT + ((size_t)g * 256 + j) * 4096;
                bf16x8 vf[4][2];
#pragma unroll
                for (int dt = 0; dt < 4; ++dt)
#pragma unroll
                    for (int ks2 = 0; ks2 < 2; ++ks2) vf[dt][ks2] = ldf(vbase + (16 * dt + lr) * 64 + ks2 * 32 + q * 8);
                f32x4 s[4];
#pragma unroll
                for (int kt = 0; kt < 4; ++kt) {
                    s[kt] = f32x4{0.f, 0.f, 0.f, 0.f};
#pragma unroll
                    for (int ks = 0; ks < 2; ++ks) s[kt] = MFMA16(kA[kt][ks], qs[ks], s[kt]);
                }
                if (slot + 1 < nv) load_k(sel[tl * 16 + slot + 1], kA);
                float mx = NEG;
#pragma unroll
                for (int kt = 0; kt < 4; ++kt)
#pragma unroll
                    for (int r = 0; r < 4; ++r) {
                        const int key = j * 64 + 32 * (kt >> 1) + 8 * q + 4 * (kt & 1) + r;
                        const float vv = (key <= t) ? s[kt][r] * SC : NEG;
                        s[kt][r] = vv; mx = fmaxf(mx, vv);
                    }
                mx = fmaxf(mx, __shfl_xor(mx, 16)); mx = fmaxf(mx, __shfl_xor(mx, 32));
                const float mn = fmaxf(m, mx), alpha = exp2f(m - mn);
                float rs = 0.f;
#pragma unroll
                for (int kt = 0; kt < 4; ++kt)
#pragma unroll
                    for (int r = 0; r < 4; ++r) {
                        const float vv = s[kt][r];
                        const float pv = (vv > -1e29f) ? exp2f(vv - mn) : 0.f;
                        s[kt][r] = pv; rs += pv;
                    }
                l = l * alpha + rs; m = mn;
#pragma unroll
                for (int dt = 0; dt < 4; ++dt) os[dt] *= alpha;
#pragma unroll
                for (int ks2 = 0; ks2 < 2; ++ks2) {
                    const bf16x8 pb = packf(s[2 * ks2], s[2 * ks2 + 1]);
#pragma unroll
                    for (int dt = 0; dt < 4; ++dt) os[dt] = MFMA16(vf[dt][ks2], pb, os[dt]);
                }
            }
            float lt = l; lt += __shfl_xor(lt, 16); lt += __shfl_xor(lt, 32);
            const float f = ((lr >> 2) == tq) ? gsel / fmaxf(lt, 1e-37f) : 0.f;
#pragma unroll
            for (int dt = 0; dt < 4; ++dt) tsel[dt] += os[dt] * f;
        }
        const int head = 4 * g + (lr & 3);
#pragma unroll
        for (int dt = 0; dt < 4; ++dt) {
            float o4[4];
#pragma unroll
            for (int r = 0; r < 4; ++r) o4[r] = tsel[dt][r] + stash[((dt * 2 + rt2) * 4 + r) * 256 + tid];
            const size_t off = (size_t)tokSel * 512 + head * 64 + 16 * dt + 4 * q;
            const u32x2 z = *(const u32x2*)(p.SZn + off);
            u32x2 o2;
            o2[0] = pack2(o4[0] * bflo(z[0]), o4[1] * bfhi(z[0]));
            o2[1] = pack2(o4[2] * bflo(z[1]), o4[3] * bfhi(z[1]));
            *(u32x2*)(p.Qn + off) = o2;
        }
    }
    __syncthreads();
}


DI void ret_item(const Params& p, int n, int h) {
    const int lane = threadIdx.x & 63, w = threadIdx.x >> 6, lr = lane & 15, q = lane >> 4;
    const float lg2 = logf(1.0f - exp2f(-5.0f - (float)h)) * LOG2E;
    const u16* rbase = p.H + (((size_t)n * 4 + h) * 256) * 128;
    const u16* kbase = p.Kr + ((size_t)h * S_ + n * 128) * 128;
    const u16* vbase = p.VrT + (((size_t)h * 128 + n) * 256) * 128;
    const u16* rlane = rbase + lr * 128 + 8 * q;
    const u16* vlane = vbase + lr * 128 + 8 * q;
#pragma unroll 1
    for (int it = 0; it < 2; ++it) {
        const int i = 32 * w + 16 * it + lr;
        bf16x8 qf[4];
#pragma unroll
        for (int ks = 0; ks < 4; ++ks) qf[ks] = ldf(p.Qr + ((size_t)h * S_ + n * 128 + i) * 128 + 32 * ks + 8 * q);
        f32x4 acc[16];
#pragma unroll
        for (int et = 0; et < 16; ++et) acc[et] = f32x4{0.f, 0.f, 0.f, 0.f};
#pragma unroll
        for (int et = 0; et < 16; ++et) {
            const u16* pe = rlane + et * 16 * 128; asm volatile("" : "+v"(pe));
#pragma unroll
            for (int ks = 0; ks < 4; ++ks) acc[et] = MFMA16(ldf(pe + 32 * ks), qf[ks], acc[et]);
        }
        {
            const float qd = exp2f((float)(i + 1) * lg2);
#pragma unroll
            for (int et = 0; et < 16; ++et) acc[et] *= qd;
        }
        for (int jk = 0; jk <= w; ++jk) {
            f32x4 s[2];
#pragma unroll
            for (int jj = 0; jj < 2; ++jj) {
                const int krow = 32 * jk + 8 * (lr >> 2) + 4 * jj + (lr & 3);
                s[jj] = f32x4{0.f, 0.f, 0.f, 0.f};
#pragma unroll
                for (int ks = 0; ks < 4; ++ks) s[jj] = MFMA16(ldf(kbase + (size_t)krow * 128 + 32 * ks + 8 * q), qf[ks], s[jj]);
            }
#pragma unroll
            for (int jj = 0; jj < 2; ++jj)
#pragma unroll
                for (int r = 0; r < 4; ++r) {
                    const int j = 32 * jk + 8 * q + 4 * jj + r;
                    s[jj][r] = (i >= j) ? s[jj][r] * exp2f((float)(i - j) * lg2) : 0.f;
                }
            const bf16x8 pb = packf(s[0], s[1]);
#pragma unroll
            for (int et = 0; et < 16; ++et) {
                const u16* pe = vlane + et * 16 * 128 + 32 * jk; asm volatile("" : "+v"(pe));
                acc[et] = MFMA16(ldf(pe), pb, acc[et]);
            }
        }
        float sm = 0.f;
#pragma unroll
        for (int et = 0; et < 16; ++et) sm += acc[et][0] + acc[et][1] + acc[et][2] + acc[et][3];
        sm += __shfl_xor(sm, 16); sm += __shfl_xor(sm, 32);
        const float mu = sm * (1.f / 256.f);
        float vs = 0.f;
#pragma unroll
        for (int et = 0; et < 16; ++et)
#pragma unroll
            for (int r = 0; r < 4; ++r) { const float d = acc[et][r] - mu; vs += d * d; }
        vs += __shfl_xor(vs, 16); vs += __shfl_xor(vs, 32);
        const float rs = rsqrtf(vs * (1.f / 256.f) + 1e-6f);
        u16* zlane = p.SZr + ((size_t)n * 128 + i) * 1024 + h * 256 + 4 * q;
#pragma unroll
        for (int et = 0; et < 16; ++et) {
            u16* zp = zlane + 16 * et; asm volatile("" : "+v"(zp));
            const u32x2 z = *(const u32x2*)zp;
            u32x2 o2;
            o2[0] = pack2((acc[et][0] - mu) * rs * bflo(z[0]), (acc[et][1] - mu) * rs * bfhi(z[0]));
            o2[1] = pack2((acc[et][2] - mu) * rs * bflo(z[1]), (acc[et][3] - mu) * rs * bfhi(z[1]));
            *(u32x2*)zp = o2;
        }
    }
}

DI void p5_tile(const Params& p, int t, unsigned char* smem) {
    const int tid = threadIdx.x;
    const int nt = t >> 7, mt = t & 127, tok0 = mt * 128;
    u16* lds = (u16*)smem; float* cst = (float*)smem;
    float* hold = (float*)p.H + (size_t)blockIdx.x * 16384;
    {
        f32x4 acc[4][4]; zero_acc(acc);
        gemm128_main(p.Qn + (size_t)(tok0 + (tid >> 3)) * 512 + (tid & 7) * 8, (size_t)32 * 512, 64,
                     p.WnoT + (size_t)(nt * 128 + (tid >> 3)) * 512 + (tid & 7) * 8, (size_t)32 * 512, 64, 8, lds, acc);
        stage_acc(cst, acc);
    }
    __syncthreads();
    emit_rows(cst, [&](int row, int c8, const float* v) {
        const u32x4 gm = ld16(p.Ma + (size_t)(tok0 + row) * 1024 + nt * 128 + c8 * 8);
        float4 a, b;
        a.x = v[0] * bflo(gm[0]); a.y = v[1] * bfhi(gm[0]); a.z = v[2] * bflo(gm[1]); a.w = v[3] * bfhi(gm[1]);
        b.x = v[4] * bflo(gm[2]); b.y = v[5] * bfhi(gm[2]); b.z = v[6] * bflo(gm[3]); b.w = v[7] * bfhi(gm[3]);
        *(float4*)(hold + row * 128 + c8 * 8) = a; *(float4*)(hold + row * 128 + c8 * 8 + 4) = b; });
    __syncthreads();
    {
        f32x4 acc[4][4]; zero_acc(acc);
        gemm128_main(p.SZr + (size_t)(tok0 + (tid >> 3)) * 1024 + (tid & 7) * 8, (size_t)32 * 1024, 64,
                     p.WroT + (size_t)(nt * 128 + (tid >> 3)) * 1024 + (tid & 7) * 8, (size_t)32 * 1024, 64, 16, lds, acc);
        stage_acc(cst, acc);
    }
    __syncthreads();
    u16* Mg = p.Qr;
    emit_rows(cst, [&](int row, int c8, const float* v) {
        const u32x4 gm = ld16(p.Mb + (size_t)(tok0 + row) * 1024 + nt * 128 + c8 * 8);
        const float4 a = *(const float4*)(hold + row * 128 + c8 * 8), b = *(const float4*)(hold + row * 128 + c8 * 8 + 4);
        float o[8];
        o[0] = a.x + v[0] * bflo(gm[0]); o[1] = a.y + v[1] * bfhi(gm[0]); o[2] = a.z + v[2] * bflo(gm[1]); o[3] = a.w + v[3] * bfhi(gm[1]);
        o[4] = b.x + v[4] * bflo(gm[2]); o[5] = b.y + v[5] * bfhi(gm[2]); o[6] = b.z + v[6] * bflo(gm[3]); o[7] = b.w + v[7] * bfhi(gm[3]);
        *(u32x4*)(Mg + (size_t)(tok0 + row) * 1024 + nt * 128 + c8 * 8) = pack8(o); });
    __syncthreads();
}

DI void p6_tile(const Params& p, int t, unsigned char* smem) {
    const int tid = threadIdx.x;
    const int nt = t >> 7, mt = t & 127, tok0 = mt * 128;
    u16* lds = (u16*)smem; float* cst = (float*)smem;
    const u16* Mg = p.Qr; u16* Y2 = p.VrT;
    {
        f32x4 acc[4][4]; zero_acc(acc);
        gemm128_main(Mg + (size_t)(tok0 + (tid >> 3)) * 1024 + (tid & 7) * 8, (size_t)32 * 1024, 64,
                     p.WoutT + (size_t)(nt * 128 + (tid >> 3)) * 1024 + (tid & 7) * 8, (size_t)32 * 1024, 64, 16, lds, acc);
        stage_acc(cst, acc);
    }
    __syncthreads();
    emit_rows(cst, [&](int row, int c8, const float* v) {
        *(u32x4*)(Y2 + (size_t)(tok0 + row) * 1024 + nt * 128 + c8 * 8) = pack8(v);
        float ss = 0.f;
#pragma unroll
        for (int k = 0; k < 8; ++k) ss += v[k] * v[k];
        ss += __shfl_xor(ss, 1); ss += __shfl_xor(ss, 2); ss += __shfl_xor(ss, 4); ss += __shfl_xor(ss, 8);
        if (c8 == 0) p.rowss[(size_t)(tok0 + row) * 8 + nt] = ss; });
    __syncthreads();
}

DI void p7_all(const Params& p) {
    const u16* Y2 = p.VrT;
    const size_t n4 = (size_t)S_ * 256;
    for (size_t i = (size_t)blockIdx.x * 256 + threadIdx.x; i < n4; i += (size_t)gridDim.x * 256) {
        const size_t row = i >> 8; const int c4 = (int)(i & 255);
        const float4 a = *(const float4*)(p.rowss + row * 8), b = *(const float4*)(p.rowss + row * 8 + 4);
        const float ss = ((a.x + a.y) + (a.z + a.w)) + ((b.x + b.y) + (b.z + b.w));
        const float rs = rsqrtf(ss * (1.f / 1024.f) + 1e-6f);
        const float4 xv = *(const float4*)(p.x + i * 4);
        const float4 gv = *(const float4*)(p.norm_post + c4 * 4);
        const u32x2 y = *(const u32x2*)(Y2 + i * 4);
        float4 o;
        o.x = xv.x + bflo(y[0]) * rs * gv.x; o.y = xv.y + bfhi(y[0]) * rs * gv.y;
        o.z = xv.z + bflo(y[1]) * rs * gv.z; o.w = xv.w + bfhi(y[1]) * rs * gv.w;
        *(float4*)(p.out + i * 4) = o;
    }
}

#ifndef MK_PHASE_MASK
#define MK_PHASE_MASK 0xff
#endif
constexpr size_t al256(size_t x) { return (x + 255) & ~(size_t)255; }
constexpr size_t O_BAR   = 0;
constexpr size_t O_WINT  = O_BAR   + 16384;
constexpr size_t O_WNOT  = O_WINT  + al256((size_t)NPAD_ * 1024 * 2);
constexpr size_t O_WROT  = O_WNOT  + (size_t)1024 * 512 * 2;
constexpr size_t O_WOUTT = O_WROT  + (size_t)1024 * 1024 * 2;
constexpr size_t O_W1T0  = O_WOUTT + (size_t)1024 * 1024 * 2;
constexpr size_t O_W1T1  = O_W1T0  + (size_t)256 * 2048 * 2;
constexpr size_t O_W2T0  = O_W1T1  + (size_t)256 * 2048 * 2;
constexpr size_t O_W2T1  = O_W2T0  + (size_t)64 * 256 * 2;
constexpr size_t O_BPART = O_W2T1  + (size_t)64 * 256 * 2;
constexpr size_t O_ROPEN = O_BPART + (size_t)2 * 16 * 256 * 4;
constexpr size_t O_ROPER = O_ROPEN + (size_t)S_ * 8 * 8;
constexpr size_t O_H     = O_ROPER + (size_t)S_ * 64 * 8;
constexpr size_t O_QN    = O_H     + (size_t)S_ * 1024 * 2;
constexpr size_t O_RAW0  = O_QN    + (size_t)S_ * 512 * 2;
constexpr size_t O_RAW1  = O_RAW0  + (size_t)S_ * 128 * 2;
constexpr size_t O_KS    = O_RAW1  + (size_t)S_ * 128 * 2;
constexpr size_t O_VST   = O_KS    + (size_t)2 * S_ * 64 * 2;
constexpr size_t O_KW    = O_VST   + (size_t)2 * S_ * 64 * 2;
constexpr size_t O_VWT   = O_KW    + (size_t)2 * S_ * 64 * 2;
constexpr size_t O_SZN   = O_VWT   + (size_t)2 * S_ * 64 * 2;
constexpr size_t O_QR    = O_SZN   + (size_t)S_ * 512 * 2;
constexpr size_t O_KR    = O_QR    + (size_t)4 * S_ * 128 * 2;
constexpr size_t O_KRT   = O_KR    + (size_t)4 * S_ * 128 * 2;
constexpr size_t O_VRT   = O_KRT   + (size_t)4 * S_ * 128 * 2;
constexpr size_t O_SZR   = O_VRT   + (size_t)4 * S_ * 256 * 2;
constexpr size_t O_GN    = O_SZR   + (size_t)S_ * 1024 * 2;
constexpr size_t O_SLAB  = O_GN    + (size_t)S_ * 24 * 4;
constexpr size_t O_KC    = O_SLAB  + (size_t)4 * 2 * 2048 * 256 * 4;
constexpr size_t O_VCT   = O_KC    + (size_t)2 * 1024 * 64 * 2;
constexpr size_t O_ROWSS = O_VCT   + (size_t)2 * 1024 * 64 * 2;
constexpr size_t WS_BYTES = O_ROWSS + (size_t)S_ * 8 * 4;

struct KArgs {
    const float *x, *norm_pre, *w_in, *b_gate, *pe_k, *w1_k, *w2_k, *pe_v, *w1_v, *w2_v, *w_nsa_o, *w_ret_o, *w_out, *norm_post;
    float* out; char* ws; int use_cg; int pad0;
};

__global__ void __launch_bounds__(256, 2) fwd_megakernel(KArgs ka) {
    Params p;
    p.x = ka.x; p.norm_pre = ka.norm_pre; p.w_in = ka.w_in; p.b_gate = ka.b_gate; p.pe_k = ka.pe_k; p.w1_k = ka.w1_k; p.w2_k = ka.w2_k;
    p.pe_v = ka.pe_v; p.w1_v = ka.w1_v; p.w2_v = ka.w2_v; p.w_nsa_o = ka.w_nsa_o; p.w_ret_o = ka.w_ret_o; p.w_out = ka.w_out; p.norm_post = ka.norm_post;
    p.out = ka.out; p.use_cg = ka.use_cg; p.pad0 = 0;
    {
        char* ws = ka.ws;
        p.bar = (unsigned*)(ws + O_BAR);
        p.WinT = (u16*)(ws + O_WINT); p.WnoT = (u16*)(ws + O_WNOT); p.WroT = (u16*)(ws + O_WROT); p.WoutT = (u16*)(ws + O_WOUTT);
        p.W1T[0] = (u16*)(ws + O_W1T0); p.W1T[1] = (u16*)(ws + O_W1T1); p.W2T[0] = (u16*)(ws + O_W2T0); p.W2T[1] = (u16*)(ws + O_W2T1);
        p.bpart = (float*)(ws + O_BPART); p.ropeN = (float2*)(ws + O_ROPEN); p.ropeR = (float2*)(ws + O_ROPER);
        p.H = (u16*)(ws + O_H); p.Qn = (u16*)(ws + O_QN); p.Raw[0] = (u16*)(ws + O_RAW0); p.Raw[1] = (u16*)(ws + O_RAW1);
        p.Ks = (u16*)(ws + O_KS); p.VsT = (u16*)(ws + O_VST); p.Kw = (u16*)(ws + O_KW); p.VwT = (u16*)(ws + O_VWT);
        p.SZn = (u16*)(ws + O_SZN); p.Qr = (u16*)(ws + O_QR); p.Kr = (u16*)(ws + O_KR); p.KrT = (u16*)(ws + O_KRT); p.VrT = (u16*)(ws + O_VRT);
        p.SZr = (u16*)(ws + O_SZR); p.Gn = (float*)(ws + O_GN); p.slab = (float*)(ws + O_SLAB); p.Kc = (u16*)(ws + O_KC); p.VcT = (u16*)(ws + O_VCT);
        p.rowss = (float*)(ws + O_ROWSS);
        p.Ma = (u16*)ka.out; p.Mb = (u16*)ka.out + (size_t)S_ * 1024;
    }
    __shared__ __attribute__((aligned(16))) unsigned char smem[4 * TILE_ELEMS * 2];
    __shared__ uint4 xb_words;
    if (threadIdx.x == 0) xb_words = make_uint4(0u, 0u, 0u, 0u);
    __syncthreads();
    XcdBarrier b = xcd_barrier_post(p.bar, (volatile LAS unsigned*)&xb_words);
    const int G = gridDim.x, B = blockIdx.x;
#define GRID_SYNC() do { if (p.use_cg) cg::this_grid().sync(); else xcd_barrier(b); } while (0)
    for (int u = B; u < P0_UNITS; u += G) p0_unit(p, u, smem);
    GRID_SYNC();
    for (int t = B; t < 55 * 128; t += G) p1_tile(p, t, smem);
    GRID_SYNC();
    for (int u = B; u < P2_UNITS; u += G) p2_unit(p, u, smem);
    GRID_SYNC();
    for (int u = B; u < P3_UNITS; u += G) p3_unit(p, u, smem);
    GRID_SYNC();
    for (int u = B; u < 1536; u += G) {
        if (u < 1024) nsa_item(p, 511 - (u >> 1), u & 1, smem);
        else ret_item(p, (u - 1024) >> 2, (u - 1024) & 3);
    }
    GRID_SYNC();
    for (int t = B; t < 1024; t += G) p5_tile(p, t, smem);
    GRID_SYNC();
    for (int t = B; t < 1024; t += G) p6_tile(p, t, smem);
    GRID_SYNC();
    p7_all(p);
}

extern "C" void kernel_launch(void* const* d_in, const int* in_sizes, int n_in, void* d_out, int out_size,
                              void* d_ws, size_t ws_size, hipStream_t stream) {
    static int grid_blocks = 0;
    if (!grid_blocks) {
        int dev = 0, cus = 0, per_cu = 0;
        (void)hipGetDevice(&dev);
        (void)hipDeviceGetAttribute(&cus, hipDeviceAttributeMultiprocessorCount, dev);
        (void)hipOccupancyMaxActiveBlocksPerMultiprocessor(&per_cu, fwd_megakernel, 256, 0);
        if (per_cu > 2) per_cu = 2;
        if (per_cu < 1) per_cu = 1;
        grid_blocks = cus * per_cu;
    }
    KArgs ka{};
    ka.x = (const float*)d_in[0]; ka.norm_pre = (const float*)d_in[1]; ka.w_in = (const float*)d_in[2]; ka.b_gate = (const float*)d_in[3];
    ka.pe_k = (const float*)d_in[4]; ka.w1_k = (const float*)d_in[5]; ka.w2_k = (const float*)d_in[6];
    ka.pe_v = (const float*)d_in[7]; ka.w1_v = (const float*)d_in[8]; ka.w2_v = (const float*)d_in[9];
    ka.w_nsa_o = (const float*)d_in[10]; ka.w_ret_o = (const float*)d_in[11]; ka.w_out = (const float*)d_in[12]; ka.norm_post = (const float*)d_in[13];
    ka.out = (float*)d_out; ka.ws = (char*)d_ws; ka.use_cg = 0; ka.pad0 = 0;
    if (WS_BYTES > ws_size) { fprintf(stderr, "workspace too small: need %zu have %zu\n", (size_t)WS_BYTES, ws_size); return; }
    (void)hipMemsetAsync(d_ws, 0, XCD_BAR_WORDS * 4, stream);
    void* args[] = {&ka};
    hipError_t e = hipLaunchCooperativeKernel((void*)fwd_megakernel, dim3(grid_blocks), dim3(256), args, 0, stream);
    if (e != hipSuccess) fprintf(stderr, "cooperative launch failed: %s (grid %d)\n", hipGetErrorString(e), grid_blocks);
}
```

```cpp
#include <hip/hip_runtime.h>
#include <hip/hip_cooperative_groups.h>
#include <cstdio>
namespace cg = cooperative_groups;

#define DI __device__ __forceinline__
#define LAS __attribute__((address_space(3)))

#define XB_TMO      128
#define XB_XCNT(j)  (256  + 64 * (j))
#define XB_XSUB(j)  (1280 + 64 * (j))
#define XB_XGEN(j)  (2304 + 64 * (j))
#define XB_TOP      3328
#define XB_TOPGEN   3392
#define XCD_BAR_WORDS 3456
#define XB_SPIN_CAP (1u << 22)

DI unsigned xb_ld(unsigned* p)              { return __hip_atomic_load(p, __ATOMIC_RELAXED, __HIP_MEMORY_SCOPE_AGENT); }
DI unsigned xb_add(unsigned* p, unsigned v) { return __hip_atomic_fetch_add(p, v, __ATOMIC_RELAXED, __HIP_MEMORY_SCOPE_AGENT); }
DI unsigned xb_xcc_id() { return (unsigned)__builtin_amdgcn_s_getreg((3 << 11) | 20) & 0xFu; }
#define XB_SPIN(cond, bar) do { unsigned _sp = 0; while (cond) { __builtin_amdgcn_s_sleep(1); \
    if ((++_sp & 255u) == 0u) { if (xb_ld(&(bar)[XB_TMO])) break; if (_sp > XB_SPIN_CAP) { atomicAdd(&(bar)[XB_TMO], 1u); break; } } } } while (0)

struct XcdBarrier { unsigned* bar; unsigned x; volatile LAS unsigned* st; };

DI XcdBarrier xcd_barrier_post(unsigned* bar, volatile LAS unsigned* st) {
    XcdBarrier b; b.bar = bar; b.x = xb_xcc_id(); b.st = st;
    if (threadIdx.x == 0) (void)xb_add(&bar[XB_XCNT(b.x)], 1u);
    return b;
}
DI void xcd_barrier_complete(unsigned* bar, unsigned x, unsigned& nloc, unsigned& nx) {
    const unsigned G = gridDim.x * gridDim.y * gridDim.z;
    unsigned sum, cnt, mine, sp = 0u;
    for (;;) {
        sum = 0u; cnt = 0u; mine = 0u;
#pragma unroll
        for (unsigned j = 0; j < 16; ++j) { const unsigned c = xb_ld(&bar[XB_XCNT(j)]); sum += c; cnt += (c > 0u) ? 1u : 0u; mine = (j == x) ? c : mine; }
        if (sum == G) break;
        __builtin_amdgcn_s_sleep(1);
        if ((++sp & 255u) == 0u) { if (xb_ld(&bar[XB_TMO])) break; if (sp > XB_SPIN_CAP) { atomicAdd(&bar[XB_TMO], 1u); break; } }
    }
    nloc = mine > 0u ? mine : 1u; nx = cnt > 0u ? cnt : 1u;
}
DI void xcd_barrier(const XcdBarrier& b) {
    asm volatile("s_waitcnt vmcnt(0)" ::: "memory");
    __syncthreads();
    if (threadIdx.x == 0) {
        unsigned* bar = b.bar;
        __builtin_amdgcn_s_waitcnt(0);
        unsigned nloc = b.st[0], nx = b.st[1];
        if (nloc == 0u) { xcd_barrier_complete(bar, b.x, nloc, nx); b.st[0] = nloc; b.st[1] = nx; }
        const unsigned old = xb_add(&bar[XB_XSUB(b.x)], 1u);
        const unsigned gen = old / nloc;
        if (old + 1u == (gen + 1u) * nloc) {
            __builtin_amdgcn_fence(__ATOMIC_RELEASE, "agent");
            asm volatile("s_waitcnt vmcnt(0)" ::: "memory");
            const unsigned og = xb_add(&bar[XB_TOP], 1u);
            const unsigned tg = og / nx;
            if (og + 1u == (tg + 1u) * nx) xb_add(&bar[XB_TOPGEN], 1u);
            else XB_SPIN(xb_ld(&bar[XB_TOPGEN]) == tg, bar);
            __builtin_amdgcn_fence(__ATOMIC_ACQUIRE, "agent");
            xb_add(&bar[XB_XGEN(b.x)], 1u);
            asm volatile("s_waitcnt vmcnt(0)" ::: "memory");
        } else {
            XB_SPIN(xb_ld(&bar[XB_XGEN(b.x)]) == gen, bar);
            __builtin_amdgcn_fence(__ATOMIC_ACQUIRE, "agent");
            asm volatile("s_waitcnt vmcnt(0)" ::: "memory");
        }
    }
    __syncthreads();
}


#ifndef MK_PROBE
#define MK_PROBE 0
#endif
typedef unsigned short u16;
using bf16x8 = __attribute__((ext_vector_type(8))) short;
using f32x4  = __attribute__((ext_vector_type(4))) float;
using u32x4  = __attribute__((ext_vector_type(4))) unsigned;
using u32x2  = __attribute__((ext_vector_type(2))) unsigned;
typedef __attribute__((ext_vector_type(2))) __bf16 bf2_t;
#define MFMA16(a, b, c) __builtin_amdgcn_mfma_f32_16x16x32_bf16((a), (b), (c), 0, 0, 0)

constexpr int S_ = 16384, DM_ = 1024, NPAD_ = 7040;
constexpr int LDT = 72;
constexpr int TILE_ELEMS = 128 * LDT;
constexpr int CST = 132;
constexpr float LOG2E = 1.4426950408889634f;

template <int N> struct IC { static constexpr int value = N; };
DI int TID() { int t = threadIdx.x; asm volatile("" : "+v"(t)); return t; }
DI unsigned pack2(float a, float b) { bf2_t v = {(__bf16)a, (__bf16)b}; return __builtin_bit_cast(unsigned, v); }
DI float bflo(unsigned u) { return __uint_as_float(u << 16); }
DI float bfhi(unsigned u) { return __uint_as_float(u & 0xffff0000u); }
DI u32x4 ld16(const u16* p) { return *(const u32x4*)p; }
DI bf16x8 ldf(const u16* p) { return *(const bf16x8*)p; }
DI u32x4 pack8(const float* v) { u32x4 r; r[0] = pack2(v[0], v[1]); r[1] = pack2(v[2], v[3]); r[2] = pack2(v[4], v[5]); r[3] = pack2(v[6], v[7]); return r; }
DI bf16x8 packf(f32x4 a, f32x4 b) { u32x4 r; r[0] = pack2(a[0], a[1]); r[1] = pack2(a[2], a[3]); r[2] = pack2(b[0], b[1]); r[3] = pack2(b[2], b[3]); return __builtin_bit_cast(bf16x8, r); }
DI float sigmoidf_(float x) { return 1.f / (1.f + __expf(-x)); }
DI float wave_max(float v) {
#pragma unroll
    for (int o = 32; o >= 1; o >>= 1) v = fmaxf(v, __shfl_xor(v, o));
    return v;
}
DI float wave_sum(float v) {
#pragma unroll
    for (int o = 32; o >= 1; o >>= 1) v += __shfl_xor(v, o);
    return v;
}

struct Params {
    const float *x, *norm_pre, *w_in, *b_gate, *pe_k, *w1_k, *w2_k, *pe_v, *w1_v, *w2_v, *w_nsa_o, *w_ret_o, *w_out, *norm_post;
    float* out;
    unsigned* bar;
    u16 *WinT, *WnoT, *WroT, *WoutT, *W1T[2], *W2T[2];
    float* bpart;
    float2 *ropeN, *ropeR;
    u16 *H;
    u16 *Qn;
    u16 *Raw[2];
    u16 *Ks, *VsT, *Kw, *VwT;
    u16 *SZn;
    u16 *Qr, *Kr;
    u16 *KrT;
    u16 *VrT;
    u16 *SZr;
    u16 *Ma, *Mb;
    float* Gn;
    float* slab;
    u16 *Kc, *VcT;
    float* rowss;
    int use_cg; int probe;
};

DI void gemm128_main(const u16* a0, size_t a_r32, int astep, const u16* b0, size_t b_r32, int bstep, int nk,
                     u16* lds, f32x4 (&acc)[4][4]) {
    const int tid = TID(), lane = tid & 63, w = tid >> 6;
    const int wr = w >> 1, wc = w & 1, lr = lane & 15, q = lane >> 4;
    u32x4 ra[4], rb[4];
#pragma unroll
    for (int i = 0; i < 4; ++i) { ra[i] = ld16(a0 + i * a_r32); rb[i] = ld16(b0 + i * b_r32); }
    const int wofs = (tid >> 3) * LDT + (tid & 7) * 8;
#pragma unroll
    for (int i = 0; i < 4; ++i) {
        *(u32x4*)(lds + wofs + i * 32 * LDT) = ra[i];
        *(u32x4*)(lds + TILE_ELEMS + wofs + i * 32 * LDT) = rb[i];
    }
    __syncthreads();
    for (int kt = 0; kt < nk; ++kt) {
        const u16* As = lds + (kt & 1) * 2 * TILE_ELEMS;
        const u16* Bs = As + TILE_ELEMS;
        const bool more = (kt + 1 < nk);
        if (more) {
            a0 += astep; b0 += bstep;
#pragma unroll
            for (int i = 0; i < 4; ++i) { ra[i] = ld16(a0 + i * a_r32); rb[i] = ld16(b0 + i * b_r32); }
        }
#pragma unroll
        for (int ks = 0; ks < 2; ++ks) {
            bf16x8 af[4], bfr[4];
#pragma unroll
            for (int t = 0; t < 4; ++t) {
                af[t]  = ldf(As + (64 * wr + 16 * t + lr) * LDT + ks * 32 + q * 8);
                bfr[t] = ldf(Bs + (64 * wc + 16 * t + lr) * LDT + ks * 32 + q * 8);
            }
#pragma unroll
            for (int ti = 0; ti < 4; ++ti)
#pragma unroll
                for (int tj = 0; tj < 4; ++tj) acc[ti][tj] = MFMA16(af[ti], bfr[tj], acc[ti][tj]);
        }
        if (more) {
            u16* Aw = lds + ((kt + 1) & 1) * 2 * TILE_ELEMS;
#pragma unroll
            for (int i = 0; i < 4; ++i) {
                *(u32x4*)(Aw + wofs + i * 32 * LDT) = ra[i];
                *(u32x4*)(Aw + TILE_ELEMS + wofs + i * 32 * LDT) = rb[i];
            }
        }
        __syncthreads();
    }
}
DI void zero_acc(f32x4 (&acc)[4][4]) {
#pragma unroll
    for (int i = 0; i < 4; ++i)
#pragma unroll
        for (int j = 0; j < 4; ++j) acc[i][j] = f32x4{0.f, 0.f, 0.f, 0.f};
}
DI void stage_acc(float* cst, const f32x4 (&acc)[4][4]) {
    const int lane = TID() & 63, w = TID() >> 6;
    const int wr = w >> 1, wc = w & 1, lr = lane & 15, q = lane >> 4;
#pragma unroll
    for (int ti = 0; ti < 4; ++ti)
#pragma unroll
        for (int tj = 0; tj < 4; ++tj)
#pragma unroll
            for (int r = 0; r < 4; ++r)
                cst[(64 * wr + 16 * ti + 4 * q + r) * CST + 64 * wc + 16 * tj + lr] = acc[ti][tj][r];
}
template <typename F> DI void emit_rows(const float* cst, F f) {
#pragma unroll 2
    for (int i = 0; i < 8; ++i) {
        const int item = TID() + 256 * i, row = item >> 4, c8 = item & 15;
        const float4 a = *(const float4*)(cst + row * CST + c8 * 8);
        const float4 b = *(const float4*)(cst + row * CST + c8 * 8 + 4);
        float v[8] = {a.x, a.y, a.z, a.w, b.x, b.y, b.z, b.w};
        f(row, c8, v);
    }
}
template <typename F> DI void emit_cols(const float* cst, F f) {
#pragma unroll 2
    for (int i = 0; i < 8; ++i) {
        const int item = TID() + 256 * i, rest = item >> 6;
        const int col = (item & 15) + 16 * (rest & 7), r8 = ((item >> 4) & 3) + 4 * (rest >> 3);
        float v[8];
#pragma unroll
        for (int k = 0; k < 8; ++k) v[k] = cst[(r8 * 8 + k) * CST + col];
        f(col, r8, v);
    }
}

DI void transpose_tile(const float* src, int ldsrc, int k0, int n0, u16* dst, int lddst, int map_in, float* tl) {
    const int tid = TID();
    const int c = tid & 63;
    int oc = n0 + c;
    if (map_in) oc = (oc < 1280) ? oc : (oc < 6912 ? oc + 24 : (oc < 6936 ? oc - 6912 + 1280 : -1));
#pragma unroll
    for (int i = 0; i < 16; ++i) {
        const int r = (tid >> 6) + 4 * i;
        tl[r * 65 + c] = (oc >= 0) ? src[(size_t)(k0 + r) * ldsrc + oc] : 0.f;
    }
    __syncthreads();
    const int nl = tid >> 2, kc = (tid & 3) * 16;
    float v[16];
#pragma unroll
    for (int i = 0; i < 16; ++i) v[i] = tl[(kc + i) * 65 + nl];
    u16* d = dst + (size_t)(n0 + nl) * lddst + k0 + kc;
    *(u32x4*)d = pack8(v);
    *(u32x4*)(d + 8) = pack8(v + 8);
    __syncthreads();
}

DI void p0_unit(const Params& p, int u, unsigned char* smem) {
    const int tid = TID(), lane = tid & 63, w = tid >> 6;
    float* tl = (float*)smem;
    if (u < 2664) {
        int t = u;
        if (t < 1760) { transpose_tile(p.w_in, 6936, (t & 15) * 64, (t >> 4) * 64, p.WinT, 1024, 1, tl); return; }
        t -= 1760;
        if (t < 128) { transpose_tile(p.w_nsa_o, 1024, (t & 7) * 64, (t >> 3) * 64, p.WnoT, 512, 0, tl); return; }
        t -= 128;
        if (t < 256) { transpose_tile(p.w_ret_o, 1024, (t & 15) * 64, (t >> 4) * 64, p.WroT, 1024, 0, tl); return; }
        t -= 256;
        if (t < 256) { transpose_tile(p.w_out, 1024, (t & 15) * 64, (t >> 4) * 64, p.WoutT, 1024, 0, tl); return; }
        t -= 256;
        if (t < 128) { transpose_tile(p.w1_k, 256, (t & 31) * 64, (t >> 5) * 64, p.W1T[0], 2048, 0, tl); return; }
        t -= 128;
        if (t < 128) { transpose_tile(p.w1_v, 256, (t & 31) * 64, (t >> 5) * 64, p.W1T[1], 2048, 0, tl); return; }
        t -= 128;
        if (t < 4) { transpose_tile(p.w2_k, 64, t * 64, 0, p.W2T[0], 256, 0, tl); return; }
        t -= 4;
        transpose_tile(p.w2_v, 64, t * 64, 0, p.W2T[1], 256, 0, tl);
        return;
    }
    u -= 2664;
    if (u < 4096) {
        const int row = u * 4 + w;
        const float* xr = p.x + (size_t)row * 1024;
        float4 v[4]; float ss = 0.f;
#pragma unroll
        for (int i = 0; i < 4; ++i) { v[i] = *(const float4*)(xr + lane * 4 + 256 * i); ss += v[i].x * v[i].x + v[i].y * v[i].y + v[i].z * v[i].z + v[i].w * v[i].w; }
        ss = wave_sum(ss);
        const float rs = rsqrtf(ss * (1.f / 1024.f) + 1e-6f);
#pragma unroll
        for (int i = 0; i < 4; ++i) {
            const float4 g = *(const float4*)(p.norm_pre + lane * 4 + 256 * i);
            u32x2 o; o[0] = pack2(v[i].x * rs * g.x, v[i].y * rs * g.y); o[1] = pack2(v[i].z * rs * g.z, v[i].w * rs * g.w);
            *(u32x2*)(p.H + (size_t)row * 1024 + lane * 4 + 256 * i) = o;
        }
        return;
    }
    u -= 4096;
    if (u < 4096) {
        const int e = u * 256 + tid, pos = e >> 6, i = e & 63;
        const float inv = 1.0f / powf(10000.0f, (float)i / 63.0f);
        const float ang = (float)pos * inv;
        float sn, cs; sincosf(ang, &sn, &cs);
        p.ropeR[e] = make_float2(cs, sn);
        return;
    }
    u -= 4096;
    if (u < 512) {
        const int e = u * 256 + tid, pos = e >> 3, i = e & 7;
        const float inv = 1.0f / powf(500000.0f, (float)(2 * i) / 16.0f);
        const float ang = (float)pos * inv;
        float sn, cs; sincosf(ang, &sn, &cs);
        p.ropeN[e] = make_float2(cs, sn);
        return;
    }
    u -= 512;
    {
        const int kv = u >> 4, ch = u & 15;
        const float* pe = kv ? p.pe_v : p.pe_k;
        const float* w1 = kv ? p.w1_v : p.w1_k;
        float s = 0.f;
        for (int k = ch * 128; k < ch * 128 + 128; ++k) s += pe[k] * w1[(size_t)k * 256 + tid];
        p.bpart[(kv * 16 + ch) * 256 + tid] = s;
    }
}
constexpr int P0_UNITS = 2664 + 4096 + 4096 + 512 + 32;

DI void p1_tile(const Params& p, int t, unsigned char* smem) {
    const int tid = TID();
    const int nt = t >> 7, mt = t & 127, tok0 = mt * 128;
    u16* lds = (u16*)smem; float* cst = (float*)smem;
    f32x4 acc[4][4]; zero_acc(acc);
    gemm128_main(p.H + (size_t)(tok0 + (tid >> 3)) * 1024 + (tid & 7) * 8, (size_t)32 * 1024, 64,
                 p.WinT + (size_t)(nt * 128 + (tid >> 3)) * 1024 + (tid & 7) * 8, (size_t)32 * 1024, 64, 16, lds, acc);
    stage_acc(cst, acc);
    __syncthreads();
    if (nt <= 4 || nt == 6 || nt == 8) {
#pragma unroll 2
        for (int i = 0; i < 8; ++i) {
            const int item = tid + 256 * i, row = item >> 4, hh = (item >> 3) & 1, ii = item & 7;
            float* px = cst + row * CST + hh * 64 + ii;
            const float x1 = px[0], x2 = px[8];
            const float2 cs = p.ropeN[(size_t)(tok0 + row) * 8 + ii];
            px[0] = x1 * cs.x - x2 * cs.y; px[8] = x2 * cs.x + x1 * cs.y;
        }
        __syncthreads();
    } else if (nt >= 14 && nt <= 21) {
        const float sc = (nt >= 18) ? 0.08838834764831845f : 1.0f;
#pragma unroll 2
        for (int i = 0; i < 32; ++i) {
            const int item = tid + 256 * i, row = item >> 6, ii = item & 63;
            float* px = cst + row * CST + ii;
            const float x1 = px[0], x2 = px[64];
            const float2 cs = p.ropeR[(size_t)(tok0 + row) * 64 + ii];
            px[0] = (x1 * cs.x - x2 * cs.y) * sc; px[64] = (x2 * cs.x + x1 * cs.y) * sc;
        }
        __syncthreads();
    }
    if (nt <= 3) {
        emit_rows(cst, [&](int row, int c8, const float* v) { *(u32x4*)(p.Qn + (size_t)(tok0 + row) * 512 + nt * 128 + c8 * 8) = pack8(v); });
    } else if (nt == 4 || nt == 5) {
        u16* dst = (nt == 4) ? p.Raw[0] : p.Raw[1];
        emit_rows(cst, [&](int row, int c8, const float* v) { *(u32x4*)(dst + (size_t)(tok0 + row) * 128 + c8 * 8) = pack8(v); });
    } else if (nt == 6 || nt == 8) {
        u16* dst = (nt == 6) ? p.Ks : p.Kw;
        emit_rows(cst, [&](int row, int c8, const float* v) { *(u32x4*)(dst + ((size_t)(c8 >> 3) * S_ + tok0 + row) * 64 + (c8 & 7) * 8) = pack8(v); });
    } else if (nt == 7 || nt == 9) {
        u16* dst = (nt == 7) ? p.VsT : p.VwT;
        emit_cols(cst, [&](int col, int r8, const float* v) {
            const int g = col >> 6, d = col & 63, tk = tok0 + r8 * 8;
            *(u32x4*)(dst + (((size_t)g * 256 + (tk >> 6)) * 64 + d) * 64 + (tk & 63)) = pack8(v); });
    } else if (nt <= 13) {
        emit_rows(cst, [&](int row, int c8, const float* v) {
            float o[8];
#pragma unroll
            for (int k = 0; k < 8; ++k) o[k] = v[k] * sigmoidf_(v[k]);
            *(u32x4*)(p.SZn + (size_t)(tok0 + row) * 512 + (nt - 10) * 128 + c8 * 8) = pack8(o); });
    } else if (nt <= 17) {
        const int h = nt - 14;
        emit_rows(cst, [&](int row, int c8, const float* v) { *(u32x4*)(p.Qr + ((size_t)h * S_ + tok0 + row) * 128 + c8 * 8) = pack8(v); });
    } else if (nt <= 21) {
        const int h = nt - 18;
        emit_rows(cst, [&](int row, int c8, const float* v) { *(u32x4*)(p.Kr + ((size_t)h * S_ + tok0 + row) * 128 + c8 * 8) = pack8(v); });
        const float lg = logf(1.0f - exp2f(-5.0f - (float)h));
        emit_cols(cst, [&](int col, int r8, const float* v) {
            float o[8];
#pragma unroll
            for (int k = 0; k < 8; ++k) o[k] = v[k] * __expf((float)(127 - (r8 * 8 + k)) * lg);
            *(u32x4*)(p.KrT + (((size_t)h * 128 + mt) * 128 + col) * 128 + r8 * 8) = pack8(o); });
    } else if (nt <= 29) {
        const int h = (nt - 22) >> 1, e0 = ((nt - 22) & 1) * 128;
        emit_cols(cst, [&](int col, int r8, const float* v) {
            *(u32x4*)(p.VrT + (((size_t)h * 128 + mt) * 256 + e0 + col) * 128 + r8 * 8) = pack8(v); });
    } else if (nt <= 37) {
        emit_rows(cst, [&](int row, int c8, const float* v) {
            float o[8];
#pragma unroll
            for (int k = 0; k < 8; ++k) o[k] = v[k] * sigmoidf_(v[k]);
            *(u32x4*)(p.SZr + (size_t)(tok0 + row) * 1024 + (nt - 30) * 128 + c8 * 8) = pack8(o); });
    } else if (nt <= 53) {
        u16* dst = (nt <= 45) ? p.Ma : p.Mb;
        const int c0 = ((nt <= 45) ? (nt - 38) : (nt - 46)) * 128;
        emit_rows(cst, [&](int row, int c8, const float* v) {
            float o[8];
#pragma unroll
            for (int k = 0; k < 8; ++k) o[k] = sigmoidf_(v[k]);
            *(u32x4*)(dst + (size_t)(tok0 + row) * 1024 + c0 + c8 * 8) = pack8(o); });
    } else {
#pragma unroll 2
        for (int i = 0; i < 12; ++i) {
            const int item = tid + 256 * i, row = item / 24, c = item - row * 24;
            p.Gn[(size_t)(tok0 + row) * 24 + c] = sigmoidf_(cst[row * CST + c] + p.b_gate[c]);
        }
    }
    __syncthreads();
}

DI void p2_unit(const Params& p, int u, unsigned char* smem) {
    const int tid = TID(), lane = tid & 63, w = tid >> 6;
    u16* lds = (u16*)smem; float* cst = (float*)smem;
    f32x4 acc[4][4]; zero_acc(acc);
    if (u < 256) {
        const int nt = u & 1, mt = (u >> 1) & 15, ks = (u >> 5) & 3, kv = u >> 7;
        const int R = mt * 128 + (tid >> 3), c = R >> 1, g = R & 1;
        const u16* a0 = (kv ? p.Raw[1] : p.Raw[0]) + (size_t)(16 * c + ks * 8) * 128 + g * 64 + (tid & 7) * 8;
        const u16* b0 = (kv ? p.W1T[1] : p.W1T[0]) + (size_t)(nt * 128 + (tid >> 3)) * 2048 + ks * 512 + (tid & 7) * 8;
        gemm128_main(a0, (size_t)16 * 16 * 128, 128, b0, (size_t)32 * 2048, 64, 8, lds, acc);
        const int wr = w >> 1, wc = w & 1, lr = lane & 15, q = lane >> 4;
        float* dst = p.slab + ((size_t)(ks * 2 + kv) * 2048 + mt * 128) * 256 + nt * 128;
#pragma unroll
        for (int ti = 0; ti < 4; ++ti)
#pragma unroll
            for (int tj = 0; tj < 4; ++tj)
#pragma unroll
                for (int r = 0; r < 4; ++r)
                    dst[(size_t)(64 * wr + 16 * ti + 4 * q + r) * 256 + 64 * wc + 16 * tj + lr] = acc[ti][tj][r];
        return;
    }
    const int v = u - 256, half = v & 1, ch = v >> 1, n = ch >> 2, h = ch & 3;
    const u16* a0 = p.VrT + (((size_t)h * 128 + n) * 256 + half * 128 + (tid >> 3)) * 128 + (tid & 7) * 8;
    const u16* b0 = p.KrT + (((size_t)h * 128 + n) * 128 + (tid >> 3)) * 128 + (tid & 7) * 8;
    gemm128_main(a0, (size_t)32 * 128, 64, b0, (size_t)32 * 128, 64, 2, lds, acc);
    stage_acc(cst, acc);
    __syncthreads();
    u16* dst = p.H + (((size_t)n * 4 + h) * 256 + half * 128) * 128;
    emit_rows(cst, [&](int row, int c8, const float* vv) { *(u32x4*)(dst + (size_t)row * 128 + c8 * 8) = pack8(vv); });
    __syncthreads();
}
constexpr int P2_UNITS = 256 + 1024;

DI float gelu_tanh(float x) {
    const float u = 0.7978845608028654f * (x + 0.044715f * x * x * x);
    const float t = 1.f - 2.f / (1.f + __expf(2.f * u));
    return 0.5f * x * (1.f + t);
}
DI void p3_unit(const Params& p, int u, unsigned char* smem) {
    const int tid = TID(), lane = tid & 63, w = tid >> 6;
    const int v = u, kv = v & 1, rt = v >> 1;
    float* bias = (float*)smem;
    {
        float s = 0.f;
#pragma unroll
        for (int i = 0; i < 16; ++i) s += p.bpart[(kv * 16 + i) * 256 + tid];
        bias[tid] = s;
    }
    __syncthreads();
    const int lr = lane & 15, q = lane >> 4;
    const int R = rt * 16 + lr;
    f32x4 acc = {0.f, 0.f, 0.f, 0.f};
#pragma unroll
    for (int ks = 0; ks < 8; ++ks) {
        const int k0 = ks * 32 + q * 8;
        float hv[8];
#pragma unroll
        for (int k = 0; k < 8; ++k) hv[k] = bias[k0 + k];
#pragma unroll
        for (int s = 0; s < 4; ++s) {
            const float* sp = p.slab + ((size_t)(s * 2 + kv) * 2048 + R) * 256 + k0;
            const float4 a = *(const float4*)sp, b = *(const float4*)(sp + 4);
            hv[0] += a.x; hv[1] += a.y; hv[2] += a.z; hv[3] += a.w; hv[4] += b.x; hv[5] += b.y; hv[6] += b.z; hv[7] += b.w;
        }
#pragma unroll
        for (int k = 0; k < 8; ++k) hv[k] = gelu_tanh(hv[k]);
        const bf16x8 af = __builtin_bit_cast(bf16x8, pack8(hv));
        const bf16x8 bfr = ldf((kv ? p.W2T[1] : p.W2T[0]) + (size_t)(16 * w + lr) * 256 + k0);
        acc = MFMA16(af, bfr, acc);
    }
    const int d = 16 * w + lr;
#pragma unroll
    for (int r = 0; r < 4; ++r) {
        const int Ro = rt * 16 + 4 * q + r, c = Ro >> 1, g = Ro & 1;
        const float val = (c < 1023) ? acc[r] : 0.f;
        const u16 bv = (u16)(pack2(val, 0.f) & 0xffffu);
        if (kv == 0) p.Kc[((size_t)g * 1024 + c) * 64 + d] = bv;
        else p.VcT[(((size_t)g * 16 + (c >> 6)) * 64 + d) * 64 + (c & 63)] = bv;
    }
    __syncthreads();
}
constexpr int P3_UNITS = 256;
DI void p3_scan(const Params& p) {
    for (int idx = blockIdx.x * 256 + TID(); idx < 131072; idx += gridDim.x * 256) {
        const int h = idx >> 15;
        const float dec = __expf(128.0f * logf(1.0f - exp2f(-5.0f - (float)h)));
        u16* base = p.H + idx;
        float r0 = 0.f;
#pragma unroll 16
        for (int n = 0; n < 128; ++n) {
            u16* pp = base + (size_t)n * 131072;
            const float kv = __uint_as_float((unsigned)(*pp) << 16);
            *pp = (u16)(pack2(r0, 0.f) & 0xffffu);
            r0 = dec * r0 + kv;
        }
    }
}

constexpr int IMPS = 260;
DI void nsa_load_tile(const u16* src, u32x4 (&r)[2]) {
    r[0] = ld16(src + TID() * 8); r[1] = ld16(src + (TID() + 256) * 8);
}
DI void nsa_store_tile(u16* dst, const u32x4 (&r)[2]) {
    const int c0 = TID(), c1 = TID() + 256;
    *(u32x4*)(dst + (c0 >> 3) * LDT + (c0 & 7) * 8) = r[0];
    *(u32x4*)(dst + (c1 >> 3) * LDT + (c1 & 7) * 8) = r[1];
}
DI void nsa_scores(const u16* Kt, const bf16x8 (&qf)[2][2], f32x4 (&s)[4][2]) {
    const int lane = TID() & 63, lr = lane & 15, q = lane >> 4;
#pragma unroll
    for (int kt = 0; kt < 4; ++kt) {
        const int krow = 32 * (kt >> 1) + 8 * (lr >> 2) + 4 * (kt & 1) + (lr & 3);
        s[kt][0] = f32x4{0.f, 0.f, 0.f, 0.f}; s[kt][1] = f32x4{0.f, 0.f, 0.f, 0.f};
#pragma unroll
        for (int ks = 0; ks < 2; ++ks) {
            const bf16x8 kf = ldf(Kt + krow * LDT + ks * 32 + q * 8);
            s[kt][0] = MFMA16(kf, qf[0][ks], s[kt][0]);
            s[kt][1] = MFMA16(kf, qf[1][ks], s[kt][1]);
        }
    }
}
DI void nsa_pv(const u16* Vt, const f32x4 (&s)[4][2], f32x4 (&o)[4][2]) {
    const int lane = TID() & 63, lr = lane & 15, q = lane >> 4;
#pragma unroll
    for (int ks2 = 0; ks2 < 2; ++ks2) {
        const bf16x8 pb0 = packf(s[2 * ks2][0], s[2 * ks2 + 1][0]);
        const bf16x8 pb1 = packf(s[2 * ks2][1], s[2 * ks2 + 1][1]);
#pragma unroll
        for (int dt = 0; dt < 4; ++dt) {
            const bf16x8 vf = ldf(Vt + (16 * dt + lr) * LDT + ks2 * 32 + q * 8);
            o[dt][0] = MFMA16(vf, pb0, o[dt][0]);
            o[dt][1] = MFMA16(vf, pb1, o[dt][1]);
        }
    }
}

DI void nsa_item(const Params& p, int tb, int g, unsigned char* smem) {
    u16* Kt = (u16*)smem;
    u16* Vt = Kt + 64 * LDT;
    float* imp = (float*)(smem + 2 * 64 * LDT * 2);
    int* sel = (int*)(imp + 32 * IMPS);
    const int tid = TID(), lane = tid & 63, w = tid >> 6, lr = lane & 15, q = lane >> 4;
    const int t0 = tb * 32, cur = t0 >> 6;
    const float SC = 0.125f * LOG2E;
    const float NEG = -1e30f;

    bf16x8 qf[2][2];
    int tokL[2]; float gc[2], gs[2], gw[2];
#pragma unroll
    for (int rt = 0; rt < 2; ++rt) {
        tokL[rt] = t0 + 8 * w + 4 * rt + (lr >> 2);
        const int head = 4 * g + (lr & 3);
#pragma unroll
        for (int ks = 0; ks < 2; ++ks) qf[rt][ks] = ldf(p.Qn + (size_t)tokL[rt] * 512 + head * 64 + 32 * ks + 8 * q);
        const float* gp = p.Gn + (size_t)tokL[rt] * 24 + head * 3;
        gc[rt] = gp[0]; gs[rt] = gp[1]; gw[rt] = gp[2];
    }
    f32x4 tot[4][2];
#pragma unroll
    for (int dt = 0; dt < 4; ++dt) { tot[dt][0] = f32x4{0.f, 0.f, 0.f, 0.f}; tot[dt][1] = f32x4{0.f, 0.f, 0.f, 0.f}; }

    for (int rep = (MK_PROBE & 256) ? 0 : 1; rep < 2; ++rep) {
        float m[2] = {NEG, NEG}, l[2] = {0.f, 0.f};
        f32x4 o[4][2];
#pragma unroll
        for (int dt = 0; dt < 4; ++dt) { o[dt][0] = f32x4{0.f, 0.f, 0.f, 0.f}; o[dt][1] = f32x4{0.f, 0.f, 0.f, 0.f}; }
        const int kb_lo = (t0 > 511 ? t0 - 511 : 0) >> 6, kb_hi = cur;
        u32x4 rk[2], rv[2];
        nsa_load_tile(p.Kw + ((size_t)g * S_ + kb_lo * 64) * 64, rk);
        nsa_load_tile(p.VwT + ((size_t)g * 256 + kb_lo) * 4096, rv);
        for (int kb = kb_lo; kb <= kb_hi; ++kb) {
            __syncthreads();
            nsa_store_tile(Kt, rk); nsa_store_tile(Vt, rv);
            __syncthreads();
            if (kb < kb_hi) {
                nsa_load_tile(p.Kw + ((size_t)g * S_ + (kb + 1) * 64) * 64, rk);
                nsa_load_tile(p.VwT + ((size_t)g * 256 + kb + 1) * 4096, rv);
            }
            f32x4 s[4][2];
            nsa_scores(Kt, qf, s);
#pragma unroll
            for (int rt = 0; rt < 2; ++rt) {
                const int t = tokL[rt];
                float mx = NEG;
#pragma unroll
                for (int kt = 0; kt < 4; ++kt)
#pragma unroll
                    for (int r = 0; r < 4; ++r) {
                        const int key = kb * 64 + 32 * (kt >> 1) + 8 * q + 4 * (kt & 1) + r;
                        const bool ok = (key <= t) && (key > t - 512);
                        const float v = ok ? s[kt][rt][r] * SC : NEG;
                        s[kt][rt][r] = v; mx = fmaxf(mx, v);
                    }
                mx = fmaxf(mx, __shfl_xor(mx, 16)); mx = fmaxf(mx, __shfl_xor(mx, 32));
                const float mn = fmaxf(m[rt], mx), alpha = exp2f(m[rt] - mn);
                float rs = 0.f;
#pragma unroll
                for (int kt = 0; kt < 4; ++kt)
#pragma unroll
                    for (int r = 0; r < 4; ++r) {
                        const float v = s[kt][rt][r];
                        const float pv = (v > -1e29f) ? exp2f(v - mn) : 0.f;
                        s[kt][rt][r] = pv; rs += pv;
                    }
                l[rt] = l[rt] * alpha + rs; m[rt] = mn;
#pragma unroll
                for (int dt = 0; dt < 4; ++dt) o[dt][rt] *= alpha;
            }
            nsa_pv(Vt, s, o);
        }
#pragma unroll
        for (int rt = 0; rt < 2; ++rt) {
            float lt = l[rt]; lt += __shfl_xor(lt, 16); lt += __shfl_xor(lt, 32);
            const float f = (rep == 1) ? gw[rt] / fmaxf(lt, 1e-37f) : 0.f;
#pragma unroll
            for (int dt = 0; dt < 4; ++dt) tot[dt][rt] += o[dt][rt] * f;
        }
    }

    for (int rep = (MK_PROBE & 512) ? 0 : 1; rep < 2; ++rep) {
        const int nct = ((t0 >> 4) >> 6) + 1;
        int cmaxv[2]; cmaxv[0] = (tokL[0] - 31) >> 4; cmaxv[1] = (tokL[1] - 31) >> 4;
        float m[2] = {NEG, NEG}, l[2] = {0.f, 0.f};
        u32x4 rk[2], rv[2];
        nsa_load_tile(p.Kc + ((size_t)g * 1024) * 64, rk);
        for (int ct = 0; ct < nct; ++ct) {
            __syncthreads();
            nsa_store_tile(Kt, rk);
            __syncthreads();
            if (ct + 1 < nct) nsa_load_tile(p.Kc + ((size_t)g * 1024 + (ct + 1) * 64) * 64, rk);
            f32x4 s[4][2];
            nsa_scores(Kt, qf, s);
#pragma unroll
            for (int rt = 0; rt < 2; ++rt) {
                float mx = NEG;
#pragma unroll
                for (int kt = 0; kt < 4; ++kt)
#pragma unroll
                    for (int r = 0; r < 4; ++r) {
                        const int c = ct * 64 + 32 * (kt >> 1) + 8 * q + 4 * (kt & 1) + r;
                        const float v = (c <= cmaxv[rt]) ? s[kt][rt][r] * SC : NEG;
                        s[kt][rt][r] = v; mx = fmaxf(mx, v);
                    }
                mx = fmaxf(mx, __shfl_xor(mx, 16)); mx = fmaxf(mx, __shfl_xor(mx, 32));
                const float mn = fmaxf(m[rt], mx), alpha = exp2f(m[rt] - mn);
                float rs = 0.f;
#pragma unroll
                for (int kt = 0; kt < 4; ++kt)
#pragma unroll
                    for (int r = 0; r < 4; ++r) { const float v = s[kt][rt][r]; rs += (v > -1e29f) ? exp2f(v - mn) : 0.f; }
                l[rt] = l[rt] * alpha + rs; m[rt] = mn;
            }
        }
        float linv[2];
#pragma unroll
        for (int rt = 0; rt < 2; ++rt) {
            float lt = l[rt]; lt += __shfl_xor(lt, 16); lt += __shfl_xor(lt, 32);
            linv[rt] = 1.f / fmaxf(lt, 1e-37f);
        }
        f32x4 o[4][2];
#pragma unroll
        for (int dt = 0; dt < 4; ++dt) { o[dt][0] = f32x4{0.f, 0.f, 0.f, 0.f}; o[dt][1] = f32x4{0.f, 0.f, 0.f, 0.f}; }
        float carry[2] = {0.f, 0.f};
        nsa_load_tile(p.Kc + ((size_t)g * 1024) * 64, rk);
        nsa_load_tile(p.VcT + ((size_t)g * 16) * 4096, rv);
        for (int ct = 0; ct < nct; ++ct) {
            __syncthreads();
            nsa_store_tile(Kt, rk); nsa_store_tile(Vt, rv);
            __syncthreads();
            if (ct + 1 < nct) {
                nsa_load_tile(p.Kc + ((size_t)g * 1024 + (ct + 1) * 64) * 64, rk);
                nsa_load_tile(p.VcT + ((size_t)g * 16 + ct + 1) * 4096, rv);
            }
            f32x4 s[4][2];
            nsa_scores(Kt, qf, s);
#pragma unroll
            for (int rt = 0; rt < 2; ++rt) {
#pragma unroll
                for (int kt = 0; kt < 4; ++kt)
#pragma unroll
                    for (int r = 0; r < 4; ++r) {
                        const int c = ct * 64 + 32 * (kt >> 1) + 8 * q + 4 * (kt & 1) + r;
                        s[kt][rt][r] = (c <= cmaxv[rt]) ? exp2f(s[kt][rt][r] * SC - m[rt]) * linv[rt] : 0.f;
                    }
                const float up1 = __shfl_up(s[1][rt][3], 16), up3 = __shfl_up(s[3][rt][3], 16);
                const float w1 = __shfl(s[1][rt][3], lr + 48), w3 = __shfl(s[3][rt][3], lr + 48);
                float e[4];
                e[0] = s[0][rt][0] + s[0][rt][1] + s[0][rt][2] + s[0][rt][3] + (q > 0 ? up1 : carry[rt]);
                e[1] = s[1][rt][0] + s[1][rt][1] + s[1][rt][2] + s[1][rt][3] + s[0][rt][3];
                e[2] = s[2][rt][0] + s[2][rt][1] + s[2][rt][2] + s[2][rt][3] + (q > 0 ? up3 : w1);
                e[3] = s[3][rt][0] + s[3][rt][1] + s[3][rt][2] + s[3][rt][3] + s[2][rt][3];
                carry[rt] = w3;
#pragma unroll
                for (int kt = 0; kt < 4; ++kt) {
                    float ev = e[kt];
                    ev += __shfl_xor(ev, 1); ev += __shfl_xor(ev, 2);
                    if ((lr & 3) == 0) imp[(8 * w + 4 * rt + (lr >> 2)) * IMPS + ct * 16 + 8 * (kt >> 1) + 2 * q + (kt & 1)] = ev;
                }
            }
            nsa_pv(Vt, s, o);
        }
#pragma unroll
        for (int rt = 0; rt < 2; ++rt)
#pragma unroll
            for (int dt = 0; dt < 4; ++dt) tot[dt][rt] += o[dt][rt] * ((rep == 1) ? gc[rt] : 0.f);
    }
    __syncthreads();

    for (int rep = (MK_PROBE & 1024) ? 0 : 1; rep < 2; ++rep)
    for (int tk = 0; tk < 8; ++tk) {
        const int tl = 8 * w + tk;
        float v[4];
#pragma unroll
        for (int i = 0; i < 4; ++i) {
            const int j = lane + 64 * i;
            const bool cand = (j <= cur) && (j != 0) && (j != cur) && (j != cur - 1);
            v[i] = cand ? imp[tl * IMPS + j] : -1.f;
        }
        int selv = -1;
        if (lane == 0) selv = 0;
        if (cur > 0 && lane == 1) selv = cur;
        if (cur > 1 && lane == 2) selv = cur - 1;
        const int nforced = 1 + (cur > 0 ? 1 : 0) + (cur > 1 ? 1 : 0);
        for (int it = nforced; it < 16; ++it) {
            const float lm = fmaxf(fmaxf(v[0], v[1]), fmaxf(v[2], v[3]));
            const float wm = wave_max(lm);
            if (wm < 0.f) break;
            int jstar;
            const unsigned long long b0 = __ballot(v[0] == wm);
            if (b0) { const int ow = __builtin_ctzll(b0); jstar = ow; if (lane == ow) v[0] = -1.f; }
            else {
                const unsigned long long b1 = __ballot(v[1] == wm);
                if (b1) { const int ow = __builtin_ctzll(b1); jstar = ow + 64; if (lane == ow) v[1] = -1.f; }
                else {
                    const unsigned long long b2 = __ballot(v[2] == wm);
                    if (b2) { const int ow = __builtin_ctzll(b2); jstar = ow + 128; if (lane == ow) v[2] = -1.f; }
                    else { const unsigned long long b3 = __ballot(v[3] == wm); if (!b3) break; const int ow = __builtin_ctzll(b3); jstar = ow + 192; if (lane == ow) v[3] = -1.f; }
                }
            }
            if (lane == it) selv = jstar;
        }
        if (lane < 16) sel[tl * 16 + lane] = selv;
    }
    __syncthreads();

    {
        unsigned* bmask = (unsigned*)(sel + 32 * 16);
        int* blist = (int*)(bmask + 256);
        bmask[tid] = 0u;
        __syncthreads();
        for (int e = tid; e < 512; e += 256) { const int j = sel[e]; if (j >= 0) atomicOr(&bmask[j], 1u << (e >> 4)); }
        __syncthreads();
        if (w == 0) {
            int base = 0;
#pragma unroll
            for (int i = 0; i < 4; ++i) {
                const int j = lane + 64 * i;
                const bool nz = bmask[j] != 0u;
                const unsigned long long b = __ballot(nz);
                const int pre = __builtin_popcountll(b & ((1ull << lane) - 1ull));
                if (nz) blist[base + pre] = j;
                base += __builtin_popcountll(b);
            }
            if (lane == 0) blist[256] = base;
        }
        __syncthreads();
        const int nl = blist[256];
        u16* Kb0 = Kt;            u16* Vb0 = Vt;
        u16* Kb1 = (u16*)imp;     u16* Vb1 = Kb1 + 64 * LDT;
        float m[2] = {NEG, NEG}, l[2] = {0.f, 0.f};
        f32x4 o[4][2];
#pragma unroll
        for (int dt = 0; dt < 4; ++dt) { o[dt][0] = f32x4{0.f, 0.f, 0.f, 0.f}; o[dt][1] = f32x4{0.f, 0.f, 0.f, 0.f}; }
        u32x4 rkA[2], rvA[2], rkB[2], rvB[2];
        auto gload = [&](int idx, u32x4 (&rk)[2], u32x4 (&rv)[2]) {
            const int j = blist[idx];
            nsa_load_tile(p.Ks + ((size_t)g * S_ + (size_t)j * 64) * 64, rk);
            nsa_load_tile(p.VsT + ((size_t)g * 256 + j) * 4096, rv);
        };
        auto sel_rt = [&](auto RT, const u16* Kb, const u16* Vb, int j, unsigned mk) {
            constexpr int rt = decltype(RT)::value;
            f32x4 s[4];
#pragma unroll
            for (int kt = 0; kt < 4; ++kt) {
                const int krow = 32 * (kt >> 1) + 8 * (lr >> 2) + 4 * (kt & 1) + (lr & 3);
                s[kt] = f32x4{0.f, 0.f, 0.f, 0.f};
#pragma unroll
                for (int ks = 0; ks < 2; ++ks) s[kt] = MFMA16(ldf(Kb + krow * LDT + ks * 32 + q * 8), qf[rt][ks], s[kt]);
            }
            const bool mine = ((mk >> (8 * w + 4 * rt + (lr >> 2))) & 1u) != 0u;
            float mx = NEG;
            if (j == cur) {
                const int dlim = mine ? (tokL[rt] - j * 64 - 8 * q) : -1;
#pragma unroll
                for (int kt = 0; kt < 4; ++kt)
#pragma unroll
                    for (int r = 0; r < 4; ++r) {
                        const float v = (32 * (kt >> 1) + 4 * (kt & 1) + r <= dlim) ? s[kt][r] * SC : NEG;
                        s[kt][r] = v; mx = fmaxf(mx, v);
                    }
                mx = fmaxf(mx, __shfl_xor(mx, 16)); mx = fmaxf(mx, __shfl_xor(mx, 32));
                const float mn = fmaxf(m[rt], mx), alpha = exp2f(m[rt] - mn);
                float rs = 0.f;
#pragma unroll
                for (int kt = 0; kt < 4; ++kt)
#pragma unroll
                    for (int r = 0; r < 4; ++r) {
                        const float v = s[kt][r];
                        const float pv = (v > -1e29f) ? exp2f(v - mn) : 0.f;
                        s[kt][r] = pv; rs += pv;
                    }
                l[rt] = l[rt] * alpha + rs; m[rt] = mn;
#pragma unroll
                for (int dt = 0; dt < 4; ++dt) o[dt][rt] *= alpha;
            } else {
#pragma unroll
                for (int kt = 0; kt < 4; ++kt) mx = fmaxf(fmaxf(mx, fmaxf(s[kt][0], s[kt][1])), fmaxf(s[kt][2], s[kt][3]));
                mx = mine ? mx * SC : NEG;
                mx = fmaxf(mx, __shfl_xor(mx, 16)); mx = fmaxf(mx, __shfl_xor(mx, 32));
                const float mn = fmaxf(m[rt], mx), alpha = exp2f(m[rt] - mn);
                const float nb = mine ? -mn : NEG;
                float rs = 0.f;
#pragma unroll
                for (int kt = 0; kt < 4; ++kt)
#pragma unroll
                    for (int r = 0; r < 4; ++r) { const float pv = exp2f(fmaf(s[kt][r], SC, nb)); s[kt][r] = pv; rs += pv; }
                l[rt] = l[rt] * alpha + rs; m[rt] = mn;
#pragma unroll
                for (int dt = 0; dt < 4; ++dt) o[dt][rt] *= alpha;
            }
#pragma unroll
            for (int ks2 = 0; ks2 < 2; ++ks2) {
                const bf16x8 pb = packf(s[2 * ks2], s[2 * ks2 + 1]);
#pragma unroll
                for (int dt = 0; dt < 4; ++dt) o[dt][rt] = MFMA16(ldf(Vb + (16 * dt + lr) * LDT + ks2 * 32 + q * 8), pb, o[dt][rt]);
            }
        };
        auto compute = [&](const u16* Kb, const u16* Vb, int j) {
            const unsigned mk = bmask[j];
            const unsigned wb = (mk >> (8 * w)) & 0xffu;
            if (wb & 0x0fu) sel_rt(IC<0>{}, Kb, Vb, j, mk);
            if (wb & 0xf0u) sel_rt(IC<1>{}, Kb, Vb, j, mk);
        };
        gload(0, rkA, rvA);
        nsa_store_tile(Kb0, rkA); nsa_store_tile(Vb0, rvA);
        if (nl > 1) gload(1, rkB, rvB);
        __syncthreads();
        for (int i = 0; i < nl; i += 2) {
            if (i + 2 < nl) gload(i + 2, rkA, rvA);
            compute(Kb0, Vb0, blist[i]);
            if (i + 1 < nl) { nsa_store_tile(Kb1, rkB); nsa_store_tile(Vb1, rvB); }
            __syncthreads();
            if (i + 1 >= nl) break;
            if (i + 3 < nl) gload(i + 3, rkB, rvB);
            compute(Kb1, Vb1, blist[i + 1]);
            if (i + 2 < nl) { nsa_store_tile(Kb0, rkA); nsa_store_tile(Vb0, rvA); }
            __syncthreads();
        }
#pragma unroll
        for (int rt = 0; rt < 2; ++rt) {
            float lt = l[rt]; lt += __shfl_xor(lt, 16); lt += __shfl_xor(lt, 32);
            const float f = gs[rt] / fmaxf(lt, 1e-37f);
#pragma unroll
            for (int dt = 0; dt < 4; ++dt) tot[dt][rt] += o[dt][rt] * f;
        }
    }

#pragma unroll
    for (int rt = 0; rt < 2; ++rt) {
        const int head = 4 * g + (lr & 3);
#pragma unroll
        for (int dt = 0; dt < 4; ++dt) {
            const size_t off = (size_t)tokL[rt] * 512 + head * 64 + 16 * dt + 4 * q;
            const u32x2 z = *(const u32x2*)(p.SZn + off);
            u32x2 o2;
            o2[0] = pack2(tot[dt][rt][0] * bflo(z[0]), tot[dt][rt][1] * bfhi(z[0]));
            o2[1] = pack2(tot[dt][rt][2] * bflo(z[1]), tot[dt][rt][3] * bfhi(z[1]));
            *(u32x2*)(p.Qn + off) = o2;
        }
    }
    __syncthreads();
}

DI void ret_item(const Params& p, int n, int h, bool dowrite) {
    const int lane = TID() & 63, w = TID() >> 6, lr = lane & 15, q = lane >> 4;
    const float lg2 = logf(1.0f - exp2f(-5.0f - (float)h)) * LOG2E;
    const u16* rbase = p.H + (((size_t)n * 4 + h) * 256) * 128;
    const u16* kbase = p.Kr + ((size_t)h * S_ + n * 128) * 128;
    const u16* vbase = p.VrT + (((size_t)h * 128 + n) * 256) * 128;
    const u16* rlane = rbase + lr * 128 + 8 * q;
    const u16* vlane = vbase + lr * 128 + 8 * q;
#pragma unroll 1
    for (int it = 0; it < 2; ++it) {
        const int i = 32 * w + 16 * it + lr;
        bf16x8 qf[4];
#pragma unroll
        for (int ks = 0; ks < 4; ++ks) qf[ks] = ldf(p.Qr + ((size_t)h * S_ + n * 128 + i) * 128 + 32 * ks + 8 * q);
        f32x4 acc[16];
#pragma unroll
        for (int et = 0; et < 16; ++et) acc[et] = f32x4{0.f, 0.f, 0.f, 0.f};
#pragma unroll
        for (int et = 0; et < 16; ++et) {
            const u16* pe = rlane + et * 16 * 128; asm volatile("" : "+v"(pe));
#pragma unroll
            for (int ks = 0; ks < 4; ++ks) acc[et] = MFMA16(ldf(pe + 32 * ks), qf[ks], acc[et]);
        }
        {
            const float qd = exp2f((float)(i + 1) * lg2);
#pragma unroll
            for (int et = 0; et < 16; ++et) acc[et] *= qd;
        }
        for (int jk = 0; jk <= w; ++jk) {
            f32x4 s[2];
#pragma unroll
            for (int jj = 0; jj < 2; ++jj) {
                const int krow = 32 * jk + 8 * (lr >> 2) + 4 * jj + (lr & 3);
                s[jj] = f32x4{0.f, 0.f, 0.f, 0.f};
#pragma unroll
                for (int ks = 0; ks < 4; ++ks) s[jj] = MFMA16(ldf(kbase + (size_t)krow * 128 + 32 * ks + 8 * q), qf[ks], s[jj]);
            }
#pragma unroll
            for (int jj = 0; jj < 2; ++jj)
#pragma unroll
                for (int r = 0; r < 4; ++r) {
                    const int j = 32 * jk + 8 * q + 4 * jj + r;
                    s[jj][r] = (i >= j) ? s[jj][r] * exp2f((float)(i - j) * lg2) : 0.f;
                }
            const bf16x8 pb = packf(s[0], s[1]);
#pragma unroll
            for (int et = 0; et < 16; ++et) {
                const u16* pe = vlane + et * 16 * 128 + 32 * jk; asm volatile("" : "+v"(pe));
                acc[et] = MFMA16(ldf(pe), pb, acc[et]);
            }
        }
        float sm = 0.f;
#pragma unroll
        for (int et = 0; et < 16; ++et) sm += acc[et][0] + acc[et][1] + acc[et][2] + acc[et][3];
        sm += __shfl_xor(sm, 16); sm += __shfl_xor(sm, 32);
        const float mu = sm * (1.f / 256.f);
        float vs = 0.f;
#pragma unroll
        for (int et = 0; et < 16; ++et)
#pragma unroll
            for (int r = 0; r < 4; ++r) { const float d = acc[et][r] - mu; vs += d * d; }
        vs += __shfl_xor(vs, 16); vs += __shfl_xor(vs, 32);
        const float rs = rsqrtf(vs * (1.f / 256.f) + 1e-6f);
        u16* zlane = p.SZr + ((size_t)n * 128 + i) * 1024 + h * 256 + 4 * q;
#pragma unroll
        for (int et = 0; et < 16; ++et) {
            u16* zp = zlane + 16 * et; asm volatile("" : "+v"(zp));
            const u32x2 z = *(const u32x2*)zp;
            u32x2 o2;
            o2[0] = pack2((acc[et][0] - mu) * rs * bflo(z[0]), (acc[et][1] - mu) * rs * bfhi(z[0]));
            o2[1] = pack2((acc[et][2] - mu) * rs * bflo(z[1]), (acc[et][3] - mu) * rs * bfhi(z[1]));
            if (dowrite) *(u32x2*)zp = o2;
        }
    }
}

DI void p5_tile(const Params& p, int t, unsigned char* smem) {
    const int tid = TID();
    const int nt = t >> 7, mt = t & 127, tok0 = mt * 128;
    u16* lds = (u16*)smem; float* cst = (float*)smem;
    float* hold = (float*)p.H + (size_t)blockIdx.x * 16384;
    {
        f32x4 acc[4][4]; zero_acc(acc);
        gemm128_main(p.Qn + (size_t)(tok0 + (tid >> 3)) * 512 + (tid & 7) * 8, (size_t)32 * 512, 64,
                     p.WnoT + (size_t)(nt * 128 + (tid >> 3)) * 512 + (tid & 7) * 8, (size_t)32 * 512, 64, 8, lds, acc);
        stage_acc(cst, acc);
    }
    __syncthreads();
    emit_rows(cst, [&](int row, int c8, const float* v) {
        const u32x4 gm = ld16(p.Ma + (size_t)(tok0 + row) * 1024 + nt * 128 + c8 * 8);
        float4 a, b;
        a.x = v[0] * bflo(gm[0]); a.y = v[1] * bfhi(gm[0]); a.z = v[2] * bflo(gm[1]); a.w = v[3] * bfhi(gm[1]);
        b.x = v[4] * bflo(gm[2]); b.y = v[5] * bfhi(gm[2]); b.z = v[6] * bflo(gm[3]); b.w = v[7] * bfhi(gm[3]);
        *(float4*)(hold + row * 128 + c8 * 8) = a; *(float4*)(hold + row * 128 + c8 * 8 + 4) = b; });
    __syncthreads();
    {
        f32x4 acc[4][4]; zero_acc(acc);
        gemm128_main(p.SZr + (size_t)(tok0 + (tid >> 3)) * 1024 + (tid & 7) * 8, (size_t)32 * 1024, 64,
                     p.WroT + (size_t)(nt * 128 + (tid >> 3)) * 1024 + (tid & 7) * 8, (size_t)32 * 1024, 64, 16, lds, acc);
        stage_acc(cst, acc);
    }
    __syncthreads();
    u16* Mg = p.Qr;
    emit_rows(cst, [&](int row, int c8, const float* v) {
        const u32x4 gm = ld16(p.Mb + (size_t)(tok0 + row) * 1024 + nt * 128 + c8 * 8);
        const float4 a = *(const float4*)(hold + row * 128 + c8 * 8), b = *(const float4*)(hold + row * 128 + c8 * 8 + 4);
        float o[8];
        o[0] = a.x + v[0] * bflo(gm[0]); o[1] = a.y + v[1] * bfhi(gm[0]); o[2] = a.z + v[2] * bflo(gm[1]); o[3] = a.w + v[3] * bfhi(gm[1]);
        o[4] = b.x + v[4] * bflo(gm[2]); o[5] = b.y + v[5] * bfhi(gm[2]); o[6] = b.z + v[6] * bflo(gm[3]); o[7] = b.w + v[7] * bfhi(gm[3]);
        *(u32x4*)(Mg + (size_t)(tok0 + row) * 1024 + nt * 128 + c8 * 8) = pack8(o); });
    __syncthreads();
}

DI void p6_tile(const Params& p, int t, unsigned char* smem) {
    const int tid = TID();
    const int nt = t >> 7, mt = t & 127, tok0 = mt * 128;
    u16* lds = (u16*)smem; float* cst = (float*)smem;
    const u16* Mg = p.Qr; u16* Y2 = p.VrT;
    {
        f32x4 acc[4][4]; zero_acc(acc);
        gemm128_main(Mg + (size_t)(tok0 + (tid >> 3)) * 1024 + (tid & 7) * 8, (size_t)32 * 1024, 64,
                     p.WoutT + (size_t)(nt * 128 + (tid >> 3)) * 1024 + (tid & 7) * 8, (size_t)32 * 1024, 64, 16, lds, acc);
        stage_acc(cst, acc);
    }
    __syncthreads();
    emit_rows(cst, [&](int row, int c8, const float* v) {
        *(u32x4*)(Y2 + (size_t)(tok0 + row) * 1024 + nt * 128 + c8 * 8) = pack8(v);
        float ss = 0.f;
#pragma unroll
        for (int k = 0; k < 8; ++k) ss += v[k] * v[k];
        ss += __shfl_xor(ss, 1); ss += __shfl_xor(ss, 2); ss += __shfl_xor(ss, 4); ss += __shfl_xor(ss, 8);
        if (c8 == 0) p.rowss[(size_t)(tok0 + row) * 8 + nt] = ss; });
    __syncthreads();
}

DI void p7_all(const Params& p) {
    const u16* Y2 = p.VrT;
    const size_t n4 = (size_t)S_ * 256;
    for (size_t i = (size_t)blockIdx.x * 256 + TID(); i < n4; i += (size_t)gridDim.x * 256) {
        const size_t row = i >> 8; const int c4 = (int)(i & 255);
        const float4 a = *(const float4*)(p.rowss + row * 8), b = *(const float4*)(p.rowss + row * 8 + 4);
        const float ss = ((a.x + a.y) + (a.z + a.w)) + ((b.x + b.y) + (b.z + b.w));
        const float rs = rsqrtf(ss * (1.f / 1024.f) + 1e-6f);
        const float4 xv = *(const float4*)(p.x + i * 4);
        const float4 gv = *(const float4*)(p.norm_post + c4 * 4);
        const u32x2 y = *(const u32x2*)(Y2 + i * 4);
        float4 o;
        o.x = xv.x + bflo(y[0]) * rs * gv.x; o.y = xv.y + bfhi(y[0]) * rs * gv.y;
        o.z = xv.z + bflo(y[1]) * rs * gv.z; o.w = xv.w + bfhi(y[1]) * rs * gv.w;
        *(float4*)(p.out + i * 4) = o;
    }
}

#ifndef MK_PROBE
#define MK_PROBE 0
#endif
constexpr size_t al256(size_t x) { return (x + 255) & ~(size_t)255; }
constexpr size_t O_BAR   = 0;
constexpr size_t O_WINT  = O_BAR   + 16384;
constexpr size_t O_WNOT  = O_WINT  + al256((size_t)NPAD_ * 1024 * 2);
constexpr size_t O_WROT  = O_WNOT  + (size_t)1024 * 512 * 2;
constexpr size_t O_WOUTT = O_WROT  + (size_t)1024 * 1024 * 2;
constexpr size_t O_W1T0  = O_WOUTT + (size_t)1024 * 1024 * 2;
constexpr size_t O_W1T1  = O_W1T0  + (size_t)256 * 2048 * 2;
constexpr size_t O_W2T0  = O_W1T1  + (size_t)256 * 2048 * 2;
constexpr size_t O_W2T1  = O_W2T0  + (size_t)64 * 256 * 2;
constexpr size_t O_BPART = O_W2T1  + (size_t)64 * 256 * 2;
constexpr size_t O_ROPEN = O_BPART + (size_t)2 * 16 * 256 * 4;
constexpr size_t O_ROPER = O_ROPEN + (size_t)S_ * 8 * 8;
constexpr size_t O_H     = O_ROPER + (size_t)S_ * 64 * 8;
constexpr size_t O_QN    = O_H     + (size_t)S_ * 1024 * 2;
constexpr size_t O_RAW0  = O_QN    + (size_t)S_ * 512 * 2;
constexpr size_t O_RAW1  = O_RAW0  + (size_t)S_ * 128 * 2;
constexpr size_t O_KS    = O_RAW1  + (size_t)S_ * 128 * 2;
constexpr size_t O_VST   = O_KS    + (size_t)2 * S_ * 64 * 2;
constexpr size_t O_KW    = O_VST   + (size_t)2 * S_ * 64 * 2;
constexpr size_t O_VWT   = O_KW    + (size_t)2 * S_ * 64 * 2;
constexpr size_t O_SZN   = O_VWT   + (size_t)2 * S_ * 64 * 2;
constexpr size_t O_QR    = O_SZN   + (size_t)S_ * 512 * 2;
constexpr size_t O_KR    = O_QR    + (size_t)4 * S_ * 128 * 2;
constexpr size_t O_KRT   = O_KR    + (size_t)4 * S_ * 128 * 2;
constexpr size_t O_VRT   = O_KRT   + (size_t)4 * S_ * 128 * 2;
constexpr size_t O_SZR   = O_VRT   + (size_t)4 * S_ * 256 * 2;
constexpr size_t O_GN    = O_SZR   + (size_t)S_ * 1024 * 2;
constexpr size_t O_SLAB  = O_GN    + (size_t)S_ * 24 * 4;
constexpr size_t O_KC    = O_SLAB  + (size_t)4 * 2 * 2048 * 256 * 4;
constexpr size_t O_VCT   = O_KC    + (size_t)2 * 1024 * 64 * 2;
constexpr size_t O_ROWSS = O_VCT   + (size_t)2 * 1024 * 64 * 2;
constexpr size_t WS_BYTES = O_ROWSS + (size_t)S_ * 8 * 4;

struct KArgs {
    const float *x, *norm_pre, *w_in, *b_gate, *pe_k, *w1_k, *w2_k, *pe_v, *w1_v, *w2_v, *w_nsa_o, *w_ret_o, *w_out, *norm_post;
    float* out; char* ws; int use_cg; int probe;
};

__global__ void __launch_bounds__(256, 2) fwd_megakernel(KArgs ka) {
    Params p;
    p.x = ka.x; p.norm_pre = ka.norm_pre; p.w_in = ka.w_in; p.b_gate = ka.b_gate; p.pe_k = ka.pe_k; p.w1_k = ka.w1_k; p.w2_k = ka.w2_k;
    p.pe_v = ka.pe_v; p.w1_v = ka.w1_v; p.w2_v = ka.w2_v; p.w_nsa_o = ka.w_nsa_o; p.w_ret_o = ka.w_ret_o; p.w_out = ka.w_out; p.norm_post = ka.norm_post;
    p.out = ka.out; p.use_cg = ka.use_cg; p.probe = ka.probe;
    {
        char* ws = ka.ws;
        p.bar = (unsigned*)(ws + O_BAR);
        p.WinT = (u16*)(ws + O_WINT); p.WnoT = (u16*)(ws + O_WNOT); p.WroT = (u16*)(ws + O_WROT); p.WoutT = (u16*)(ws + O_WOUTT);
        p.W1T[0] = (u16*)(ws + O_W1T0); p.W1T[1] = (u16*)(ws + O_W1T1); p.W2T[0] = (u16*)(ws + O_W2T0); p.W2T[1] = (u16*)(ws + O_W2T1);
        p.bpart = (float*)(ws + O_BPART); p.ropeN = (float2*)(ws + O_ROPEN); p.ropeR = (float2*)(ws + O_ROPER);
        p.H = (u16*)(ws + O_H); p.Qn = (u16*)(ws + O_QN); p.Raw[0] = (u16*)(ws + O_RAW0); p.Raw[1] = (u16*)(ws + O_RAW1);
        p.Ks = (u16*)(ws + O_KS); p.VsT = (u16*)(ws + O_VST); p.Kw = (u16*)(ws + O_KW); p.VwT = (u16*)(ws + O_VWT);
        p.SZn = (u16*)(ws + O_SZN); p.Qr = (u16*)(ws + O_QR); p.Kr = (u16*)(ws + O_KR); p.KrT = (u16*)(ws + O_KRT); p.VrT = (u16*)(ws + O_VRT);
        p.SZr = (u16*)(ws + O_SZR); p.Gn = (float*)(ws + O_GN); p.slab = (float*)(ws + O_SLAB); p.Kc = (u16*)(ws + O_KC); p.VcT = (u16*)(ws + O_VCT);
        p.rowss = (float*)(ws + O_ROWSS);
        p.Ma = (u16*)ka.out; p.Mb = (u16*)ka.out + (size_t)S_ * 1024;
    }
    __shared__ __attribute__((aligned(16))) unsigned char smem[4 * TILE_ELEMS * 2];
    __shared__ uint4 xb_words;
    if (threadIdx.x == 0) xb_words = make_uint4(0u, 0u, 0u, 0u);
    __syncthreads();
    XcdBarrier b = xcd_barrier_post(p.bar, (volatile LAS unsigned*)&xb_words);
    const int G = gridDim.x, B = blockIdx.x;
#define GRID_SYNC() do { if (p.use_cg) cg::this_grid().sync(); else xcd_barrier(b); } while (0)

    for (int rep = (MK_PROBE & 1) ? 0 : 1; rep < 2; ++rep)
    for (int u = B; u < P0_UNITS; u += G) p0_unit(p, u, smem);
    GRID_SYNC();
    for (int rep = (MK_PROBE & 2) ? 0 : 1; rep < 2; ++rep)
    for (int t = B; t < 55 * 128; t += G) p1_tile(p, t, smem);
    GRID_SYNC();
    for (int rep = (MK_PROBE & 4) ? 0 : 1; rep < 2; ++rep)
    for (int u = B; u < P2_UNITS; u += G) p2_unit(p, u, smem);
    GRID_SYNC();
    for (int rep = (MK_PROBE & 8) ? 0 : 1; rep < 2; ++rep)
    for (int u = B; u < P3_UNITS; u += G) p3_unit(p, u, smem);
    p3_scan(p);
    GRID_SYNC();
    for (int u = B; u < 1536; u += G) {
        if (u < 1024) nsa_item(p, 511 - (u >> 1), u & 1, smem);
        else { if (MK_PROBE & 4096) ret_item(p, (u - 1024) >> 2, (u - 1024) & 3, false); ret_item(p, (u - 1024) >> 2, (u - 1024) & 3, true); }
    }
    GRID_SYNC();
    for (int rep = (MK_PROBE & 16) ? 0 : 1; rep < 2; ++rep)
    for (int t = B; t < 1024; t += G) p5_tile(p, t, smem);
    GRID_SYNC();
    for (int rep = (MK_PROBE & 32) ? 0 : 1; rep < 2; ++rep)
    for (int t = B; t < 1024; t += G) p6_tile(p, t, smem);
    GRID_SYNC();
    for (int rep = (MK_PROBE & 64) ? 0 : 1; rep < 2; ++rep)
    p7_all(p);
}

extern "C" void kernel_launch(void* const* d_in, const int* in_sizes, int n_in, void* d_out, int out_size,
                              void* d_ws, size_t ws_size, hipStream_t stream) {
    static int grid_blocks = 0;
    if (!grid_blocks) {
        int dev = 0, cus = 0, per_cu = 0;
        (void)hipGetDevice(&dev);
        (void)hipDeviceGetAttribute(&cus, hipDeviceAttributeMultiprocessorCount, dev);
        (void)hipOccupancyMaxActiveBlocksPerMultiprocessor(&per_cu, fwd_megakernel, 256, 0);
        if (per_cu > 2) per_cu = 2;
        if (per_cu < 1) per_cu = 1;
        grid_blocks = cus * per_cu;
    }
    KArgs ka{};
    ka.x = (const float*)d_in[0]; ka.norm_pre = (const float*)d_in[1]; ka.w_in = (const float*)d_in[2]; ka.b_gate = (const float*)d_in[3];
    ka.pe_k = (const float*)d_in[4]; ka.w1_k = (const float*)d_in[5]; ka.w2_k = (const float*)d_in[6];
    ka.pe_v = (const float*)d_in[7]; ka.w1_v = (const float*)d_in[8]; ka.w2_v = (const float*)d_in[9];
    ka.w_nsa_o = (const float*)d_in[10]; ka.w_ret_o = (const float*)d_in[11]; ka.w_out = (const float*)d_in[12]; ka.norm_post = (const float*)d_in[13];
    ka.out = (float*)d_out; ka.ws = (char*)d_ws; ka.use_cg = 0; ka.probe = MK_PROBE;
    if (WS_BYTES > ws_size) { fprintf(stderr, "workspace too small: need %zu have %zu\n", (size_t)WS_BYTES, ws_size); return; }
    (void)hipMemsetAsync(d_ws, 0, XCD_BAR_WORDS * 4, stream);
    void* args[] = {&ka};
    hipError_t e = hipLaunchCooperativeKernel((void*)fwd_megakernel, dim3(grid_blocks), dim3(256), args, 0, stream);
    if (e != hipSuccess) fprintf(stderr, "cooperative launch failed: %s (grid %d)\n", hipGetErrorString(e), grid_blocks);
}
```

```cpp
#include <hip/hip_runtime.h>
#include <hip/hip_cooperative_groups.h>
#include <cstdio>
namespace cg = cooperative_groups;

#define DI __device__ __forceinline__
#define LAS __attribute__((address_space(3)))

#define XB_TMO      128
#define XB_XCNT(j)  (256  + 64 * (j))
#define XB_XSUB(j)  (1280 + 64 * (j))
#define XB_XGEN(j)  (2304 + 64 * (j))
#define XB_TOP      3328
#define XB_TOPGEN   3392
#define XCD_BAR_WORDS 3456
#define XB_SPIN_CAP (1u << 22)

DI unsigned xb_ld(unsigned* p)              { return __hip_atomic_load(p, __ATOMIC_RELAXED, __HIP_MEMORY_SCOPE_AGENT); }
DI unsigned xb_add(unsigned* p, unsigned v) { return __hip_atomic_fetch_add(p, v, __ATOMIC_RELAXED, __HIP_MEMORY_SCOPE_AGENT); }
DI unsigned xb_xcc_id() { return (unsigned)__builtin_amdgcn_s_getreg((3 << 11) | 20) & 0xFu; }
#define XB_SPIN(cond, bar) do { unsigned _sp = 0; while (cond) { __builtin_amdgcn_s_sleep(1); \
    if ((++_sp & 255u) == 0u) { if (xb_ld(&(bar)[XB_TMO])) break; if (_sp > XB_SPIN_CAP) { atomicAdd(&(bar)[XB_TMO], 1u); break; } } } } while (0)

struct XcdBarrier { unsigned* bar; unsigned x; volatile LAS unsigned* st; };

DI XcdBarrier xcd_barrier_post(unsigned* bar, volatile LAS unsigned* st) {
    XcdBarrier b; b.bar = bar; b.x = xb_xcc_id(); b.st = st;
    if (threadIdx.x == 0) (void)xb_add(&bar[XB_XCNT(b.x)], 1u);
    return b;
}
DI void xcd_barrier_complete(unsigned* bar, unsigned x, unsigned& nloc, unsigned& nx) {
    const unsigned G = gridDim.x * gridDim.y * gridDim.z;
    unsigned sum, cnt, mine, sp = 0u;
    for (;;) {
        sum = 0u; cnt = 0u; mine = 0u;
#pragma unroll
        for (unsigned j = 0; j < 16; ++j) { const unsigned c = xb_ld(&bar[XB_XCNT(j)]); sum += c; cnt += (c > 0u) ? 1u : 0u; mine = (j == x) ? c : mine; }
        if (sum == G) break;
        __builtin_amdgcn_s_sleep(1);
        if ((++sp & 255u) == 0u) { if (xb_ld(&bar[XB_TMO])) break; if (sp > XB_SPIN_CAP) { atomicAdd(&bar[XB_TMO], 1u); break; } }
    }
    nloc = mine > 0u ? mine : 1u; nx = cnt > 0u ? cnt : 1u;
}
DI void xcd_barrier(const XcdBarrier& b) {
    asm volatile("s_waitcnt vmcnt(0)" ::: "memory");
    __syncthreads();
    if (threadIdx.x == 0) {
        unsigned* bar = b.bar;
        __builtin_amdgcn_s_waitcnt(0);
        unsigned nloc = b.st[0], nx = b.st[1];
        if (nloc == 0u) { xcd_barrier_complete(bar, b.x, nloc, nx); b.st[0] = nloc; b.st[1] = nx; }
        const unsigned old = xb_add(&bar[XB_XSUB(b.x)], 1u);
        const unsigned gen = old / nloc;
        if (old + 1u == (gen + 1u) * nloc) {
            __builtin_amdgcn_fence(__ATOMIC_RELEASE, "agent");
            asm volatile("s_waitcnt vmcnt(0)" ::: "memory");
            const unsigned og = xb_add(&bar[XB_TOP], 1u);
            const unsigned tg = og / nx;
            if (og + 1u == (tg + 1u) * nx) xb_add(&bar[XB_TOPGEN], 1u);
            else XB_SPIN(xb_ld(&bar[XB_TOPGEN]) == tg, bar);
            __builtin_amdgcn_fence(__ATOMIC_ACQUIRE, "agent");
            xb_add(&bar[XB_XGEN(b.x)], 1u);
            asm volatile("s_waitcnt vmcnt(0)" ::: "memory");
        } else {
            XB_SPIN(xb_ld(&bar[XB_XGEN(b.x)]) == gen, bar);
            __builtin_amdgcn_fence(__ATOMIC_ACQUIRE, "agent");
            asm volatile("s_waitcnt vmcnt(0)" ::: "memory");
        }
    }
    __syncthreads();
}


#ifndef MK_PROBE
#define MK_PROBE 0
#endif
typedef unsigned short u16;
using bf16x8 = __attribute__((ext_vector_type(8))) short;
using f32x4  = __attribute__((ext_vector_type(4))) float;
using u32x4  = __attribute__((ext_vector_type(4))) unsigned;
using u32x2  = __attribute__((ext_vector_type(2))) unsigned;
typedef __attribute__((ext_vector_type(2))) __bf16 bf2_t;
#define MFMA16(a, b, c) __builtin_amdgcn_mfma_f32_16x16x32_bf16((a), (b), (c), 0, 0, 0)

constexpr int S_ = 16384, DM_ = 1024, NPAD_ = 7040;
constexpr int LDT = 64;
DI int swzA(int row) { return row & 7; }
DI int swzK(int row) { return (((row >> 3) & 3) << 1) | ((row >> 1) & 1); }
constexpr int TILE_ELEMS = 128 * LDT;
constexpr int CST = 132;
constexpr float LOG2E = 1.4426950408889634f;

template <int N> struct IC { static constexpr int value = N; };
DI int TID() { int t = threadIdx.x; asm volatile("" : "+v"(t)); return t; }
DI unsigned pack2(float a, float b) { bf2_t v = {(__bf16)a, (__bf16)b}; return __builtin_bit_cast(unsigned, v); }
DI float bflo(unsigned u) { return __uint_as_float(u << 16); }
DI float bfhi(unsigned u) { return __uint_as_float(u & 0xffff0000u); }
DI u32x4 ld16(const u16* p) { return *(const u32x4*)p; }
DI bf16x8 ldf(const u16* p) { return *(const bf16x8*)p; }
DI u32x4 pack8(const float* v) { u32x4 r; r[0] = pack2(v[0], v[1]); r[1] = pack2(v[2], v[3]); r[2] = pack2(v[4], v[5]); r[3] = pack2(v[6], v[7]); return r; }
DI bf16x8 packf(f32x4 a, f32x4 b) { u32x4 r; r[0] = pack2(a[0], a[1]); r[1] = pack2(a[2], a[3]); r[2] = pack2(b[0], b[1]); r[3] = pack2(b[2], b[3]); return __builtin_bit_cast(bf16x8, r); }
DI float ex2(float x) { return __builtin_amdgcn_exp2f(x); }
DI float sigmoidf_(float x) { return 1.f / (1.f + __expf(-x)); }
DI float wave_max(float v) {
#pragma unroll
    for (int o = 32; o >= 1; o >>= 1) v = fmaxf(v, __shfl_xor(v, o));
    return v;
}
DI float wave_sum(float v) {
#pragma unroll
    for (int o = 32; o >= 1; o >>= 1) v += __shfl_xor(v, o);
    return v;
}

struct Params {
    const float *x, *norm_pre, *w_in, *b_gate, *pe_k, *w1_k, *w2_k, *pe_v, *w1_v, *w2_v, *w_nsa_o, *w_ret_o, *w_out, *norm_post;
    float* out;
    unsigned* bar;
    u16 *WinT, *WnoT, *WroT, *WoutT, *W1T[2], *W2T[2];
    float* bpart;
    float2 *ropeN, *ropeR;
    u16 *H;
    u16 *Qn;
    u16 *Raw[2];
    u16 *Ks, *VsT, *Kw, *VwT;
    u16 *SZn;
    u16 *Qr, *Kr;
    u16 *KrT;
    u16 *VrT;
    u16 *SZr;
    u16 *Ma, *Mb;
    float* Gn;
    float* slab;
    u16 *Kc, *VcT;
    float* rowss;
    int use_cg; int probe;
};

DI void gemm128_main(const u16* a0, size_t a_r32, int astep, const u16* b0, size_t b_r32, int bstep, int nk,
                     u16* lds, f32x4 (&acc)[4][4]) {
    const int tid = TID(), lane = tid & 63, w = tid >> 6;
    const int wr = w >> 1, wc = w & 1, lr = lane & 15, q = lane >> 4;
    const int wofs = (tid >> 3) * LDT + (((tid & 7) ^ swzA(tid >> 3)) << 3);
    u32x4 ra0[4], rb0[4], ra1[4], rb1[4];
    auto gl = [&](int kt, u32x4 (&ra)[4], u32x4 (&rb)[4]) {
        const int k = kt < nk ? kt : nk - 1;
        const u16* ap = a0 + (size_t)k * astep; const u16* bp = b0 + (size_t)k * bstep;
#pragma unroll
        for (int i = 0; i < 4; ++i) { ra[i] = ld16(ap + i * a_r32); rb[i] = ld16(bp + i * b_r32); }
    };
    auto st = [&](u16* buf, const u32x4 (&ra)[4], const u32x4 (&rb)[4]) {
#pragma unroll
        for (int i = 0; i < 4; ++i) {
            *(u32x4*)(buf + wofs + i * 32 * LDT) = ra[i];
            *(u32x4*)(buf + TILE_ELEMS + wofs + i * 32 * LDT) = rb[i];
        }
    };
    auto mm = [&](const u16* As) {
        const u16* Bs = As + TILE_ELEMS;
#pragma unroll
        for (int ks = 0; ks < 2; ++ks) {
            bf16x8 af[4], bfr[4];
#pragma unroll
            for (int t = 0; t < 4; ++t) {
                af[t]  = ldf(As + (64 * wr + 16 * t + lr) * LDT + (((ks * 4 + q) ^ (lr & 7)) << 3));
                bfr[t] = ldf(Bs + (64 * wc + 16 * t + lr) * LDT + (((ks * 4 + q) ^ (lr & 7)) << 3));
            }
#pragma unroll
            for (int ti = 0; ti < 4; ++ti)
#pragma unroll
                for (int tj = 0; tj < 4; ++tj) acc[ti][tj] = MFMA16(af[ti], bfr[tj], acc[ti][tj]);
        }
    };
    u16* buf0 = lds; u16* buf1 = lds + 2 * TILE_ELEMS;
    gl(0, ra0, rb0);
    st(buf0, ra0, rb0);
    gl(1, ra1, rb1);
    __syncthreads();
    for (int kt = 0; kt < nk; kt += 2) {
        gl(kt + 2, ra0, rb0);
        __builtin_amdgcn_sched_barrier(0);
        mm(buf0);
        __builtin_amdgcn_sched_barrier(0);
        st(buf1, ra1, rb1);
        __syncthreads();
        gl(kt + 3, ra1, rb1);
        __builtin_amdgcn_sched_barrier(0);
        mm(buf1);
        __builtin_amdgcn_sched_barrier(0);
        st(buf0, ra0, rb0);
        __syncthreads();
    }
}
DI void zero_acc(f32x4 (&acc)[4][4]) {
#pragma unroll
    for (int i = 0; i < 4; ++i)
#pragma unroll
        for (int j = 0; j < 4; ++j) acc[i][j] = f32x4{0.f, 0.f, 0.f, 0.f};
}
DI void stage_acc(float* cst, const f32x4 (&acc)[4][4]) {
    const int lane = TID() & 63, w = TID() >> 6;
    const int wr = w >> 1, wc = w & 1, lr = lane & 15, q = lane >> 4;
#pragma unroll
    for (int ti = 0; ti < 4; ++ti)
#pragma unroll
        for (int tj = 0; tj < 4; ++tj)
#pragma unroll
            for (int r = 0; r < 4; ++r)
                cst[(64 * wr + 16 * ti + 4 * q + r) * CST + 64 * wc + 16 * tj + lr] = acc[ti][tj][r];
}
template <typename F> DI void emit_rows(const float* cst, F f) {
#pragma unroll 2
    for (int i = 0; i < 8; ++i) {
        const int item = TID() + 256 * i, row = item >> 4, c8 = item & 15;
        const float4 a = *(const float4*)(cst + row * CST + c8 * 8);
        const float4 b = *(const float4*)(cst + row * CST + c8 * 8 + 4);
        float v[8] = {a.x, a.y, a.z, a.w, b.x, b.y, b.z, b.w};
        f(row, c8, v);
    }
}
template <typename F> DI void emit_cols(const float* cst, F f) {
#pragma unroll 2
    for (int i = 0; i < 8; ++i) {
        const int item = TID() + 256 * i, rest = item >> 6;
        const int col = (item & 15) + 16 * (rest & 7), r8 = ((item >> 4) & 3) + 4 * (rest >> 3);
        float v[8];
#pragma unroll
        for (int k = 0; k < 8; ++k) v[k] = cst[(r8 * 8 + k) * CST + col];
        f(col, r8, v);
    }
}

DI void transpose_tile(const float* src, int ldsrc, int k0, int n0, u16* dst, int lddst, int map_in, float* tl) {
    const int tid = TID();
    const int c = tid & 63;
    int oc = n0 + c;
    if (map_in) oc = (oc < 1280) ? oc : (oc < 6912 ? oc + 24 : (oc < 6936 ? oc - 6912 + 1280 : -1));
#pragma unroll
    for (int i = 0; i < 16; ++i) {
        const int r = (tid >> 6) + 4 * i;
        tl[r * 65 + c] = (oc >= 0) ? src[(size_t)(k0 + r) * ldsrc + oc] : 0.f;
    }
    __syncthreads();
    const int nl = tid >> 2, kc = (tid & 3) * 16;
    float v[16];
#pragma unroll
    for (int i = 0; i < 16; ++i) v[i] = tl[(kc + i) * 65 + nl];
    u16* d = dst + (size_t)(n0 + nl) * lddst + k0 + kc;
    *(u32x4*)d = pack8(v);
    *(u32x4*)(d + 8) = pack8(v + 8);
    __syncthreads();
}

DI void p0_unit(const Params& p, int u, unsigned char* smem) {
    const int tid = TID(), lane = tid & 63, w = tid >> 6;
    float* tl = (float*)smem;
    if (u < 2664) {
        int t = u;
        if (t < 1760) { transpose_tile(p.w_in, 6936, (t & 15) * 64, (t >> 4) * 64, p.WinT, 1024, 1, tl); return; }
        t -= 1760;
        if (t < 128) { transpose_tile(p.w_nsa_o, 1024, (t & 7) * 64, (t >> 3) * 64, p.WnoT, 512, 0, tl); return; }
        t -= 128;
        if (t < 256) { transpose_tile(p.w_ret_o, 1024, (t & 15) * 64, (t >> 4) * 64, p.WroT, 1024, 0, tl); return; }
        t -= 256;
        if (t < 256) { transpose_tile(p.w_out, 1024, (t & 15) * 64, (t >> 4) * 64, p.WoutT, 1024, 0, tl); return; }
        t -= 256;
        if (t < 128) { transpose_tile(p.w1_k, 256, (t & 31) * 64, (t >> 5) * 64, p.W1T[0], 2048, 0, tl); return; }
        t -= 128;
        if (t < 128) { transpose_tile(p.w1_v, 256, (t & 31) * 64, (t >> 5) * 64, p.W1T[1], 2048, 0, tl); return; }
        t -= 128;
        if (t < 4) { transpose_tile(p.w2_k, 64, t * 64, 0, p.W2T[0], 256, 0, tl); return; }
        t -= 4;
        transpose_tile(p.w2_v, 64, t * 64, 0, p.W2T[1], 256, 0, tl);
        return;
    }
    u -= 2664;
    if (u < 4096) {
        const int row = u * 4 + w;
        const float* xr = p.x + (size_t)row * 1024;
        float4 v[4]; float ss = 0.f;
#pragma unroll
        for (int i = 0; i < 4; ++i) { v[i] = *(const float4*)(xr + lane * 4 + 256 * i); ss += v[i].x * v[i].x + v[i].y * v[i].y + v[i].z * v[i].z + v[i].w * v[i].w; }
        ss = wave_sum(ss);
        const float rs = rsqrtf(ss * (1.f / 1024.f) + 1e-6f);
#pragma unroll
        for (int i = 0; i < 4; ++i) {
            const float4 g = *(const float4*)(p.norm_pre + lane * 4 + 256 * i);
            u32x2 o; o[0] = pack2(v[i].x * rs * g.x, v[i].y * rs * g.y); o[1] = pack2(v[i].z * rs * g.z, v[i].w * rs * g.w);
            *(u32x2*)(p.H + (size_t)row * 1024 + lane * 4 + 256 * i) = o;
        }
        return;
    }
    u -= 4096;
    if (u < 4096) {
        const int e = u * 256 + tid, pos = e >> 6, i = e & 63;
        const float inv = 1.0f / powf(10000.0f, (float)i / 63.0f);
        const float ang = (float)pos * inv;
        float sn, cs; sincosf(ang, &sn, &cs);
        p.ropeR[e] = make_float2(cs, sn);
        return;
    }
    u -= 4096;
    if (u < 512) {
        const int e = u * 256 + tid, pos = e >> 3, i = e & 7;
        const float inv = 1.0f / powf(500000.0f, (float)(2 * i) / 16.0f);
        const float ang = (float)pos * inv;
        float sn, cs; sincosf(ang, &sn, &cs);
        p.ropeN[e] = make_float2(cs, sn);
        return;
    }
    u -= 512;
    {
        const int kv = u >> 4, ch = u & 15;
        const float* pe = kv ? p.pe_v : p.pe_k;
        const float* w1 = kv ? p.w1_v : p.w1_k;
        float s = 0.f;
        for (int k = ch * 128; k < ch * 128 + 128; ++k) s += pe[k] * w1[(size_t)k * 256 + tid];
        p.bpart[(kv * 16 + ch) * 256 + tid] = s;
    }
}
constexpr int P0_UNITS = 2664 + 4096 + 4096 + 512 + 32;

DI void p1_tile(const Params& p, int t, unsigned char* smem) {
    const int tid = TID();
    const int nt = t >> 7, mt = t & 127, tok0 = mt * 128;
    u16* lds = (u16*)smem; float* cst = (float*)smem;
    f32x4 acc[4][4]; zero_acc(acc);
    gemm128_main(p.H + (size_t)(tok0 + (tid >> 3)) * 1024 + (tid & 7) * 8, (size_t)32 * 1024, 64,
                 p.WinT + (size_t)(nt * 128 + (tid >> 3)) * 1024 + (tid & 7) * 8, (size_t)32 * 1024, 64, 16, lds, acc);
    stage_acc(cst, acc);
    __syncthreads();
    if (nt <= 4 || nt == 6 || nt == 8) {
#pragma unroll 2
        for (int i = 0; i < 8; ++i) {
            const int item = tid + 256 * i, row = item >> 4, hh = (item >> 3) & 1, ii = item & 7;
            float* px = cst + row * CST + hh * 64 + ii;
            const float x1 = px[0], x2 = px[8];
            const float2 cs = p.ropeN[(size_t)(tok0 + row) * 8 + ii];
            px[0] = x1 * cs.x - x2 * cs.y; px[8] = x2 * cs.x + x1 * cs.y;
        }
        __syncthreads();
    } else if (nt >= 14 && nt <= 21) {
        const float sc = (nt >= 18) ? 0.08838834764831845f : 1.0f;
#pragma unroll 2
        for (int i = 0; i < 32; ++i) {
            const int item = tid + 256 * i, row = item >> 6, ii = item & 63;
            float* px = cst + row * CST + ii;
            const float x1 = px[0], x2 = px[64];
            const float2 cs = p.ropeR[(size_t)(tok0 + row) * 64 + ii];
            px[0] = (x1 * cs.x - x2 * cs.y) * sc; px[64] = (x2 * cs.x + x1 * cs.y) * sc;
        }
        __syncthreads();
    }
    if (nt <= 3) {
        emit_rows(cst, [&](int row, int c8, const float* v) { *(u32x4*)(p.Qn + (size_t)(tok0 + row) * 512 + nt * 128 + c8 * 8) = pack8(v); });
    } else if (nt == 4 || nt == 5) {
        u16* dst = (nt == 4) ? p.Raw[0] : p.Raw[1];
        emit_rows(cst, [&](int row, int c8, const float* v) { *(u32x4*)(dst + (size_t)(tok0 + row) * 128 + c8 * 8) = pack8(v); });
    } else if (nt == 6 || nt == 8) {
        u16* dst = (nt == 6) ? p.Ks : p.Kw;
        emit_rows(cst, [&](int row, int c8, const float* v) { *(u32x4*)(dst + ((size_t)(c8 >> 3) * S_ + tok0 + row) * 64 + (c8 & 7) * 8) = pack8(v); });
    } else if (nt == 7 || nt == 9) {
        u16* dst = (nt == 7) ? p.VsT : p.VwT;
        emit_cols(cst, [&](int col, int r8, const float* v) {
            const int g = col >> 6, d = col & 63, tk = tok0 + r8 * 8;
            *(u32x4*)(dst + (((size_t)g * 256 + (tk >> 6)) * 64 + d) * 64 + (tk & 63)) = pack8(v); });
    } else if (nt <= 13) {
        emit_rows(cst, [&](int row, int c8, const float* v) {
            float o[8];
#pragma unroll
            for (int k = 0; k < 8; ++k) o[k] = v[k] * sigmoidf_(v[k]);
            *(u32x4*)(p.SZn + (size_t)(tok0 + row) * 512 + (nt - 10) * 128 + c8 * 8) = pack8(o); });
    } else if (nt <= 17) {
        const int h = nt - 14;
        emit_rows(cst, [&](int row, int c8, const float* v) { *(u32x4*)(p.Qr + ((size_t)h * S_ + tok0 + row) * 128 + c8 * 8) = pack8(v); });
    } else if (nt <= 21) {
        const int h = nt - 18;
        emit_rows(cst, [&](int row, int c8, const float* v) { *(u32x4*)(p.Kr + ((size_t)h * S_ + tok0 + row) * 128 + c8 * 8) = pack8(v); });
        const float lg = logf(1.0f - exp2f(-5.0f - (float)h));
        emit_cols(cst, [&](int col, int r8, const float* v) {
            float o[8];
#pragma unroll
            for (int k = 0; k < 8; ++k) o[k] = v[k] * __expf((float)(127 - (r8 * 8 + k)) * lg);
            *(u32x4*)(p.KrT + (((size_t)h * 128 + mt) * 128 + col) * 128 + r8 * 8) = pack8(o); });
    } else if (nt <= 29) {
        const int h = (nt - 22) >> 1, e0 = ((nt - 22) & 1) * 128;
        emit_cols(cst, [&](int col, int r8, const float* v) {
            *(u32x4*)(p.VrT + (((size_t)h * 128 + mt) * 256 + e0 + col) * 128 + r8 * 8) = pack8(v); });
    } else if (nt <= 37) {
        emit_rows(cst, [&](int row, int c8, const float* v) {
            float o[8];
#pragma unroll
            for (int k = 0; k < 8; ++k) o[k] = v[k] * sigmoidf_(v[k]);
            *(u32x4*)(p.SZr + (size_t)(tok0 + row) * 1024 + (nt - 30) * 128 + c8 * 8) = pack8(o); });
    } else if (nt <= 53) {
        u16* dst = (nt <= 45) ? p.Ma : p.Mb;
        const int c0 = ((nt <= 45) ? (nt - 38) : (nt - 46)) * 128;
        emit_rows(cst, [&](int row, int c8, const float* v) {
            float o[8];
#pragma unroll
            for (int k = 0; k < 8; ++k) o[k] = sigmoidf_(v[k]);
            *(u32x4*)(dst + (size_t)(tok0 + row) * 1024 + c0 + c8 * 8) = pack8(o); });
    } else {
#pragma unroll 2
        for (int i = 0; i < 12; ++i) {
            const int item = tid + 256 * i, row = item / 24, c = item - row * 24;
            p.Gn[(size_t)(tok0 + row) * 24 + c] = sigmoidf_(cst[row * CST + c] + p.b_gate[c]);
        }
    }
    __syncthreads();
}

DI void p2_unit(const Params& p, int u, unsigned char* smem) {
    const int tid = TID(), lane = tid & 63, w = tid >> 6;
    u16* lds = (u16*)smem; float* cst = (float*)smem;
    f32x4 acc[4][4]; zero_acc(acc);
    if (u < 256) {
        const int nt = u & 1, mt = (u >> 1) & 15, ks = (u >> 5) & 3, kv = u >> 7;
        const int R = mt * 128 + (tid >> 3), c = R >> 1, g = R & 1;
        const u16* a0 = (kv ? p.Raw[1] : p.Raw[0]) + (size_t)(16 * c + ks * 8) * 128 + g * 64 + (tid & 7) * 8;
        const u16* b0 = (kv ? p.W1T[1] : p.W1T[0]) + (size_t)(nt * 128 + (tid >> 3)) * 2048 + ks * 512 + (tid & 7) * 8;
        gemm128_main(a0, (size_t)16 * 16 * 128, 128, b0, (size_t)32 * 2048, 64, 8, lds, acc);
        const int wr = w >> 1, wc = w & 1, lr = lane & 15, q = lane >> 4;
        float* dst = p.slab + ((size_t)(ks * 2 + kv) * 2048 + mt * 128) * 256 + nt * 128;
#pragma unroll
        for (int ti = 0; ti < 4; ++ti)
#pragma unroll
            for (int tj = 0; tj < 4; ++tj)
#pragma unroll
                for (int r = 0; r < 4; ++r)
                    dst[(size_t)(64 * wr + 16 * ti + 4 * q + r) * 256 + 64 * wc + 16 * tj + lr] = acc[ti][tj][r];
        return;
    }
    const int v = u - 256, half = v & 1, ch = v >> 1, n = ch >> 2, h = ch & 3;
    const u16* a0 = p.VrT + (((size_t)h * 128 + n) * 256 + half * 128 + (tid >> 3)) * 128 + (tid & 7) * 8;
    const u16* b0 = p.KrT + (((size_t)h * 128 + n) * 128 + (tid >> 3)) * 128 + (tid & 7) * 8;
    gemm128_main(a0, (size_t)32 * 128, 64, b0, (size_t)32 * 128, 64, 2, lds, acc);
    stage_acc(cst, acc);
    __syncthreads();
    u16* dst = p.H + (((size_t)n * 4 + h) * 256 + half * 128) * 128;
    emit_rows(cst, [&](int row, int c8, const float* vv) { *(u32x4*)(dst + (size_t)row * 128 + c8 * 8) = pack8(vv); });
    __syncthreads();
}
constexpr int P2_UNITS = 256 + 1024;

DI float gelu_tanh(float x) {
    const float u = 0.7978845608028654f * (x + 0.044715f * x * x * x);
    const float t = 1.f - 2.f / (1.f + __expf(2.f * u));
    return 0.5f * x * (1.f + t);
}
DI void p3_unit(const Params& p, int u, unsigned char* smem) {
    const int tid = TID(), lane = tid & 63, w = tid >> 6;
    const int v = u, kv = v & 1, rt = v >> 1;
    float* bias = (float*)smem;
    {
        float s = 0.f;
#pragma unroll
        for (int i = 0; i < 16; ++i) s += p.bpart[(kv * 16 + i) * 256 + tid];
        bias[tid] = s;
    }
    __syncthreads();
    const int lr = lane & 15, q = lane >> 4;
    const int R = rt * 16 + lr;
    f32x4 acc = {0.f, 0.f, 0.f, 0.f};
#pragma unroll
    for (int ks = 0; ks < 8; ++ks) {
        const int k0 = ks * 32 + q * 8;
        float hv[8];
#pragma unroll
        for (int k = 0; k < 8; ++k) hv[k] = bias[k0 + k];
#pragma unroll
        for (int s = 0; s < 4; ++s) {
            const float* sp = p.slab + ((size_t)(s * 2 + kv) * 2048 + R) * 256 + k0;
            const float4 a = *(const float4*)sp, b = *(const float4*)(sp + 4);
            hv[0] += a.x; hv[1] += a.y; hv[2] += a.z; hv[3] += a.w; hv[4] += b.x; hv[5] += b.y; hv[6] += b.z; hv[7] += b.w;
        }
#pragma unroll
        for (int k = 0; k < 8; ++k) hv[k] = gelu_tanh(hv[k]);
        const bf16x8 af = __builtin_bit_cast(bf16x8, pack8(hv));
        const bf16x8 bfr = ldf((kv ? p.W2T[1] : p.W2T[0]) + (size_t)(16 * w + lr) * 256 + k0);
        acc = MFMA16(af, bfr, acc);
    }
    const int d = 16 * w + lr;
#pragma unroll
    for (int r = 0; r < 4; ++r) {
        const int Ro = rt * 16 + 4 * q + r, c = Ro >> 1, g = Ro & 1;
        const float val = (c < 1023) ? acc[r] : 0.f;
        const u16 bv = (u16)(pack2(val, 0.f) & 0xffffu);
        if (kv == 0) p.Kc[((size_t)g * 1024 + c) * 64 + d] = bv;
        else p.VcT[(((size_t)g * 16 + (c >> 6)) * 64 + d) * 64 + (c & 63)] = bv;
    }
    __syncthreads();
}
constexpr int P3_UNITS = 256;
DI void p3_scan(const Params& p) {
    for (int idx = blockIdx.x * 256 + TID(); idx < 131072; idx += gridDim.x * 256) {
        const int h = idx >> 15;
        const float dec = __expf(128.0f * logf(1.0f - exp2f(-5.0f - (float)h)));
        u16* base = p.H + idx;
        float r0 = 0.f;
#pragma unroll 16
        for (int n = 0; n < 128; ++n) {
            u16* pp = base + (size_t)n * 131072;
            const float kv = __uint_as_float((unsigned)(*pp) << 16);
            *pp = (u16)(pack2(r0, 0.f) & 0xffffu);
            r0 = dec * r0 + kv;
        }
    }
}

constexpr int IMPS = 260;
DI void nsa_load_tile(const u16* src, u32x4 (&r)[2]) {
    r[0] = ld16(src + TID() * 8); r[1] = ld16(src + (TID() + 256) * 8);
}
DI void nsa_store_k(u16* dst, const u32x4 (&r)[2]) {
    const int c0 = TID(), r0 = c0 >> 3, r1 = r0 + 32;
    *(u32x4*)(dst + r0 * LDT + (((c0 & 7) ^ swzK(r0)) << 3)) = r[0];
    *(u32x4*)(dst + r1 * LDT + (((c0 & 7) ^ swzK(r1)) << 3)) = r[1];
}
DI void nsa_store_v(u16* dst, const u32x4 (&r)[2]) {
    const int c0 = TID(), r0 = c0 >> 3, r1 = r0 + 32;
    *(u32x4*)(dst + r0 * LDT + (((c0 & 7) ^ swzA(r0)) << 3)) = r[0];
    *(u32x4*)(dst + r1 * LDT + (((c0 & 7) ^ swzA(r1)) << 3)) = r[1];
}
DI void nsa_scores(const u16* Kt, const bf16x8 (&qf)[2][2], f32x4 (&s)[4][2]) {
    const int lane = TID() & 63, lr = lane & 15, q = lane >> 4;
#pragma unroll
    for (int kt = 0; kt < 4; ++kt) {
        const int krow = 32 * (kt >> 1) + 8 * (lr >> 2) + 4 * (kt & 1) + (lr & 3);
        s[kt][0] = f32x4{0.f, 0.f, 0.f, 0.f}; s[kt][1] = f32x4{0.f, 0.f, 0.f, 0.f};
#pragma unroll
        for (int ks = 0; ks < 2; ++ks) {
            const bf16x8 kf = ldf(Kt + krow * LDT + (((ks * 4 + q) ^ swzK(krow)) << 3));
            s[kt][0] = MFMA16(kf, qf[0][ks], s[kt][0]);
            s[kt][1] = MFMA16(kf, qf[1][ks], s[kt][1]);
        }
    }
}
DI void nsa_pv(const u16* Vt, const f32x4 (&s)[4][2], f32x4 (&o)[4][2]) {
    const int lane = TID() & 63, lr = lane & 15, q = lane >> 4;
#pragma unroll
    for (int ks2 = 0; ks2 < 2; ++ks2) {
        const bf16x8 pb0 = packf(s[2 * ks2][0], s[2 * ks2 + 1][0]);
        const bf16x8 pb1 = packf(s[2 * ks2][1], s[2 * ks2 + 1][1]);
#pragma unroll
        for (int dt = 0; dt < 4; ++dt) {
            const bf16x8 vf = ldf(Vt + (16 * dt + lr) * LDT + (((ks2 * 4 + q) ^ (lr & 7)) << 3));
            o[dt][0] = MFMA16(vf, pb0, o[dt][0]);
            o[dt][1] = MFMA16(vf, pb1, o[dt][1]);
        }
    }
}

DI void nsa_item(const Params& p, int tb, int g, unsigned char* smem) {
    u16* Kt = (u16*)smem;
    u16* Vt = Kt + 64 * LDT;
    float* imp = (float*)(smem + 2 * 64 * LDT * 2);
    int* sel = (int*)(imp + 32 * IMPS);
    const int tid = TID(), lane = tid & 63, w = tid >> 6, lr = lane & 15, q = lane >> 4;
    const int t0 = tb * 32, cur = t0 >> 6;
    const float SC = 0.125f * LOG2E;
    const float NEG = -1e30f;

    bf16x8 qf[2][2];
    int tokL[2]; float gc[2], gs[2], gw[2];
#pragma unroll
    for (int rt = 0; rt < 2; ++rt) {
        tokL[rt] = t0 + 8 * w + 4 * rt + (lr >> 2);
        const int head = 4 * g + (lr & 3);
#pragma unroll
        for (int ks = 0; ks < 2; ++ks) qf[rt][ks] = ldf(p.Qn + (size_t)tokL[rt] * 512 + head * 64 + 32 * ks + 8 * q);
        const float* gp = p.Gn + (size_t)tokL[rt] * 24 + head * 3;
        gc[rt] = gp[0]; gs[rt] = gp[1]; gw[rt] = gp[2];
    }
    f32x4 tot[4][2];
#pragma unroll
    for (int dt = 0; dt < 4; ++dt) { tot[dt][0] = f32x4{0.f, 0.f, 0.f, 0.f}; tot[dt][1] = f32x4{0.f, 0.f, 0.f, 0.f}; }

    for (int rep = (MK_PROBE & 256) ? 0 : 1; rep < 2; ++rep) {
        float m[2] = {NEG, NEG}, l[2] = {0.f, 0.f};
        f32x4 o[4][2];
#pragma unroll
        for (int dt = 0; dt < 4; ++dt) { o[dt][0] = f32x4{0.f, 0.f, 0.f, 0.f}; o[dt][1] = f32x4{0.f, 0.f, 0.f, 0.f}; }
        const int kb_lo = (t0 > 511 ? t0 - 511 : 0) >> 6, kb_hi = cur;
        u32x4 rk[2], rv[2];
        nsa_load_tile(p.Kw + ((size_t)g * S_ + kb_lo * 64) * 64, rk);
        nsa_load_tile(p.VwT + ((size_t)g * 256 + kb_lo) * 4096, rv);
        for (int kb = kb_lo; kb <= kb_hi; ++kb) {
            __syncthreads();
            nsa_store_k(Kt, rk); nsa_store_v(Vt, rv);
            __syncthreads();
            if (kb < kb_hi) {
                nsa_load_tile(p.Kw + ((size_t)g * S_ + (kb + 1) * 64) * 64, rk);
                nsa_load_tile(p.VwT + ((size_t)g * 256 + kb + 1) * 4096, rv);
            }
            f32x4 s[4][2];
            nsa_scores(Kt, qf, s);
#pragma unroll
            for (int rt = 0; rt < 2; ++rt) {
                const int t = tokL[rt];
                float mx = NEG;
#pragma unroll
                for (int kt = 0; kt < 4; ++kt)
#pragma unroll
                    for (int r = 0; r < 4; ++r) {
                        const int key = kb * 64 + 32 * (kt >> 1) + 8 * q + 4 * (kt & 1) + r;
                        const bool ok = (key <= t) && (key > t - 512);
                        const float v = ok ? s[kt][rt][r] * SC : NEG;
                        s[kt][rt][r] = v; mx = fmaxf(mx, v);
                    }
                mx = fmaxf(mx, __shfl_xor(mx, 16)); mx = fmaxf(mx, __shfl_xor(mx, 32));
                const float mn = fmaxf(m[rt], mx), alpha = ex2(m[rt] - mn);
                float rs = 0.f;
#pragma unroll
                for (int kt = 0; kt < 4; ++kt)
#pragma unroll
                    for (int r = 0; r < 4; ++r) {
                        const float v = s[kt][rt][r];
                        const float pv = (v > -1e29f) ? ex2(v - mn) : 0.f;
                        s[kt][rt][r] = pv; rs += pv;
                    }
                l[rt] = l[rt] * alpha + rs; m[rt] = mn;
#pragma unroll
                for (int dt = 0; dt < 4; ++dt) o[dt][rt] *= alpha;
            }
            nsa_pv(Vt, s, o);
        }
#pragma unroll
        for (int rt = 0; rt < 2; ++rt) {
            float lt = l[rt]; lt += __shfl_xor(lt, 16); lt += __shfl_xor(lt, 32);
            const float f = (rep == 1) ? gw[rt] / fmaxf(lt, 1e-37f) : 0.f;
#pragma unroll
            for (int dt = 0; dt < 4; ++dt) tot[dt][rt] += o[dt][rt] * f;
        }
    }

    for (int rep = (MK_PROBE & 512) ? 0 : 1; rep < 2; ++rep) {
        const int nct = ((t0 >> 4) >> 6) + 1;
        int cmaxv[2]; cmaxv[0] = (tokL[0] - 31) >> 4; cmaxv[1] = (tokL[1] - 31) >> 4;
        float m[2] = {NEG, NEG}, l[2] = {0.f, 0.f};
        u32x4 rk[2], rv[2];
        nsa_load_tile(p.Kc + ((size_t)g * 1024) * 64, rk);
        for (int ct = 0; ct < nct; ++ct) {
            __syncthreads();
            nsa_store_k(Kt, rk);
            __syncthreads();
            if (ct + 1 < nct) nsa_load_tile(p.Kc + ((size_t)g * 1024 + (ct + 1) * 64) * 64, rk);
            f32x4 s[4][2];
            nsa_scores(Kt, qf, s);
#pragma unroll
            for (int rt = 0; rt < 2; ++rt) {
                float mx = NEG;
#pragma unroll
                for (int kt = 0; kt < 4; ++kt)
#pragma unroll
                    for (int r = 0; r < 4; ++r) {
                        const int c = ct * 64 + 32 * (kt >> 1) + 8 * q + 4 * (kt & 1) + r;
                        const float v = (c <= cmaxv[rt]) ? s[kt][rt][r] * SC : NEG;
                        s[kt][rt][r] = v; mx = fmaxf(mx, v);
                    }
                mx = fmaxf(mx, __shfl_xor(mx, 16)); mx = fmaxf(mx, __shfl_xor(mx, 32));
                const float mn = fmaxf(m[rt], mx), alpha = ex2(m[rt] - mn);
                float rs = 0.f;
#pragma unroll
                for (int kt = 0; kt < 4; ++kt)
#pragma unroll
                    for (int r = 0; r < 4; ++r) { const float v = s[kt][rt][r]; rs += (v > -1e29f) ? ex2(v - mn) : 0.f; }
                l[rt] = l[rt] * alpha + rs; m[rt] = mn;
            }
        }
        float linv[2];
#pragma unroll
        for (int rt = 0; rt < 2; ++rt) {
            float lt = l[rt]; lt += __shfl_xor(lt, 16); lt += __shfl_xor(lt, 32);
            linv[rt] = 1.f / fmaxf(lt, 1e-37f);
        }
        f32x4 o[4][2];
#pragma unroll
        for (int dt = 0; dt < 4; ++dt) { o[dt][0] = f32x4{0.f, 0.f, 0.f, 0.f}; o[dt][1] = f32x4{0.f, 0.f, 0.f, 0.f}; }
        float carry[2] = {0.f, 0.f};
        nsa_load_tile(p.Kc + ((size_t)g * 1024) * 64, rk);
        nsa_load_tile(p.VcT + ((size_t)g * 16) * 4096, rv);
        for (int ct = 0; ct < nct; ++ct) {
            __syncthreads();
            nsa_store_k(Kt, rk); nsa_store_v(Vt, rv);
            __syncthreads();
            if (ct + 1 < nct) {
                nsa_load_tile(p.Kc + ((size_t)g * 1024 + (ct + 1) * 64) * 64, rk);
                nsa_load_tile(p.VcT + ((size_t)g * 16 + ct + 1) * 4096, rv);
            }
            f32x4 s[4][2];
            nsa_scores(Kt, qf, s);
#pragma unroll
            for (int rt = 0; rt < 2; ++rt) {
#pragma unroll
                for (int kt = 0; kt < 4; ++kt)
#pragma unroll
                    for (int r = 0; r < 4; ++r) {
                        const int c = ct * 64 + 32 * (kt >> 1) + 8 * q + 4 * (kt & 1) + r;
                        s[kt][rt][r] = (c <= cmaxv[rt]) ? ex2(s[kt][rt][r] * SC - m[rt]) * linv[rt] : 0.f;
                    }
                const float up1 = __shfl_up(s[1][rt][3], 16), up3 = __shfl_up(s[3][rt][3], 16);
                const float w1 = __shfl(s[1][rt][3], lr + 48), w3 = __shfl(s[3][rt][3], lr + 48);
                float e[4];
                e[0] = s[0][rt][0] + s[0][rt][1] + s[0][rt][2] + s[0][rt][3] + (q > 0 ? up1 : carry[rt]);
                e[1] = s[1][rt][0] + s[1][rt][1] + s[1][rt][2] + s[1][rt][3] + s[0][rt][3];
                e[2] = s[2][rt][0] + s[2][rt][1] + s[2][rt][2] + s[2][rt][3] + (q > 0 ? up3 : w1);
                e[3] = s[3][rt][0] + s[3][rt][1] + s[3][rt][2] + s[3][rt][3] + s[2][rt][3];
                carry[rt] = w3;
#pragma unroll
                for (int kt = 0; kt < 4; ++kt) {
                    float ev = e[kt];
                    ev += __shfl_xor(ev, 1); ev += __shfl_xor(ev, 2);
                    if ((lr & 3) == 0) imp[(8 * w + 4 * rt + (lr >> 2)) * IMPS + ct * 16 + 8 * (kt >> 1) + 2 * q + (kt & 1)] = ev;
                }
            }
            nsa_pv(Vt, s, o);
        }
#pragma unroll
        for (int rt = 0; rt < 2; ++rt)
#pragma unroll
            for (int dt = 0; dt < 4; ++dt) tot[dt][rt] += o[dt][rt] * ((rep == 1) ? gc[rt] : 0.f);
    }
    __syncthreads();

    for (int rep = (MK_PROBE & 1024) ? 0 : 1; rep < 2; ++rep)
    for (int tk = 0; tk < 8; ++tk) {
        const int tl = 8 * w + tk;
        float v[4];
#pragma unroll
        for (int i = 0; i < 4; ++i) {
            const int j = lane + 64 * i;
            const bool cand = (j <= cur) && (j != 0) && (j != cur) && (j != cur - 1);
            v[i] = cand ? imp[tl * IMPS + j] : -1.f;
        }
        int selv = -1;
        if (lane == 0) selv = 0;
        if (cur > 0 && lane == 1) selv = cur;
        if (cur > 1 && lane == 2) selv = cur - 1;
        const int nforced = 1 + (cur > 0 ? 1 : 0) + (cur > 1 ? 1 : 0);
        for (int it = nforced; it < 16; ++it) {
            const float lm = fmaxf(fmaxf(v[0], v[1]), fmaxf(v[2], v[3]));
            const float wm = wave_max(lm);
            if (wm < 0.f) break;
            int jstar;
            const unsigned long long b0 = __ballot(v[0] == wm);
            if (b0) { const int ow = __builtin_ctzll(b0); jstar = ow; if (lane == ow) v[0] = -1.f; }
            else {
                const unsigned long long b1 = __ballot(v[1] == wm);
                if (b1) { const int ow = __builtin_ctzll(b1); jstar = ow + 64; if (lane == ow) v[1] = -1.f; }
                else {
                    const unsigned long long b2 = __ballot(v[2] == wm);
                    if (b2) { const int ow = __builtin_ctzll(b2); jstar = ow + 128; if (lane == ow) v[2] = -1.f; }
                    else { const unsigned long long b3 = __ballot(v[3] == wm); if (!b3) break; const int ow = __builtin_ctzll(b3); jstar = ow + 192; if (lane == ow) v[3] = -1.f; }
                }
            }
            if (lane == it) selv = jstar;
        }
        if (lane < 16) sel[tl * 16 + lane] = selv;
    }
    __syncthreads();

    {
        unsigned* bmask = (unsigned*)(sel + 32 * 16);
        int* blist = (int*)(bmask + 256);
        bmask[tid] = 0u;
        __syncthreads();
        for (int e = tid; e < 512; e += 256) { const int j = sel[e]; if (j >= 0) atomicOr(&bmask[j], 1u << (e >> 4)); }
        __syncthreads();
        if (w == 0) {
            int base = 0;
#pragma unroll
            for (int i = 0; i < 4; ++i) {
                const int j = lane + 64 * i;
                const bool nz = bmask[j] != 0u;
                const unsigned long long b = __ballot(nz);
                const int pre = __builtin_popcountll(b & ((1ull << lane) - 1ull));
                if (nz) blist[base + pre] = j;
                base += __builtin_popcountll(b);
            }
            if (lane == 0) blist[256] = base;
        }
        __syncthreads();
        const int nl = blist[256];
        for (int rep = (MK_PROBE & (2048 | 16384)) ? 0 : 1; rep < 2; ++rep) {
        u16* Kb0 = Kt;            u16* Vb0 = Vt;
        u16* Kb1 = (u16*)imp;     u16* Vb1 = Kb1 + 64 * LDT;
        float m[2] = {NEG, NEG}, l[2] = {0.f, 0.f};
        f32x4 o[4][2];
#pragma unroll
        for (int dt = 0; dt < 4; ++dt) { o[dt][0] = f32x4{0.f, 0.f, 0.f, 0.f}; o[dt][1] = f32x4{0.f, 0.f, 0.f, 0.f}; }
        u32x4 rkA[2], rvA[2], rkB[2], rvB[2];
        auto gload = [&](int idx, u32x4 (&rk)[2], u32x4 (&rv)[2]) {
            const int j = blist[idx];
            nsa_load_tile(p.Ks + ((size_t)g * S_ + (size_t)j * 64) * 64, rk);
            nsa_load_tile(p.VsT + ((size_t)g * 256 + j) * 4096, rv);
        };
        auto sel_rt = [&](auto RT, const u16* Kb, const u16* Vb, int j, unsigned mk) {
            constexpr int rt = decltype(RT)::value;
            f32x4 s[4];
#pragma unroll
            for (int kt = 0; kt < 4; ++kt) {
                const int krow = 32 * (kt >> 1) + 8 * (lr >> 2) + 4 * (kt & 1) + (lr & 3);
                s[kt] = f32x4{0.f, 0.f, 0.f, 0.f};
#pragma unroll
                for (int ks = 0; ks < 2; ++ks) s[kt] = MFMA16(ldf(Kb + krow * LDT + (((ks * 4 + q) ^ swzK(krow)) << 3)), qf[rt][ks], s[kt]);
            }
            const bool mine = ((mk >> (8 * w + 4 * rt + (lr >> 2))) & 1u) != 0u;
            float mx = NEG;
            if (j == cur) {
                const int dlim = mine ? (tokL[rt] - j * 64 - 8 * q) : -1;
#pragma unroll
                for (int kt = 0; kt < 4; ++kt)
#pragma unroll
                    for (int r = 0; r < 4; ++r) {
                        const float v = (32 * (kt >> 1) + 4 * (kt & 1) + r <= dlim) ? s[kt][r] * SC : NEG;
                        s[kt][r] = v; mx = fmaxf(mx, v);
                    }
                mx = fmaxf(mx, __shfl_xor(mx, 16)); mx = fmaxf(mx, __shfl_xor(mx, 32));
                const float mn = fmaxf(m[rt], mx), alpha = ex2(m[rt] - mn);
                float rs = 0.f;
#pragma unroll
                for (int kt = 0; kt < 4; ++kt)
#pragma unroll
                    for (int r = 0; r < 4; ++r) {
                        const float v = s[kt][r];
                        const float pv = (v > -1e29f) ? ex2(v - mn) : 0.f;
                        s[kt][r] = pv; rs += pv;
                    }
                l[rt] = l[rt] * alpha + rs; m[rt] = mn;
#pragma unroll
                for (int dt = 0; dt < 4; ++dt) o[dt][rt] *= alpha;
            } else {
#pragma unroll
                for (int kt = 0; kt < 4; ++kt) mx = fmaxf(fmaxf(mx, fmaxf(s[kt][0], s[kt][1])), fmaxf(s[kt][2], s[kt][3]));
                mx = mine ? mx * SC : NEG;
                mx = fmaxf(mx, __shfl_xor(mx, 16)); mx = fmaxf(mx, __shfl_xor(mx, 32));
                const float mn = fmaxf(m[rt], mx), alpha = ex2(m[rt] - mn);
                const float nb = mine ? -mn : NEG;
                float rs = 0.f;
#pragma unroll
                for (int kt = 0; kt < 4; ++kt)
#pragma unroll
                    for (int r = 0; r < 4; ++r) { const float pv = ex2(fmaf(s[kt][r], SC, nb)); s[kt][r] = pv; rs += pv; }
                l[rt] = l[rt] * alpha + rs; m[rt] = mn;
#pragma unroll
                for (int dt = 0; dt < 4; ++dt) o[dt][rt] *= alpha;
            }
#pragma unroll
            for (int ks2 = 0; ks2 < 2; ++ks2) {
                const bf16x8 pb = packf(s[2 * ks2], s[2 * ks2 + 1]);
#pragma unroll
                for (int dt = 0; dt < 4; ++dt) o[dt][rt] = MFMA16(ldf(Vb + (16 * dt + lr) * LDT + (((ks2 * 4 + q) ^ (lr & 7)) << 3)), pb, o[dt][rt]);
            }
        };
        auto compute = [&](const u16* Kb, const u16* Vb, int j) {
            if ((MK_PROBE & 16384) && rep == 0) return;
            const unsigned mk = bmask[j];
            const unsigned wb = (mk >> (8 * w)) & 0xffu;
            if (wb & 0x0fu) sel_rt(IC<0>{}, Kb, Vb, j, mk);
            if (wb & 0xf0u) sel_rt(IC<1>{}, Kb, Vb, j, mk);
        };
        gload(0, rkA, rvA);
        nsa_store_k(Kb0, rkA); nsa_store_v(Vb0, rvA);
        gload(min(1, nl - 1), rkB, rvB);
        __syncthreads();
        for (int i = 0; i < nl; i += 2) {
            gload(min(i + 2, nl - 1), rkA, rvA);
            compute(Kb0, Vb0, blist[i]);
            nsa_store_k(Kb1, rkB); nsa_store_v(Vb1, rvB);
            __syncthreads();
            gload(min(i + 3, nl - 1), rkB, rvB);
            if (i + 1 < nl) compute(Kb1, Vb1, blist[i + 1]);
            nsa_store_k(Kb0, rkA); nsa_store_v(Vb0, rvA);
            __syncthreads();
        }
#pragma unroll
        for (int rt = 0; rt < 2; ++rt) {
            float lt = l[rt]; lt += __shfl_xor(lt, 16); lt += __shfl_xor(lt, 32);
            const float f = (rep == 1) ? gs[rt] / fmaxf(lt, 1e-37f) : 0.f;
#pragma unroll
            for (int dt = 0; dt < 4; ++dt) tot[dt][rt] += o[dt][rt] * f;
        }
        __syncthreads();
        }
    }

#pragma unroll
    for (int rt = 0; rt < 2; ++rt) {
        const int head = 4 * g + (lr & 3);
#pragma unroll
        for (int dt = 0; dt < 4; ++dt) {
            const size_t off = (size_t)tokL[rt] * 512 + head * 64 + 16 * dt + 4 * q;
            const u32x2 z = *(const u32x2*)(p.SZn + off);
            u32x2 o2;
            o2[0] = pack2(tot[dt][rt][0] * bflo(z[0]), tot[dt][rt][1] * bfhi(z[0]));
            o2[1] = pack2(tot[dt][rt][2] * bflo(z[1]), tot[dt][rt][3] * bfhi(z[1]));
            *(u32x2*)(p.Qn + off) = o2;
        }
    }
    __syncthreads();
}

DI void ret_item(const Params& p, int n, int h, bool dowrite) {
    const int lane = TID() & 63, w = TID() >> 6, lr = lane & 15, q = lane >> 4;
    const float lg2 = logf(1.0f - exp2f(-5.0f - (float)h)) * LOG2E;
    const u16* rbase = p.H + (((size_t)n * 4 + h) * 256) * 128;
    const u16* kbase = p.Kr + ((size_t)h * S_ + n * 128) * 128;
    const u16* vbase = p.VrT + (((size_t)h * 128 + n) * 256) * 128;
    const u16* rlane = rbase + lr * 128 + 8 * q;
    const u16* vlane = vbase + lr * 128 + 8 * q;
#pragma unroll 1
    for (int it = 0; it < 2; ++it) {
        const int i = 32 * w + 16 * it + lr;
        bf16x8 qf[4];
#pragma unroll
        for (int ks = 0; ks < 4; ++ks) qf[ks] = ldf(p.Qr + ((size_t)h * S_ + n * 128 + i) * 128 + 32 * ks + 8 * q);
        f32x4 acc[16];
#pragma unroll
        for (int et = 0; et < 16; ++et) acc[et] = f32x4{0.f, 0.f, 0.f, 0.f};
#pragma unroll
        for (int et = 0; et < 16; ++et) {
            const u16* pe = rlane + et * 16 * 128; asm volatile("" : "+v"(pe));
#pragma unroll
            for (int ks = 0; ks < 4; ++ks) acc[et] = MFMA16(ldf(pe + 32 * ks), qf[ks], acc[et]);
        }
        {
            const float qd = ex2((float)(i + 1) * lg2);
#pragma unroll
            for (int et = 0; et < 16; ++et) acc[et] *= qd;
        }
        for (int jk = 0; jk <= w; ++jk) {
            f32x4 s[2];
#pragma unroll
            for (int jj = 0; jj < 2; ++jj) {
                const int krow = 32 * jk + 8 * (lr >> 2) + 4 * jj + (lr & 3);
                s[jj] = f32x4{0.f, 0.f, 0.f, 0.f};
#pragma unroll
                for (int ks = 0; ks < 4; ++ks) s[jj] = MFMA16(ldf(kbase + (size_t)krow * 128 + 32 * ks + 8 * q), qf[ks], s[jj]);
            }
#pragma unroll
            for (int jj = 0; jj < 2; ++jj)
#pragma unroll
                for (int r = 0; r < 4; ++r) {
                    const int j = 32 * jk + 8 * q + 4 * jj + r;
                    s[jj][r] = (i >= j) ? s[jj][r] * ex2((float)(i - j) * lg2) : 0.f;
                }
            const bf16x8 pb = packf(s[0], s[1]);
#pragma unroll
            for (int et = 0; et < 16; ++et) {
                const u16* pe = vlane + et * 16 * 128 + 32 * jk; asm volatile("" : "+v"(pe));
                acc[et] = MFMA16(ldf(pe), pb, acc[et]);
            }
        }
        float sm = 0.f;
#pragma unroll
        for (int et = 0; et < 16; ++et) sm += acc[et][0] + acc[et][1] + acc[et][2] + acc[et][3];
        sm += __shfl_xor(sm, 16); sm += __shfl_xor(sm, 32);
        const float mu = sm * (1.f / 256.f);
        float vs = 0.f;
#pragma unroll
        for (int et = 0; et < 16; ++et)
#pragma unroll
            for (int r = 0; r < 4; ++r) { const float d = acc[et][r] - mu; vs += d * d; }
        vs += __shfl_xor(vs, 16); vs += __shfl_xor(vs, 32);
        const float rs = rsqrtf(vs * (1.f / 256.f) + 1e-6f);
        u16* zlane = p.SZr + ((size_t)n * 128 + i) * 1024 + h * 256 + 4 * q;
#pragma unroll
        for (int et = 0; et < 16; ++et) {
            u16* zp = zlane + 16 * et; asm volatile("" : "+v"(zp));
            const u32x2 z = *(const u32x2*)zp;
            u32x2 o2;
            o2[0] = pack2((acc[et][0] - mu) * rs * bflo(z[0]), (acc[et][1] - mu) * rs * bfhi(z[0]));
            o2[1] = pack2((acc[et][2] - mu) * rs * bflo(z[1]), (acc[et][3] - mu) * rs * bfhi(z[1]));
            if (dowrite) *(u32x2*)zp = o2;
        }
    }
}

DI void p5_tile(const Params& p, int t, unsigned char* smem) {
    const int tid = TID();
    const int nt = t >> 7, mt = t & 127, tok0 = mt * 128;
    u16* lds = (u16*)smem; float* cst = (float*)smem;
    float* hold = (float*)p.H + (size_t)blockIdx.x * 16384;
    {
        f32x4 acc[4][4]; zero_acc(acc);
        gemm128_main(p.Qn + (size_t)(tok0 + (tid >> 3)) * 512 + (tid & 7) * 8, (size_t)32 * 512, 64,
                     p.WnoT + (size_t)(nt * 128 + (tid >> 3)) * 512 + (tid & 7) * 8, (size_t)32 * 512, 64, 8, lds, acc);
        stage_acc(cst, acc);
    }
    __syncthreads();
    emit_rows(cst, [&](int row, int c8, const float* v) {
        const u32x4 gm = ld16(p.Ma + (size_t)(tok0 + row) * 1024 + nt * 128 + c8 * 8);
        float4 a, b;
        a.x = v[0] * bflo(gm[0]); a.y = v[1] * bfhi(gm[0]); a.z = v[2] * bflo(gm[1]); a.w = v[3] * bfhi(gm[1]);
        b.x = v[4] * bflo(gm[2]); b.y = v[5] * bfhi(gm[2]); b.z = v[6] * bflo(gm[3]); b.w = v[7] * bfhi(gm[3]);
        *(float4*)(hold + row * 128 + c8 * 8) = a; *(float4*)(hold + row * 128 + c8 * 8 + 4) = b; });
    __syncthreads();
    {
        f32x4 acc[4][4]; zero_acc(acc);
        gemm128_main(p.SZr + (size_t)(tok0 + (tid >> 3)) * 1024 + (tid & 7) * 8, (size_t)32 * 1024, 64,
                     p.WroT + (size_t)(nt * 128 + (tid >> 3)) * 1024 + (tid & 7) * 8, (size_t)32 * 1024, 64, 16, lds, acc);
        stage_acc(cst, acc);
    }
    __syncthreads();
    u16* Mg = p.Qr;
    emit_rows(cst, [&](int row, int c8, const float* v) {
        const u32x4 gm = ld16(p.Mb + (size_t)(tok0 + row) * 1024 + nt * 128 + c8 * 8);
        const float4 a = *(const float4*)(hold + row * 128 + c8 * 8), b = *(const float4*)(hold + row * 128 + c8 * 8 + 4);
        float o[8];
        o[0] = a.x + v[0] * bflo(gm[0]); o[1] = a.y + v[1] * bfhi(gm[0]); o[2] = a.z + v[2] * bflo(gm[1]); o[3] = a.w + v[3] * bfhi(gm[1]);
        o[4] = b.x + v[4] * bflo(gm[2]); o[5] = b.y + v[5] * bfhi(gm[2]); o[6] = b.z + v[6] * bflo(gm[3]); o[7] = b.w + v[7] * bfhi(gm[3]);
        *(u32x4*)(Mg + (size_t)(tok0 + row) * 1024 + nt * 128 + c8 * 8) = pack8(o); });
    __syncthreads();
}

DI void p6_tile(const Params& p, int t, unsigned char* smem) {
    const int tid = TID();
    const int nt = t >> 7, mt = t & 127, tok0 = mt * 128;
    u16* lds = (u16*)smem; float* cst = (float*)smem;
    const u16* Mg = p.Qr; u16* Y2 = p.VrT;
    {
        f32x4 acc[4][4]; zero_acc(acc);
        gemm128_main(Mg + (size_t)(tok0 + (tid >> 3)) * 1024 + (tid & 7) * 8, (size_t)32 * 1024, 64,
                     p.WoutT + (size_t)(nt * 128 + (tid >> 3)) * 1024 + (tid & 7) * 8, (size_t)32 * 1024, 64, 16, lds, acc);
        stage_acc(cst, acc);
    }
    __syncthreads();
    emit_rows(cst, [&](int row, int c8, const float* v) {
        *(u32x4*)(Y2 + (size_t)(tok0 + row) * 1024 + nt * 128 + c8 * 8) = pack8(v);
        float ss = 0.f;
#pragma unroll
        for (int k = 0; k < 8; ++k) ss += v[k] * v[k];
        ss += __shfl_xor(ss, 1); ss += __shfl_xor(ss, 2); ss += __shfl_xor(ss, 4); ss += __shfl_xor(ss, 8);
        if (c8 == 0) p.rowss[(size_t)(tok0 + row) * 8 + nt] = ss; });
    __syncthreads();
}

DI void p7_all(const Params& p) {
    const u16* Y2 = p.VrT;
    const size_t n4 = (size_t)S_ * 256;
    for (size_t i = (size_t)blockIdx.x * 256 + TID(); i < n4; i += (size_t)gridDim.x * 256) {
        const size_t row = i >> 8; const int c4 = (int)(i & 255);
        const float4 a = *(const float4*)(p.rowss + row * 8), b = *(const float4*)(p.rowss + row * 8 + 4);
        const float ss = ((a.x + a.y) + (a.z + a.w)) + ((b.x + b.y) + (b.z + b.w));
        const float rs = rsqrtf(ss * (1.f / 1024.f) + 1e-6f);
        const float4 xv = *(const float4*)(p.x + i * 4);
        const float4 gv = *(const float4*)(p.norm_post + c4 * 4);
        const u32x2 y = *(const u32x2*)(Y2 + i * 4);
        float4 o;
        o.x = xv.x + bflo(y[0]) * rs * gv.x; o.y = xv.y + bfhi(y[0]) * rs * gv.y;
        o.z = xv.z + bflo(y[1]) * rs * gv.z; o.w = xv.w + bfhi(y[1]) * rs * gv.w;
        *(float4*)(p.out + i * 4) = o;
    }
}

#ifndef MK_PROBE
#define MK_PROBE 0
#endif
constexpr size_t al256(size_t x) { return (x + 255) & ~(size_t)255; }
constexpr size_t O_BAR   = 0;
constexpr size_t O_WINT  = O_BAR   + 16384;
constexpr size_t O_WNOT  = O_WINT  + al256((size_t)NPAD_ * 1024 * 2);
constexpr size_t O_WROT  = O_WNOT  + (size_t)1024 * 512 * 2;
constexpr size_t O_WOUTT = O_WROT  + (size_t)1024 * 1024 * 2;
constexpr size_t O_W1T0  = O_WOUTT + (size_t)1024 * 1024 * 2;
constexpr size_t O_W1T1  = O_W1T0  + (size_t)256 * 2048 * 2;
constexpr size_t O_W2T0  = O_W1T1  + (size_t)256 * 2048 * 2;
constexpr size_t O_W2T1  = O_W2T0  + (size_t)64 * 256 * 2;
constexpr size_t O_BPART = O_W2T1  + (size_t)64 * 256 * 2;
constexpr size_t O_ROPEN = O_BPART + (size_t)2 * 16 * 256 * 4;
constexpr size_t O_ROPER = O_ROPEN + (size_t)S_ * 8 * 8;
constexpr size_t O_H     = O_ROPER + (size_t)S_ * 64 * 8;
constexpr size_t O_QN    = O_H     + (size_t)S_ * 1024 * 2;
constexpr size_t O_RAW0  = O_QN    + (size_t)S_ * 512 * 2;
constexpr size_t O_RAW1  = O_RAW0  + (size_t)S_ * 128 * 2;
constexpr size_t O_KS    = O_RAW1  + (size_t)S_ * 128 * 2;
constexpr size_t O_VST   = O_KS    + (size_t)2 * S_ * 64 * 2;
constexpr size_t O_KW    = O_VST   + (size_t)2 * S_ * 64 * 2;
constexpr size_t O_VWT   = O_KW    + (size_t)2 * S_ * 64 * 2;
constexpr size_t O_SZN   = O_VWT   + (size_t)2 * S_ * 64 * 2;
constexpr size_t O_QR    = O_SZN   + (size_t)S_ * 512 * 2;
constexpr size_t O_KR    = O_QR    + (size_t)4 * S_ * 128 * 2;
constexpr size_t O_KRT   = O_KR    + (size_t)4 * S_ * 128 * 2;
constexpr size_t O_VRT   = O_KRT   + (size_t)4 * S_ * 128 * 2;
constexpr size_t O_SZR   = O_VRT   + (size_t)4 * S_ * 256 * 2;
constexpr size_t O_GN    = O_SZR   + (size_t)S_ * 1024 * 2;
constexpr size_t O_SLAB  = O_GN    + (size_t)S_ * 24 * 4;
constexpr size_t O_KC    = O_SLAB  + (size_t)4 * 2 * 2048 * 256 * 4;
constexpr size_t O_VCT   = O_KC    + (size_t)2 * 1024 * 64 * 2;
constexpr size_t O_ROWSS = O_VCT   + (size_t)2 * 1024 * 64 * 2;
constexpr size_t WS_BYTES = O_ROWSS + (size_t)S_ * 8 * 4;

struct KArgs {
    const float *x, *norm_pre, *w_in, *b_gate, *pe_k, *w1_k, *w2_k, *pe_v, *w1_v, *w2_v, *w_nsa_o, *w_ret_o, *w_out, *norm_post;
    float* out; char* ws; int use_cg; int probe;
};

__global__ void __launch_bounds__(256, 2) fwd_megakernel(KArgs ka) {
    Params p;
    p.x = ka.x; p.norm_pre = ka.norm_pre; p.w_in = ka.w_in; p.b_gate = ka.b_gate; p.pe_k = ka.pe_k; p.w1_k = ka.w1_k; p.w2_k = ka.w2_k;
    p.pe_v = ka.pe_v; p.w1_v = ka.w1_v; p.w2_v = ka.w2_v; p.w_nsa_o = ka.w_nsa_o; p.w_ret_o = ka.w_ret_o; p.w_out = ka.w_out; p.norm_post = ka.norm_post;
    p.out = ka.out; p.use_cg = ka.use_cg; p.probe = ka.probe;
    {
        char* ws = ka.ws;
        p.bar = (unsigned*)(ws + O_BAR);
        p.WinT = (u16*)(ws + O_WINT); p.WnoT = (u16*)(ws + O_WNOT); p.WroT = (u16*)(ws + O_WROT); p.WoutT = (u16*)(ws + O_WOUTT);
        p.W1T[0] = (u16*)(ws + O_W1T0); p.W1T[1] = (u16*)(ws + O_W1T1); p.W2T[0] = (u16*)(ws + O_W2T0); p.W2T[1] = (u16*)(ws + O_W2T1);
        p.bpart = (float*)(ws + O_BPART); p.ropeN = (float2*)(ws + O_ROPEN); p.ropeR = (float2*)(ws + O_ROPER);
        p.H = (u16*)(ws + O_H); p.Qn = (u16*)(ws + O_QN); p.Raw[0] = (u16*)(ws + O_RAW0); p.Raw[1] = (u16*)(ws + O_RAW1);
        p.Ks = (u16*)(ws + O_KS); p.VsT = (u16*)(ws + O_VST); p.Kw = (u16*)(ws + O_KW); p.VwT = (u16*)(ws + O_VWT);
        p.SZn = (u16*)(ws + O_SZN); p.Qr = (u16*)(ws + O_QR); p.Kr = (u16*)(ws + O_KR); p.KrT = (u16*)(ws + O_KRT); p.VrT = (u16*)(ws + O_VRT);
        p.SZr = (u16*)(ws + O_SZR); p.Gn = (float*)(ws + O_GN); p.slab = (float*)(ws + O_SLAB); p.Kc = (u16*)(ws + O_KC); p.VcT = (u16*)(ws + O_VCT);
        p.rowss = (float*)(ws + O_ROWSS);
        p.Ma = (u16*)ka.out; p.Mb = (u16*)ka.out + (size_t)S_ * 1024;
    }
    __shared__ __attribute__((aligned(16))) unsigned char smem[69632];
    __shared__ uint4 xb_words;
    if (threadIdx.x == 0) xb_words = make_uint4(0u, 0u, 0u, 0u);
    __syncthreads();
    XcdBarrier b = xcd_barrier_post(p.bar, (volatile LAS unsigned*)&xb_words);
    const int G = gridDim.x, B = blockIdx.x;
#define GRID_SYNC() do { if (p.use_cg) cg::this_grid().sync(); else xcd_barrier(b); } while (0)

    for (int rep = (MK_PROBE & 1) ? 0 : 1; rep < 2; ++rep)
    for (int u = B; u < P0_UNITS; u += G) p0_unit(p, u, smem);
    GRID_SYNC();
    for (int rep = (MK_PROBE & 2) ? 0 : 1; rep < 2; ++rep)
    for (int t = B; t < 55 * 128; t += G) p1_tile(p, t, smem);
    GRID_SYNC();
    for (int rep = (MK_PROBE & 4) ? 0 : 1; rep < 2; ++rep)
    for (int u = B; u < P2_UNITS; u += G) p2_unit(p, u, smem);
    GRID_SYNC();
    for (int rep = (MK_PROBE & 8) ? 0 : 1; rep < 2; ++rep)
    for (int u = B; u < P3_UNITS; u += G) p3_unit(p, u, smem);
    p3_scan(p);
    GRID_SYNC();
    for (int u = B; u < 1536; u += G) {
        if (u < 1024) nsa_item(p, (u < 512) ? 511 - (u >> 1) : ((u - 512) >> 1), u & 1, smem);
        else { if (MK_PROBE & 4096) ret_item(p, (u - 1024) >> 2, (u - 1024) & 3, false); ret_item(p, (u - 1024) >> 2, (u - 1024) & 3, true); }
    }
    GRID_SYNC();
    for (int rep = (MK_PROBE & 16) ? 0 : 1; rep < 2; ++rep)
    for (int t = B; t < 1024; t += G) p5_tile(p, t, smem);
    GRID_SYNC();
    for (int rep = (MK_PROBE & 32) ? 0 : 1; rep < 2; ++rep)
    for (int t = B; t < 1024; t += G) p6_tile(p, t, smem);
    GRID_SYNC();
    for (int rep = (MK_PROBE & 64) ? 0 : 1; rep < 2; ++rep)
    p7_all(p);
}

extern "C" void kernel_launch(void* const* d_in, const int* in_sizes, int n_in, void* d_out, int out_size,
                              void* d_ws, size_t ws_size, hipStream_t stream) {
    static int grid_blocks = 0;
    if (!grid_blocks) {
        int dev = 0, cus = 0, per_cu = 0;
        (void)hipGetDevice(&dev);
        (void)hipDeviceGetAttribute(&cus, hipDeviceAttributeMultiprocessorCount, dev);
        (void)hipOccupancyMaxActiveBlocksPerMultiprocessor(&per_cu, fwd_megakernel, 256, 0);
        if (per_cu > 2) per_cu = 2;
        if (per_cu < 1) per_cu = 1;
        grid_blocks = cus * per_cu;
    }
    KArgs ka{};
    ka.x = (const float*)d_in[0]; ka.norm_pre = (const float*)d_in[1]; ka.w_in = (const float*)d_in[2]; ka.b_gate = (const float*)d_in[3];
    ka.pe_k = (const float*)d_in[4]; ka.w1_k = (const float*)d_in[5]; ka.w2_k = (const float*)d_in[6];
    ka.pe_v = (const float*)d_in[7]; ka.w1_v = (const float*)d_in[8]; ka.w2_v = (const float*)d_in[9];
    ka.w_nsa_o = (const float*)d_in[10]; ka.w_ret_o = (const float*)d_in[11]; ka.w_out = (const float*)d_in[12]; ka.norm_post = (const float*)d_in[13];
    ka.out = (float*)d_out; ka.ws = (char*)d_ws; ka.use_cg = 0; ka.probe = MK_PROBE;
    if (WS_BYTES > ws_size) { fprintf(stderr, "workspace too small: need %zu have %zu\n", (size_t)WS_BYTES, ws_size); return; }
    (void)hipMemsetAsync(d_ws, 0, XCD_BAR_WORDS * 4, stream);
    void* args[] = {&ka};
    hipError_t e = hipLaunchCooperativeKernel((void*)fwd_megakernel, dim3(grid_blocks), dim3(256), args, 0, stream);
    if (e != hipSuccess) fprintf(stderr, "cooperative launch failed: %s (grid %d)\n", hipGetErrorString(e), grid_blocks);
}
```

```cpp
#include <hip/hip_runtime.h>
#include <hip/hip_cooperative_groups.h>
#include <cstdio>
namespace cg = cooperative_groups;

#define DI __device__ __forceinline__
#define LAS __attribute__((address_space(3)))

#define XB_TMO      128
#define XB_XCNT(j)  (256  + 64 * (j))
#define XB_XSUB(j)  (1280 + 64 * (j))
#define XB_XGEN(j)  (2304 + 64 * (j))
#define XB_TOP      3328
#define XB_TOPGEN   3392
#define XCD_BAR_WORDS 3456
#define XB_SPIN_CAP (1u << 22)

DI unsigned xb_ld(unsigned* p)              { return __hip_atomic_load(p, __ATOMIC_RELAXED, __HIP_MEMORY_SCOPE_AGENT); }
DI unsigned xb_add(unsigned* p, unsigned v) { return __hip_atomic_fetch_add(p, v, __ATOMIC_RELAXED, __HIP_MEMORY_SCOPE_AGENT); }
DI unsigned xb_xcc_id() { return (unsigned)__builtin_amdgcn_s_getreg((3 << 11) | 20) & 0xFu; }
#define XB_SPIN(cond, bar) do { unsigned _sp = 0; while (cond) { __builtin_amdgcn_s_sleep(1); \
    if ((++_sp & 255u) == 0u) { if (xb_ld(&(bar)[XB_TMO])) break; if (_sp > XB_SPIN_CAP) { atomicAdd(&(bar)[XB_TMO], 1u); break; } } } } while (0)

struct XcdBarrier { unsigned* bar; unsigned x; volatile LAS unsigned* st; };

DI XcdBarrier xcd_barrier_post(unsigned* bar, volatile LAS unsigned* st) {
    XcdBarrier b; b.bar = bar; b.x = xb_xcc_id(); b.st = st;
    if (threadIdx.x == 0) (void)xb_add(&bar[XB_XCNT(b.x)], 1u);
    return b;
}
DI void xcd_barrier_complete(unsigned* bar, unsigned x, unsigned& nloc, unsigned& nx) {
    const unsigned G = gridDim.x * gridDim.y * gridDim.z;
    unsigned sum, cnt, mine, sp = 0u;
    for (;;) {
        sum = 0u; cnt = 0u; mine = 0u;
#pragma unroll
        for (unsigned j = 0; j < 16; ++j) { const unsigned c = xb_ld(&bar[XB_XCNT(j)]); sum += c; cnt += (c > 0u) ? 1u : 0u; mine = (j == x) ? c : mine; }
        if (sum == G) break;
        __builtin_amdgcn_s_sleep(1);
        if ((++sp & 255u) == 0u) { if (xb_ld(&bar[XB_TMO])) break; if (sp > XB_SPIN_CAP) { atomicAdd(&bar[XB_TMO], 1u); break; } }
    }
    nloc = mine > 0u ? mine : 1u; nx = cnt > 0u ? cnt : 1u;
}
DI void xcd_barrier(const XcdBarrier& b) {
    asm volatile("s_waitcnt vmcnt(0)" ::: "memory");
    __syncthreads();
    if (threadIdx.x == 0) {
        unsigned* bar = b.bar;
        __builtin_amdgcn_s_waitcnt(0);
        unsigned nloc = b.st[0], nx = b.st[1];
        if (nloc == 0u) { xcd_barrier_complete(bar, b.x, nloc, nx); b.st[0] = nloc; b.st[1] = nx; }
        const unsigned old = xb_add(&bar[XB_XSUB(b.x)], 1u);
        const unsigned gen = old / nloc;
        if (old + 1u == (gen + 1u) * nloc) {
            __builtin_amdgcn_fence(__ATOMIC_RELEASE, "agent");
            asm volatile("s_waitcnt vmcnt(0)" ::: "memory");
            const unsigned og = xb_add(&bar[XB_TOP], 1u);
            const unsigned tg = og / nx;
            if (og + 1u == (tg + 1u) * nx) xb_add(&bar[XB_TOPGEN], 1u);
            else XB_SPIN(xb_ld(&bar[XB_TOPGEN]) == tg, bar);
            __builtin_amdgcn_fence(__ATOMIC_ACQUIRE, "agent");
            xb_add(&bar[XB_XGEN(b.x)], 1u);
            asm volatile("s_waitcnt vmcnt(0)" ::: "memory");
        } else {
            XB_SPIN(xb_ld(&bar[XB_XGEN(b.x)]) == gen, bar);
            __builtin_amdgcn_fence(__ATOMIC_ACQUIRE, "agent");
            asm volatile("s_waitcnt vmcnt(0)" ::: "memory");
        }
    }
    __syncthreads();
}


#ifndef MK_PROBE
#define MK_PROBE 0
#endif
typedef unsigned short u16;
using bf16x8 = __attribute__((ext_vector_type(8))) short;
using f32x4  = __attribute__((ext_vector_type(4))) float;
using u32x4  = __attribute__((ext_vector_type(4))) unsigned;
using u32x2  = __attribute__((ext_vector_type(2))) unsigned;
typedef __attribute__((ext_vector_type(2))) __bf16 bf2_t;
#define MFMA16(a, b, c) __builtin_amdgcn_mfma_f32_16x16x32_bf16((a), (b), (c), 0, 0, 0)

constexpr int S_ = 16384, DM_ = 1024, NPAD_ = 7040;
constexpr int LDT = 64;
DI int swzA(int row) { return row & 7; }
DI int swzK(int row) { return (((row >> 3) & 3) << 1) | ((row >> 1) & 1); }
constexpr int TILE_ELEMS = 128 * LDT;
constexpr int CST = 132;
constexpr float LOG2E = 1.4426950408889634f;

template <int N> struct IC { static constexpr int value = N; };
DI int TID() { int t = threadIdx.x; asm volatile("" : "+v"(t)); return t; }
DI unsigned pack2(float a, float b) { bf2_t v = {(__bf16)a, (__bf16)b}; return __builtin_bit_cast(unsigned, v); }
DI float bflo(unsigned u) { return __uint_as_float(u << 16); }
DI float bfhi(unsigned u) { return __uint_as_float(u & 0xffff0000u); }
DI u32x4 ld16(const u16* p) { return *(const u32x4*)p; }
DI bf16x8 ldf(const u16* p) { return *(const bf16x8*)p; }
DI u32x4 pack8(const float* v) { u32x4 r; r[0] = pack2(v[0], v[1]); r[1] = pack2(v[2], v[3]); r[2] = pack2(v[4], v[5]); r[3] = pack2(v[6], v[7]); return r; }
DI bf16x8 packf(f32x4 a, f32x4 b) { u32x4 r; r[0] = pack2(a[0], a[1]); r[1] = pack2(a[2], a[3]); r[2] = pack2(b[0], b[1]); r[3] = pack2(b[2], b[3]); return __builtin_bit_cast(bf16x8, r); }
DI float ex2(float x) { return __builtin_amdgcn_exp2f(x); }
DI float sigmoidf_(float x) { return 1.f / (1.f + __expf(-x)); }
#define DPP_U(v, ctrl) ((unsigned)__builtin_amdgcn_update_dpp(0, (int)(v), (ctrl), 0xf, 0xf, true))
DI unsigned wave_umax(unsigned v) {
    v = max(v, DPP_U(v, 0xB1));
    v = max(v, DPP_U(v, 0x4E));
    v = max(v, DPP_U(v, 0x141));
    v = max(v, DPP_U(v, 0x140));
    const unsigned a = __builtin_amdgcn_readlane(v, 0), b = __builtin_amdgcn_readlane(v, 16);
    const unsigned c = __builtin_amdgcn_readlane(v, 32), d = __builtin_amdgcn_readlane(v, 48);
    return max(max(a, b), max(c, d));
}
DI float wave_max(float v) {
#pragma unroll
    for (int o = 32; o >= 1; o >>= 1) v = fmaxf(v, __shfl_xor(v, o));
    return v;
}
DI float wave_sum(float v) {
#pragma unroll
    for (int o = 32; o >= 1; o >>= 1) v += __shfl_xor(v, o);
    return v;
}

struct Params {
    const float *x, *norm_pre, *w_in, *b_gate, *pe_k, *w1_k, *w2_k, *pe_v, *w1_v, *w2_v, *w_nsa_o, *w_ret_o, *w_out, *norm_post;
    float* out;
    unsigned* bar;
    u16 *WinT, *WnoT, *WroT, *WoutT, *W1T[2], *W2T[2];
    float* bpart;
    float2 *ropeN, *ropeR;
    u16 *H;
    u16 *Qn;
    u16 *Raw[2];
    u16 *Ks, *VsT, *Kw, *VwT;
    u16 *SZn;
    u16 *Qr, *Kr;
    u16 *KrT;
    u16 *VrT;
    u16 *SZr;
    u16 *Ma, *Mb;
    float* Gn;
    float* slab;
    u16 *Kc, *VcT;
    float* rowss;
    int use_cg; int probe;
};

DI void gemm128_main(const u16* a0, size_t a_r32, int astep, const u16* b0, size_t b_r32, int bstep, int nk,
                     u16* lds, f32x4 (&acc)[4][4]) {
    const int tid = TID(), lane = tid & 63, w = tid >> 6;
    const int wr = w >> 1, wc = w & 1, lr = lane & 15, q = lane >> 4;
    const int wofs = (tid >> 3) * LDT + (((tid & 7) ^ swzA(tid >> 3)) << 3);
    u32x4 ra0[4], rb0[4], ra1[4], rb1[4];
    auto gl = [&](int kt, u32x4 (&ra)[4], u32x4 (&rb)[4]) {
        const int k = kt < nk ? kt : nk - 1;
        const u16* ap = a0 + (size_t)k * astep; const u16* bp = b0 + (size_t)k * bstep;
#pragma unroll
        for (int i = 0; i < 4; ++i) { ra[i] = ld16(ap + i * a_r32); rb[i] = ld16(bp + i * b_r32); }
    };
    auto st = [&](u16* buf, const u32x4 (&ra)[4], const u32x4 (&rb)[4]) {
#pragma unroll
        for (int i = 0; i < 4; ++i) {
            *(u32x4*)(buf + wofs + i * 32 * LDT) = ra[i];
            *(u32x4*)(buf + TILE_ELEMS + wofs + i * 32 * LDT) = rb[i];
        }
    };
    auto mm = [&](const u16* As) {
        const u16* Bs = As + TILE_ELEMS;
#pragma unroll
        for (int ks = 0; ks < 2; ++ks) {
            bf16x8 af[4], bfr[4];
#pragma unroll
            for (int t = 0; t < 4; ++t) {
                af[t]  = ldf(As + (64 * wr + 16 * t + lr) * LDT + (((ks * 4 + q) ^ (lr & 7)) << 3));
                bfr[t] = ldf(Bs + (64 * wc + 16 * t + lr) * LDT + (((ks * 4 + q) ^ (lr & 7)) << 3));
            }
#pragma unroll
            for (int ti = 0; ti < 4; ++ti)
#pragma unroll
                for (int tj = 0; tj < 4; ++tj) acc[ti][tj] = MFMA16(af[ti], bfr[tj], acc[ti][tj]);
        }
    };
    u16* buf0 = lds; u16* buf1 = lds + 2 * TILE_ELEMS;
    gl(0, ra0, rb0);
    st(buf0, ra0, rb0);
    gl(1, ra1, rb1);
    __syncthreads();
    for (int kt = 0; kt < nk; kt += 2) {
        gl(kt + 2, ra0, rb0);
        __builtin_amdgcn_sched_barrier(0);
        mm(buf0);
        __builtin_amdgcn_sched_barrier(0);
        st(buf1, ra1, rb1);
        __syncthreads();
        gl(kt + 3, ra1, rb1);
        __builtin_amdgcn_sched_barrier(0);
        mm(buf1);
        __builtin_amdgcn_sched_barrier(0);
        st(buf0, ra0, rb0);
        __syncthreads();
    }
}
DI void zero_acc(f32x4 (&acc)[4][4]) {
#pragma unroll
    for (int i = 0; i < 4; ++i)
#pragma unroll
        for (int j = 0; j < 4; ++j) acc[i][j] = f32x4{0.f, 0.f, 0.f, 0.f};
}
DI void stage_acc(float* cst, const f32x4 (&acc)[4][4]) {
    const int lane = TID() & 63, w = TID() >> 6;
    const int wr = w >> 1, wc = w & 1, lr = lane & 15, q = lane >> 4;
#pragma unroll
    for (int ti = 0; ti < 4; ++ti)
#pragma unroll
        for (int tj = 0; tj < 4; ++tj)
#pragma unroll
            for (int r = 0; r < 4; ++r)
                cst[(64 * wr + 16 * ti + 4 * q + r) * CST + 64 * wc + 16 * tj + lr] = acc[ti][tj][r];
}
template <typename F> DI void emit_rows(const float* cst, F f) {
#pragma unroll 2
    for (int i = 0; i < 8; ++i) {
        const int item = TID() + 256 * i, row = item >> 4, c8 = item & 15;
        const float4 a = *(const float4*)(cst + row * CST + c8 * 8);
        const float4 b = *(const float4*)(cst + row * CST + c8 * 8 + 4);
        float v[8] = {a.x, a.y, a.z, a.w, b.x, b.y, b.z, b.w};
        f(row, c8, v);
    }
}
template <typename F> DI void emit_cols(const float* cst, F f) {
#pragma unroll 2
    for (int i = 0; i < 8; ++i) {
        const int item = TID() + 256 * i, rest = item >> 6;
        const int col = (item & 15) + 16 * (rest & 7), r8 = ((item >> 4) & 3) + 4 * (rest >> 3);
        float v[8];
#pragma unroll
        for (int k = 0; k < 8; ++k) v[k] = cst[(r8 * 8 + k) * CST + col];
        f(col, r8, v);
    }
}

DI void transpose_tile(const float* src, int ldsrc, int k0, int n0, u16* dst, int lddst, int map_in, float* tl) {
    const int tid = TID();
    const int c = tid & 63;
    int oc = n0 + c;
    if (map_in) oc = (oc < 1280) ? oc : (oc < 6912 ? oc + 24 : (oc < 6936 ? oc - 6912 + 1280 : -1));
#pragma unroll
    for (int i = 0; i < 16; ++i) {
        const int r = (tid >> 6) + 4 * i;
        tl[r * 65 + c] = (oc >= 0) ? src[(size_t)(k0 + r) * ldsrc + oc] : 0.f;
    }
    __syncthreads();
    const int nl = tid >> 2, kc = (tid & 3) * 16;
    float v[16];
#pragma unroll
    for (int i = 0; i < 16; ++i) v[i] = tl[(kc + i) * 65 + nl];
    u16* d = dst + (size_t)(n0 + nl) * lddst + k0 + kc;
    *(u32x4*)d = pack8(v);
    *(u32x4*)(d + 8) = pack8(v + 8);
    __syncthreads();
}

DI void p0_unit(const Params& p, int u, unsigned char* smem) {
    const int tid = TID(), lane = tid & 63, w = tid >> 6;
    float* tl = (float*)smem;
    if (u < 2664) {
        int t = u;
        if (t < 1760) { transpose_tile(p.w_in, 6936, (t & 15) * 64, (t >> 4) * 64, p.WinT, 1024, 1, tl); return; }
        t -= 1760;
        if (t < 128) { transpose_tile(p.w_nsa_o, 1024, (t & 7) * 64, (t >> 3) * 64, p.WnoT, 512, 0, tl); return; }
        t -= 128;
        if (t < 256) { transpose_tile(p.w_ret_o, 1024, (t & 15) * 64, (t >> 4) * 64, p.WroT, 1024, 0, tl); return; }
        t -= 256;
        if (t < 256) { transpose_tile(p.w_out, 1024, (t & 15) * 64, (t >> 4) * 64, p.WoutT, 1024, 0, tl); return; }
        t -= 256;
        if (t < 128) { transpose_tile(p.w1_k, 256, (t & 31) * 64, (t >> 5) * 64, p.W1T[0], 2048, 0, tl); return; }
        t -= 128;
        if (t < 128) { transpose_tile(p.w1_v, 256, (t & 31) * 64, (t >> 5) * 64, p.W1T[1], 2048, 0, tl); return; }
        t -= 128;
        if (t < 4) { transpose_tile(p.w2_k, 64, t * 64, 0, p.W2T[0], 256, 0, tl); return; }
        t -= 4;
        transpose_tile(p.w2_v, 64, t * 64, 0, p.W2T[1], 256, 0, tl);
        return;
    }
    u -= 2664;
    if (u < 4096) {
        const int row = u * 4 + w;
        const float* xr = p.x + (size_t)row * 1024;
        float4 v[4]; float ss = 0.f;
#pragma unroll
        for (int i = 0; i < 4; ++i) { v[i] = *(const float4*)(xr + lane * 4 + 256 * i); ss += v[i].x * v[i].x + v[i].y * v[i].y + v[i].z * v[i].z + v[i].w * v[i].w; }
        ss = wave_sum(ss);
        const float rs = rsqrtf(ss * (1.f / 1024.f) + 1e-6f);
#pragma unroll
        for (int i = 0; i < 4; ++i) {
            const float4 g = *(const float4*)(p.norm_pre + lane * 4 + 256 * i);
            u32x2 o; o[0] = pack2(v[i].x * rs * g.x, v[i].y * rs * g.y); o[1] = pack2(v[i].z * rs * g.z, v[i].w * rs * g.w);
            *(u32x2*)(p.H + (size_t)row * 1024 + lane * 4 + 256 * i) = o;
        }
        return;
    }
    u -= 4096;
    if (u < 4096) {
        const int e = u * 256 + tid, pos = e >> 6, i = e & 63;
        const float inv = 1.0f / powf(10000.0f, (float)i / 63.0f);
        const float ang = (float)pos * inv;
        float sn, cs; sincosf(ang, &sn, &cs);
        p.ropeR[e] = make_float2(cs, sn);
        return;
    }
    u -= 4096;
    if (u < 512) {
        const int e = u * 256 + tid, pos = e >> 3, i = e & 7;
        const float inv = 1.0f / powf(500000.0f, (float)(2 * i) / 16.0f);
        const float ang = (float)pos * inv;
        float sn, cs; sincosf(ang, &sn, &cs);
        p.ropeN[e] = make_float2(cs, sn);
        return;
    }
    u -= 512;
    {
        const int kv = u >> 4, ch = u & 15;
        const float* pe = kv ? p.pe_v : p.pe_k;
        const float* w1 = kv ? p.w1_v : p.w1_k;
        float s = 0.f;
        for (int k = ch * 128; k < ch * 128 + 128; ++k) s += pe[k] * w1[(size_t)k * 256 + tid];
        p.bpart[(kv * 16 + ch) * 256 + tid] = s;
    }
}
constexpr int P0_UNITS = 2664 + 4096 + 4096 + 512 + 32;

DI void p1_tile(const Params& p, int t, unsigned char* smem) {
    const int tid = TID();
    const int nt = t >> 7, mt = t & 127, tok0 = mt * 128;
    u16* lds = (u16*)smem; float* cst = (float*)smem;
    f32x4 acc[4][4]; zero_acc(acc);
    gemm128_main(p.H + (size_t)(tok0 + (tid >> 3)) * 1024 + (tid & 7) * 8, (size_t)32 * 1024, 64,
                 p.WinT + (size_t)(nt * 128 + (tid >> 3)) * 1024 + (tid & 7) * 8, (size_t)32 * 1024, 64, 16, lds, acc);
    stage_acc(cst, acc);
    __syncthreads();
    if (nt <= 4 || nt == 6 || nt == 8) {
#pragma unroll 2
        for (int i = 0; i < 8; ++i) {
            const int item = tid + 256 * i, row = item >> 4, hh = (item >> 3) & 1, ii = item & 7;
            float* px = cst + row * CST + hh * 64 + ii;
            const float x1 = px[0], x2 = px[8];
            const float2 cs = p.ropeN[(size_t)(tok0 + row) * 8 + ii];
            px[0] = x1 * cs.x - x2 * cs.y; px[8] = x2 * cs.x + x1 * cs.y;
        }
        __syncthreads();
    } else if (nt >= 14 && nt <= 21) {
        const float sc = (nt >= 18) ? 0.08838834764831845f : 1.0f;
#pragma unroll 2
        for (int i = 0; i < 32; ++i) {
            const int item = tid + 256 * i, row = item >> 6, ii = item & 63;
            float* px = cst + row * CST + ii;
            const float x1 = px[0], x2 = px[64];
            const float2 cs = p.ropeR[(size_t)(tok0 + row) * 64 + ii];
            px[0] = (x1 * cs.x - x2 * cs.y) * sc; px[64] = (x2 * cs.x + x1 * cs.y) * sc;
        }
        __syncthreads();
    }
    if (nt <= 3) {
        emit_rows(cst, [&](int row, int c8, const float* v) { *(u32x4*)(p.Qn + (size_t)(tok0 + row) * 512 + nt * 128 + c8 * 8) = pack8(v); });
    } else if (nt == 4 || nt == 5) {
        u16* dst = (nt == 4) ? p.Raw[0] : p.Raw[1];
        emit_rows(cst, [&](int row, int c8, const float* v) { *(u32x4*)(dst + (size_t)(tok0 + row) * 128 + c8 * 8) = pack8(v); });
    } else if (nt == 6 || nt == 8) {
        u16* dst = (nt == 6) ? p.Ks : p.Kw;
        emit_rows(cst, [&](int row, int c8, const float* v) { *(u32x4*)(dst + ((size_t)(c8 >> 3) * S_ + tok0 + row) * 64 + (c8 & 7) * 8) = pack8(v); });
    } else if (nt == 7 || nt == 9) {
        u16* dst = (nt == 7) ? p.VsT : p.VwT;
        emit_cols(cst, [&](int col, int r8, const float* v) {
            const int g = col >> 6, d = col & 63, tk = tok0 + r8 * 8;
            *(u32x4*)(dst + (((size_t)g * 256 + (tk >> 6)) * 64 + d) * 64 + (tk & 63)) = pack8(v); });
    } else if (nt <= 13) {
        emit_rows(cst, [&](int row, int c8, const float* v) {
            float o[8];
#pragma unroll
            for (int k = 0; k < 8; ++k) o[k] = v[k] * sigmoidf_(v[k]);
            *(u32x4*)(p.SZn + (size_t)(tok0 + row) * 512 + (nt - 10) * 128 + c8 * 8) = pack8(o); });
    } else if (nt <= 17) {
        const int h = nt - 14;
        emit_rows(cst, [&](int row, int c8, const float* v) { *(u32x4*)(p.Qr + ((size_t)h * S_ + tok0 + row) * 128 + c8 * 8) = pack8(v); });
    } else if (nt <= 21) {
        const int h = nt - 18;
        emit_rows(cst, [&](int row, int c8, const float* v) { *(u32x4*)(p.Kr + ((size_t)h * S_ + tok0 + row) * 128 + c8 * 8) = pack8(v); });
        const float lg = logf(1.0f - exp2f(-5.0f - (float)h));
        emit_cols(cst, [&](int col, int r8, const float* v) {
            float o[8];
#pragma unroll
            for (int k = 0; k < 8; ++k) o[k] = v[k] * __expf((float)(127 - (r8 * 8 + k)) * lg);
            *(u32x4*)(p.KrT + (((size_t)h * 128 + mt) * 128 + col) * 128 + r8 * 8) = pack8(o); });
    } else if (nt <= 29) {
        const int h = (nt - 22) >> 1, e0 = ((nt - 22) & 1) * 128;
        emit_cols(cst, [&](int col, int r8, const float* v) {
            *(u32x4*)(p.VrT + (((size_t)h * 128 + mt) * 256 + e0 + col) * 128 + r8 * 8) = pack8(v); });
    } else if (nt <= 37) {
        emit_rows(cst, [&](int row, int c8, const float* v) {
            float o[8];
#pragma unroll
            for (int k = 0; k < 8; ++k) o[k] = v[k] * sigmoidf_(v[k]);
            *(u32x4*)(p.SZr + (size_t)(tok0 + row) * 1024 + (nt - 30) * 128 + c8 * 8) = pack8(o); });
    } else if (nt <= 53) {
        u16* dst = (nt <= 45) ? p.Ma : p.Mb;
        const int c0 = ((nt <= 45) ? (nt - 38) : (nt - 46)) * 128;
        emit_rows(cst, [&](int row, int c8, const float* v) {
            float o[8];
#pragma unroll
            for (int k = 0; k < 8; ++k) o[k] = sigmoidf_(v[k]);
            *(u32x4*)(dst + (size_t)(tok0 + row) * 1024 + c0 + c8 * 8) = pack8(o); });
    } else {
#pragma unroll 2
        for (int i = 0; i < 12; ++i) {
            const int item = tid + 256 * i, row = item / 24, c = item - row * 24;
            p.Gn[(size_t)(tok0 + row) * 24 + c] = sigmoidf_(cst[row * CST + c] + p.b_gate[c]);
        }
    }
    __syncthreads();
}

DI void p2_unit(const Params& p, int u, unsigned char* smem) {
    const int tid = TID(), lane = tid & 63, w = tid >> 6;
    u16* lds = (u16*)smem; float* cst = (float*)smem;
    f32x4 acc[4][4]; zero_acc(acc);
    if (u < 256) {
        const int nt = u & 1, mt = (u >> 1) & 15, ks = (u >> 5) & 3, kv = u >> 7;
        const int R = mt * 128 + (tid >> 3), c = R >> 1, g = R & 1;
        const u16* a0 = (kv ? p.Raw[1] : p.Raw[0]) + (size_t)(16 * c + ks * 8) * 128 + g * 64 + (tid & 7) * 8;
        const u16* b0 = (kv ? p.W1T[1] : p.W1T[0]) + (size_t)(nt * 128 + (tid >> 3)) * 2048 + ks * 512 + (tid & 7) * 8;
        gemm128_main(a0, (size_t)16 * 16 * 128, 128, b0, (size_t)32 * 2048, 64, 8, lds, acc);
        const int wr = w >> 1, wc = w & 1, lr = lane & 15, q = lane >> 4;
        float* dst = p.slab + ((size_t)(ks * 2 + kv) * 2048 + mt * 128) * 256 + nt * 128;
#pragma unroll
        for (int ti = 0; ti < 4; ++ti)
#pragma unroll
            for (int tj = 0; tj < 4; ++tj)
#pragma unroll
                for (int r = 0; r < 4; ++r)
                    dst[(size_t)(64 * wr + 16 * ti + 4 * q + r) * 256 + 64 * wc + 16 * tj + lr] = acc[ti][tj][r];
        return;
    }
    const int v = u - 256, half = v & 1, ch = v >> 1, n = ch >> 2, h = ch & 3;
    const u16* a0 = p.VrT + (((size_t)h * 128 + n) * 256 + half * 128 + (tid >> 3)) * 128 + (tid & 7) * 8;
    const u16* b0 = p.KrT + (((size_t)h * 128 + n) * 128 + (tid >> 3)) * 128 + (tid & 7) * 8;
    gemm128_main(a0, (size_t)32 * 128, 64, b0, (size_t)32 * 128, 64, 2, lds, acc);
    stage_acc(cst, acc);
    __syncthreads();
    u16* dst = p.H + (((size_t)n * 4 + h) * 256 + half * 128) * 128;
    emit_rows(cst, [&](int row, int c8, const float* vv) { *(u32x4*)(dst + (size_t)row * 128 + c8 * 8) = pack8(vv); });
    __syncthreads();
}
constexpr int P2_UNITS = 256 + 1024;

DI float gelu_tanh(float x) {
    const float u = 0.7978845608028654f * (x + 0.044715f * x * x * x);
    const float t = 1.f - 2.f / (1.f + __expf(2.f * u));
    return 0.5f * x * (1.f + t);
}
DI void p3_unit(const Params& p, int u, unsigned char* smem) {
    const int tid = TID(), lane = tid & 63, w = tid >> 6;
    const int v = u, kv = v & 1, rt = v >> 1;
    float* bias = (float*)smem;
    {
        float s = 0.f;
#pragma unroll
        for (int i = 0; i < 16; ++i) s += p.bpart[(kv * 16 + i) * 256 + tid];
        bias[tid] = s;
    }
    __syncthreads();
    const int lr = lane & 15, q = lane >> 4;
    const int R = rt * 16 + lr;
    f32x4 acc = {0.f, 0.f, 0.f, 0.f};
#pragma unroll
    for (int ks = 0; ks < 8; ++ks) {
        const int k0 = ks * 32 + q * 8;
        float hv[8];
#pragma unroll
        for (int k = 0; k < 8; ++k) hv[k] = bias[k0 + k];
#pragma unroll
        for (int s = 0; s < 4; ++s) {
            const float* sp = p.slab + ((size_t)(s * 2 + kv) * 2048 + R) * 256 + k0;
            const float4 a = *(const float4*)sp, b = *(const float4*)(sp + 4);
            hv[0] += a.x; hv[1] += a.y; hv[2] += a.z; hv[3] += a.w; hv[4] += b.x; hv[5] += b.y; hv[6] += b.z; hv[7] += b.w;
        }
#pragma unroll
        for (int k = 0; k < 8; ++k) hv[k] = gelu_tanh(hv[k]);
        const bf16x8 af = __builtin_bit_cast(bf16x8, pack8(hv));
        const bf16x8 bfr = ldf((kv ? p.W2T[1] : p.W2T[0]) + (size_t)(16 * w + lr) * 256 + k0);
        acc = MFMA16(af, bfr, acc);
    }
    const int d = 16 * w + lr;
#pragma unroll
    for (int r = 0; r < 4; ++r) {
        const int Ro = rt * 16 + 4 * q + r, c = Ro >> 1, g = Ro & 1;
        const float val = (c < 1023) ? acc[r] : 0.f;
        const u16 bv = (u16)(pack2(val, 0.f) & 0xffffu);
        if (kv == 0) p.Kc[((size_t)g * 1024 + c) * 64 + d] = bv;
        else p.VcT[(((size_t)g * 16 + (c >> 6)) * 64 + d) * 64 + (c & 63)] = bv;
    }
    __syncthreads();
}
constexpr int P3_UNITS = 256;
DI void p3_scan(const Params& p) {
    for (int idx = blockIdx.x * 256 + TID(); idx < 131072; idx += gridDim.x * 256) {
        const int h = idx >> 15;
        const float dec = __expf(128.0f * logf(1.0f - exp2f(-5.0f - (float)h)));
        u16* base = p.H + idx;
        float r0 = 0.f;
#pragma unroll 16
        for (int n = 0; n < 128; ++n) {
            u16* pp = base + (size_t)n * 131072;
            const float kv = __uint_as_float((unsigned)(*pp) << 16);
            *pp = (u16)(pack2(r0, 0.f) & 0xffffu);
            r0 = dec * r0 + kv;
        }
    }
}

constexpr int IMPS = 260;
DI void nsa_load_tile(const u16* src, u32x4 (&r)[2]) {
    r[0] = ld16(src + TID() * 8); r[1] = ld16(src + (TID() + 256) * 8);
}
DI void nsa_store_k(u16* dst, const u32x4 (&r)[2]) {
    const int c0 = TID(), r0 = c0 >> 3, r1 = r0 + 32;
    *(u32x4*)(dst + r0 * LDT + (((c0 & 7) ^ swzK(r0)) << 3)) = r[0];
    *(u32x4*)(dst + r1 * LDT + (((c0 & 7) ^ swzK(r1)) << 3)) = r[1];
}
DI void nsa_store_v(u16* dst, const u32x4 (&r)[2]) {
    const int c0 = TID(), r0 = c0 >> 3, r1 = r0 + 32;
    *(u32x4*)(dst + r0 * LDT + (((c0 & 7) ^ swzA(r0)) << 3)) = r[0];
    *(u32x4*)(dst + r1 * LDT + (((c0 & 7) ^ swzA(r1)) << 3)) = r[1];
}
DI void nsa_scores(const u16* Kt, const bf16x8 (&qf)[2][2], f32x4 (&s)[4][2]) {
    const int lane = TID() & 63, lr = lane & 15, q = lane >> 4;
#pragma unroll
    for (int kt = 0; kt < 4; ++kt) {
        const int krow = 32 * (kt >> 1) + 8 * (lr >> 2) + 4 * (kt & 1) + (lr & 3);
        s[kt][0] = f32x4{0.f, 0.f, 0.f, 0.f}; s[kt][1] = f32x4{0.f, 0.f, 0.f, 0.f};
#pragma unroll
        for (int ks = 0; ks < 2; ++ks) {
            const bf16x8 kf = ldf(Kt + krow * LDT + (((ks * 4 + q) ^ swzK(krow)) << 3));
            s[kt][0] = MFMA16(kf, qf[0][ks], s[kt][0]);
            s[kt][1] = MFMA16(kf, qf[1][ks], s[kt][1]);
        }
    }
}
DI void nsa_pv(const u16* Vt, const f32x4 (&s)[4][2], f32x4 (&o)[4][2]) {
    const int lane = TID() & 63, lr = lane & 15, q = lane >> 4;
#pragma unroll
    for (int ks2 = 0; ks2 < 2; ++ks2) {
        const bf16x8 pb0 = packf(s[2 * ks2][0], s[2 * ks2 + 1][0]);
        const bf16x8 pb1 = packf(s[2 * ks2][1], s[2 * ks2 + 1][1]);
#pragma unroll
        for (int dt = 0; dt < 4; ++dt) {
            const bf16x8 vf = ldf(Vt + (16 * dt + lr) * LDT + (((ks2 * 4 + q) ^ (lr & 7)) << 3));
            o[dt][0] = MFMA16(vf, pb0, o[dt][0]);
            o[dt][1] = MFMA16(vf, pb1, o[dt][1]);
        }
    }
}

DI void nsa_item(const Params& p, int tb, int g, unsigned char* smem) {
    u16* Kt = (u16*)smem;
    u16* Vt = Kt + 64 * LDT;
    float* imp = (float*)(smem + 2 * 64 * LDT * 2);
    int* sel = (int*)(smem + 65536);
    const int tid = TID(), lane = tid & 63, w = tid >> 6, lr = lane & 15, q = lane >> 4;
    const int t0 = tb * 32, cur = t0 >> 6;
    const float SC = 0.125f * LOG2E;
    const float NEG = -1e30f;

    bf16x8 qf[2][2];
    int tokL[2]; float gc[2], gs[2], gw[2];
#pragma unroll
    for (int rt = 0; rt < 2; ++rt) {
        tokL[rt] = t0 + 8 * w + 4 * rt + (lr >> 2);
        const int head = 4 * g + (lr & 3);
#pragma unroll
        for (int ks = 0; ks < 2; ++ks) qf[rt][ks] = ldf(p.Qn + (size_t)tokL[rt] * 512 + head * 64 + 32 * ks + 8 * q);
        const float* gp = p.Gn + (size_t)tokL[rt] * 24 + head * 3;
        gc[rt] = gp[0]; gs[rt] = gp[1]; gw[rt] = gp[2];
    }
    f32x4 tot[4][2];
#pragma unroll
    for (int dt = 0; dt < 4; ++dt) { tot[dt][0] = f32x4{0.f, 0.f, 0.f, 0.f}; tot[dt][1] = f32x4{0.f, 0.f, 0.f, 0.f}; }

    for (int rep = (MK_PROBE & 256) ? 0 : 1; rep < 2; ++rep) {
        float m[2] = {NEG, NEG}, l[2] = {0.f, 0.f};
        f32x4 o[4][2];
#pragma unroll
        for (int dt = 0; dt < 4; ++dt) { o[dt][0] = f32x4{0.f, 0.f, 0.f, 0.f}; o[dt][1] = f32x4{0.f, 0.f, 0.f, 0.f}; }
        const int kb_lo = (t0 > 511 ? t0 - 511 : 0) >> 6, kb_hi = cur;
        u32x4 rk[2], rv[2];
        nsa_load_tile(p.Kw + ((size_t)g * S_ + kb_lo * 64) * 64, rk);
        nsa_load_tile(p.VwT + ((size_t)g * 256 + kb_lo) * 4096, rv);
        for (int kb = kb_lo; kb <= kb_hi; ++kb) {
            __syncthreads();
            nsa_store_k(Kt, rk); nsa_store_v(Vt, rv);
            __syncthreads();
            if (kb < kb_hi) {
                nsa_load_tile(p.Kw + ((size_t)g * S_ + (kb + 1) * 64) * 64, rk);
                nsa_load_tile(p.VwT + ((size_t)g * 256 + kb + 1) * 4096, rv);
            }
            f32x4 s[4][2];
            nsa_scores(Kt, qf, s);
            const bool interior = (kb * 64 + 63 <= t0) && (kb * 64 > t0 + 31 - 512);
#pragma unroll
            for (int rt = 0; rt < 2; ++rt) {
                if (interior) {
                    float mx = NEG;
#pragma unroll
                    for (int kt = 0; kt < 4; ++kt) mx = fmaxf(fmaxf(mx, fmaxf(s[kt][rt][0], s[kt][rt][1])), fmaxf(s[kt][rt][2], s[kt][rt][3]));
                    mx *= SC;
                    mx = fmaxf(mx, __shfl_xor(mx, 16)); mx = fmaxf(mx, __shfl_xor(mx, 32));
                    const float mn = fmaxf(m[rt], mx), alpha = ex2(m[rt] - mn);
                    float rs = 0.f;
#pragma unroll
                    for (int kt = 0; kt < 4; ++kt)
#pragma unroll
                        for (int r = 0; r < 4; ++r) { const float pv = ex2(fmaf(s[kt][rt][r], SC, -mn)); s[kt][rt][r] = pv; rs += pv; }
                    l[rt] = l[rt] * alpha + rs; m[rt] = mn;
#pragma unroll
                    for (int dt = 0; dt < 4; ++dt) o[dt][rt] *= alpha;
                    continue;
                }
                const int t = tokL[rt];
                float mx = NEG;
#pragma unroll
                for (int kt = 0; kt < 4; ++kt)
#pragma unroll
                    for (int r = 0; r < 4; ++r) {
                        const int key = kb * 64 + 32 * (kt >> 1) + 8 * q + 4 * (kt & 1) + r;
                        const bool ok = (key <= t) && (key > t - 512);
                        const float v = ok ? s[kt][rt][r] * SC : NEG;
                        s[kt][rt][r] = v; mx = fmaxf(mx, v);
                    }
                mx = fmaxf(mx, __shfl_xor(mx, 16)); mx = fmaxf(mx, __shfl_xor(mx, 32));
                const float mn = fmaxf(m[rt], mx), alpha = ex2(m[rt] - mn);
                float rs = 0.f;
#pragma unroll
                for (int kt = 0; kt < 4; ++kt)
#pragma unroll
                    for (int r = 0; r < 4; ++r) {
                        const float v = s[kt][rt][r];
                        const float pv = (v > -1e29f) ? ex2(v - mn) : 0.f;
                        s[kt][rt][r] = pv; rs += pv;
                    }
                l[rt] = l[rt] * alpha + rs; m[rt] = mn;
#pragma unroll
                for (int dt = 0; dt < 4; ++dt) o[dt][rt] *= alpha;
            }
            nsa_pv(Vt, s, o);
        }
#pragma unroll
        for (int rt = 0; rt < 2; ++rt) {
            float lt = l[rt]; lt += __shfl_xor(lt, 16); lt += __shfl_xor(lt, 32);
            const float f = (rep == 1) ? gw[rt] / fmaxf(lt, 1e-37f) : 0.f;
#pragma unroll
            for (int dt = 0; dt < 4; ++dt) tot[dt][rt] += o[dt][rt] * f;
        }
    }

    for (int rep = (MK_PROBE & 512) ? 0 : 1; rep < 2; ++rep) {
        const int nct = ((t0 >> 4) >> 6) + 1;
        int cmaxv[2]; cmaxv[0] = (tokL[0] - 31) >> 4; cmaxv[1] = (tokL[1] - 31) >> 4;
        const int cfull = (t0 - 31) >> 4;
        float m[2] = {NEG, NEG}, l[2] = {0.f, 0.f};
        u32x4 rk[2], rv[2];
        nsa_load_tile(p.Kc + ((size_t)g * 1024) * 64, rk);
        for (int ct = 0; ct < nct; ++ct) {
            __syncthreads();
            nsa_store_k(Kt, rk);
            __syncthreads();
            if (ct + 1 < nct) nsa_load_tile(p.Kc + ((size_t)g * 1024 + (ct + 1) * 64) * 64, rk);
            f32x4 s[4][2];
            nsa_scores(Kt, qf, s);
#pragma unroll
            for (int rt = 0; rt < 2; ++rt) {
                if (ct * 64 + 63 <= cfull) {
                    float mx = NEG;
#pragma unroll
                    for (int kt = 0; kt < 4; ++kt) mx = fmaxf(fmaxf(mx, fmaxf(s[kt][rt][0], s[kt][rt][1])), fmaxf(s[kt][rt][2], s[kt][rt][3]));
                    mx *= SC;
                    mx = fmaxf(mx, __shfl_xor(mx, 16)); mx = fmaxf(mx, __shfl_xor(mx, 32));
                    const float mn = fmaxf(m[rt], mx), alpha = ex2(m[rt] - mn);
                    float rs = 0.f;
#pragma unroll
                    for (int kt = 0; kt < 4; ++kt)
#pragma unroll
                        for (int r = 0; r < 4; ++r) rs += ex2(fmaf(s[kt][rt][r], SC, -mn));
                    l[rt] = l[rt] * alpha + rs; m[rt] = mn;
                    continue;
                }
                float mx = NEG;
#pragma unroll
                for (int kt = 0; kt < 4; ++kt)
#pragma unroll
                    for (int r = 0; r < 4; ++r) {
                        const int c = ct * 64 + 32 * (kt >> 1) + 8 * q + 4 * (kt & 1) + r;
                        const float v = (c <= cmaxv[rt]) ? s[kt][rt][r] * SC : NEG;
                        s[kt][rt][r] = v; mx = fmaxf(mx, v);
                    }
                mx = fmaxf(mx, __shfl_xor(mx, 16)); mx = fmaxf(mx, __shfl_xor(mx, 32));
                const float mn = fmaxf(m[rt], mx), alpha = ex2(m[rt] - mn);
                float rs = 0.f;
#pragma unroll
                for (int kt = 0; kt < 4; ++kt)
#pragma unroll
                    for (int r = 0; r < 4; ++r) { const float v = s[kt][rt][r]; rs += (v > -1e29f) ? ex2(v - mn) : 0.f; }
                l[rt] = l[rt] * alpha + rs; m[rt] = mn;
            }
        }
        float linv[2];
#pragma unroll
        for (int rt = 0; rt < 2; ++rt) {
            float lt = l[rt]; lt += __shfl_xor(lt, 16); lt += __shfl_xor(lt, 32);
            linv[rt] = 1.f / fmaxf(lt, 1e-37f);
        }
        f32x4 o[4][2];
#pragma unroll
        for (int dt = 0; dt < 4; ++dt) { o[dt][0] = f32x4{0.f, 0.f, 0.f, 0.f}; o[dt][1] = f32x4{0.f, 0.f, 0.f, 0.f}; }
        float carry[2] = {0.f, 0.f};
        nsa_load_tile(p.Kc + ((size_t)g * 1024) * 64, rk);
        nsa_load_tile(p.VcT + ((size_t)g * 16) * 4096, rv);
        for (int ct = 0; ct < nct; ++ct) {
            __syncthreads();
            nsa_store_k(Kt, rk); nsa_store_v(Vt, rv);
            __syncthreads();
            if (ct + 1 < nct) {
                nsa_load_tile(p.Kc + ((size_t)g * 1024 + (ct + 1) * 64) * 64, rk);
                nsa_load_tile(p.VcT + ((size_t)g * 16 + ct + 1) * 4096, rv);
            }
            f32x4 s[4][2];
            nsa_scores(Kt, qf, s);
#pragma unroll
            for (int rt = 0; rt < 2; ++rt) {
                if (ct * 64 + 63 <= cfull) {
#pragma unroll
                    for (int kt = 0; kt < 4; ++kt)
#pragma unroll
                        for (int r = 0; r < 4; ++r) s[kt][rt][r] = ex2(fmaf(s[kt][rt][r], SC, -m[rt])) * linv[rt];
                } else {
#pragma unroll
                    for (int kt = 0; kt < 4; ++kt)
#pragma unroll
                        for (int r = 0; r < 4; ++r) {
                            const int c = ct * 64 + 32 * (kt >> 1) + 8 * q + 4 * (kt & 1) + r;
                            s[kt][rt][r] = (c <= cmaxv[rt]) ? ex2(s[kt][rt][r] * SC - m[rt]) * linv[rt] : 0.f;
                        }
                }
                const float up1 = __shfl_up(s[1][rt][3], 16), up3 = __shfl_up(s[3][rt][3], 16);
                const float w1 = __shfl(s[1][rt][3], lr + 48), w3 = __shfl(s[3][rt][3], lr + 48);
                float e[4];
                e[0] = s[0][rt][0] + s[0][rt][1] + s[0][rt][2] + s[0][rt][3] + (q > 0 ? up1 : carry[rt]);
                e[1] = s[1][rt][0] + s[1][rt][1] + s[1][rt][2] + s[1][rt][3] + s[0][rt][3];
                e[2] = s[2][rt][0] + s[2][rt][1] + s[2][rt][2] + s[2][rt][3] + (q > 0 ? up3 : w1);
                e[3] = s[3][rt][0] + s[3][rt][1] + s[3][rt][2] + s[3][rt][3] + s[2][rt][3];
                carry[rt] = w3;
#pragma unroll
                for (int kt = 0; kt < 4; ++kt) {
                    float ev = e[kt];
                    ev += __shfl_xor(ev, 1); ev += __shfl_xor(ev, 2);
                    if ((lr & 3) == 0) imp[(8 * w + 4 * rt + (lr >> 2)) * IMPS + ct * 16 + 8 * (kt >> 1) + 2 * q + (kt & 1)] = ev;
                }
            }
            nsa_pv(Vt, s, o);
        }
#pragma unroll
        for (int rt = 0; rt < 2; ++rt)
#pragma unroll
            for (int dt = 0; dt < 4; ++dt) tot[dt][rt] += o[dt][rt] * ((rep == 1) ? gc[rt] : 0.f);
    }
    __syncthreads();

    for (int rep = (MK_PROBE & 1024) ? 0 : 1; rep < 2; ++rep)
    for (int tk = 0; tk < 8; ++tk) {
        const int tl = 8 * w + tk;
        unsigned v[4];
#pragma unroll
        for (int i = 0; i < 4; ++i) {
            const int j = lane + 64 * i;
            const bool cand = (j <= cur) && (j != 0) && (j != cur) && (j != cur - 1);
            v[i] = cand ? (__float_as_uint(imp[tl * IMPS + j]) + 1u) : 0u;
        }
        int selv = -1;
        if (lane == 0) selv = 0;
        if (cur > 0 && lane == 1) selv = cur;
        if (cur > 1 && lane == 2) selv = cur - 1;
        const int nforced = 1 + (cur > 0 ? 1 : 0) + (cur > 1 ? 1 : 0);
        for (int it = nforced; it < 16; ++it) {
            const unsigned wm = wave_umax(max(max(v[0], v[1]), max(v[2], v[3])));
            if (wm == 0u) break;
            int jstar;
            const unsigned long long b0 = __ballot(v[0] == wm);
            if (b0) { const int ow = __builtin_ctzll(b0); jstar = ow; if (lane == ow) v[0] = 0u; }
            else {
                const unsigned long long b1 = __ballot(v[1] == wm);
                if (b1) { const int ow = __builtin_ctzll(b1); jstar = ow + 64; if (lane == ow) v[1] = 0u; }
                else {
                    const unsigned long long b2 = __ballot(v[2] == wm);
                    if (b2) { const int ow = __builtin_ctzll(b2); jstar = ow + 128; if (lane == ow) v[2] = 0u; }
                    else { const unsigned long long b3 = __ballot(v[3] == wm); if (!b3) break; const int ow = __builtin_ctzll(b3); jstar = ow + 192; if (lane == ow) v[3] = 0u; }
                }
            }
            if (lane == it) selv = jstar;
        }
        if (lane < 16) sel[tl * 16 + lane] = selv;
    }
    __syncthreads();

    {
        unsigned* bmask = (unsigned*)(sel + 32 * 16);
        int* blist = (int*)(bmask + 256);
        bmask[tid] = 0u;
        __syncthreads();
        for (int e = tid; e < 512; e += 256) { const int j = sel[e]; if (j >= 0) atomicOr(&bmask[j], 1u << (e >> 4)); }
        __syncthreads();
        if (w == 0) {
            int base = 0;
#pragma unroll
            for (int i = 0; i < 4; ++i) {
                const int j = lane + 64 * i;
                const bool nz = bmask[j] != 0u;
                const unsigned long long b = __ballot(nz);
                const int pre = __builtin_popcountll(b & ((1ull << lane) - 1ull));
                if (nz) blist[base + pre] = j;
                base += __builtin_popcountll(b);
            }
            if (lane == 0) sel[0] = base;
        }
        __syncthreads();
        const int nl = sel[0];
        for (int rep = (MK_PROBE & (2048 | 16384)) ? 0 : 1; rep < 2; ++rep) {
        u16* st0 = (u16*)smem;
        u16* st1 = (u16*)(smem + 32768);
        float m[2] = {NEG, NEG}, l[2] = {0.f, 0.f};
        f32x4 o[4][2];
#pragma unroll
        for (int dt = 0; dt < 4; ++dt) { o[dt][0] = f32x4{0.f, 0.f, 0.f, 0.f}; o[dt][1] = f32x4{0.f, 0.f, 0.f, 0.f}; }
        u32x4 RA[4][2], RB[4][2];
        auto gloadS = [&](int st, u32x4 (&R)[4][2]) {
            const int j0 = blist[min(2 * st, nl - 1)], j1 = blist[min(2 * st + 1, nl - 1)];
            nsa_load_tile(p.Ks + ((size_t)g * S_ + (size_t)j0 * 64) * 64, R[0]);
            nsa_load_tile(p.VsT + ((size_t)g * 256 + j0) * 4096, R[1]);
            nsa_load_tile(p.Ks + ((size_t)g * S_ + (size_t)j1 * 64) * 64, R[2]);
            nsa_load_tile(p.VsT + ((size_t)g * 256 + j1) * 4096, R[3]);
        };
        auto storeS = [&](u16* stg, const u32x4 (&R)[4][2]) {
            nsa_store_k(stg, R[0]); nsa_store_v(stg + 4096, R[1]); nsa_store_k(stg + 8192, R[2]); nsa_store_v(stg + 12288, R[3]);
        };
        auto sel_rt = [&](auto RT, const u16* Kb, const u16* Vb, int j, unsigned mk) {
            constexpr int rt = decltype(RT)::value;
            f32x4 s[4];
#pragma unroll
            for (int kt = 0; kt < 4; ++kt) {
                const int krow = 32 * (kt >> 1) + 8 * (lr >> 2) + 4 * (kt & 1) + (lr & 3);
                s[kt] = f32x4{0.f, 0.f, 0.f, 0.f};
#pragma unroll
                for (int ks = 0; ks < 2; ++ks) s[kt] = MFMA16(ldf(Kb + krow * LDT + (((ks * 4 + q) ^ swzK(krow)) << 3)), qf[rt][ks], s[kt]);
            }
            const bool mine = ((mk >> (8 * w + 4 * rt + (lr >> 2))) & 1u) != 0u;
            float mx = NEG;
            if (j == cur) {
                const int dlim = mine ? (tokL[rt] - j * 64 - 8 * q) : -1;
#pragma unroll
                for (int kt = 0; kt < 4; ++kt)
#pragma unroll
                    for (int r = 0; r < 4; ++r) {
                        const float v = (32 * (kt >> 1) + 4 * (kt & 1) + r <= dlim) ? s[kt][r] * SC : NEG;
                        s[kt][r] = v; mx = fmaxf(mx, v);
                    }
                mx = fmaxf(mx, __shfl_xor(mx, 16)); mx = fmaxf(mx, __shfl_xor(mx, 32));
                const float mn = fmaxf(m[rt], mx), alpha = ex2(m[rt] - mn);
                float rs = 0.f;
#pragma unroll
                for (int kt = 0; kt < 4; ++kt)
#pragma unroll
                    for (int r = 0; r < 4; ++r) {
                        const float v = s[kt][r];
                        const float pv = (v > -1e29f) ? ex2(v - mn) : 0.f;
                        s[kt][r] = pv; rs += pv;
                    }
                l[rt] = l[rt] * alpha + rs; m[rt] = mn;
#pragma unroll
                for (int dt = 0; dt < 4; ++dt) o[dt][rt] *= alpha;
            } else {
#pragma unroll
                for (int kt = 0; kt < 4; ++kt) mx = fmaxf(fmaxf(mx, fmaxf(s[kt][0], s[kt][1])), fmaxf(s[kt][2], s[kt][3]));
                mx = mine ? mx * SC : NEG;
                mx = fmaxf(mx, __shfl_xor(mx, 16)); mx = fmaxf(mx, __shfl_xor(mx, 32));
                const float mn = fmaxf(m[rt], mx), alpha = ex2(m[rt] - mn);
                const float nb = mine ? -mn : NEG;
                float rs = 0.f;
#pragma unroll
                for (int kt = 0; kt < 4; ++kt)
#pragma unroll
                    for (int r = 0; r < 4; ++r) { const float pv = ex2(fmaf(s[kt][r], SC, nb)); s[kt][r] = pv; rs += pv; }
                l[rt] = l[rt] * alpha + rs; m[rt] = mn;
#pragma unroll
                for (int dt = 0; dt < 4; ++dt) o[dt][rt] *= alpha;
            }
#pragma unroll
            for (int ks2 = 0; ks2 < 2; ++ks2) {
                const bf16x8 pb = packf(s[2 * ks2], s[2 * ks2 + 1]);
#pragma unroll
                for (int dt = 0; dt < 4; ++dt) o[dt][rt] = MFMA16(ldf(Vb + (16 * dt + lr) * LDT + (((ks2 * 4 + q) ^ (lr & 7)) << 3)), pb, o[dt][rt]);
            }
        };
        auto compute = [&](const u16* Kb, const u16* Vb, int j) {
            if ((MK_PROBE & 16384) && rep == 0) return;
            const unsigned mk = bmask[j];
            const unsigned wb = (mk >> (8 * w)) & 0xffu;
            if (wb & 0x0fu) sel_rt(IC<0>{}, Kb, Vb, j, mk);
            if (wb & 0xf0u) sel_rt(IC<1>{}, Kb, Vb, j, mk);
        };
        auto computeS = [&](const u16* stg, int st) {
            compute(stg, stg + 4096, blist[2 * st]);
            if (2 * st + 1 < nl) compute(stg + 8192, stg + 12288, blist[2 * st + 1]);
        };
        const int nst = (nl + 1) >> 1;
        gloadS(0, RA);
        storeS(st0, RA);
        gloadS(1, RB);
        __syncthreads();
        for (int st = 0; st < nst; st += 2) {
            gloadS(st + 2, RA);
            computeS(st0, st);
            storeS(st1, RB);
            __syncthreads();
            gloadS(st + 3, RB);
            if (st + 1 < nst) computeS(st1, st + 1);
            storeS(st0, RA);
            __syncthreads();
        }
#pragma unroll
        for (int rt = 0; rt < 2; ++rt) {
            float lt = l[rt]; lt += __shfl_xor(lt, 16); lt += __shfl_xor(lt, 32);
            const float f = (rep == 1) ? gs[rt] / fmaxf(lt, 1e-37f) : 0.f;
#pragma unroll
            for (int dt = 0; dt < 4; ++dt) tot[dt][rt] += o[dt][rt] * f;
        }
        __syncthreads();
        }
    }

#pragma unroll
    for (int rt = 0; rt < 2; ++rt) {
        const int head = 4 * g + (lr & 3);
#pragma unroll
        for (int dt = 0; dt < 4; ++dt) {
            const size_t off = (size_t)tokL[rt] * 512 + head * 64 + 16 * dt + 4 * q;
            const u32x2 z = *(const u32x2*)(p.SZn + off);
            u32x2 o2;
            o2[0] = pack2(tot[dt][rt][0] * bflo(z[0]), tot[dt][rt][1] * bfhi(z[0]));
            o2[1] = pack2(tot[dt][rt][2] * bflo(z[1]), tot[dt][rt][3] * bfhi(z[1]));
            *(u32x2*)(p.Qn + off) = o2;
        }
    }
    __syncthreads();
}

DI void ret_item(const Params& p, int n, int h, bool dowrite) {
    const int lane = TID() & 63, w = TID() >> 6, lr = lane & 15, q = lane >> 4;
    const float lg2 = logf(1.0f - exp2f(-5.0f - (float)h)) * LOG2E;
    const u16* rbase = p.H + (((size_t)n * 4 + h) * 256) * 128;
    const u16* kbase = p.Kr + ((size_t)h * S_ + n * 128) * 128;
    const u16* vbase = p.VrT + (((size_t)h * 128 + n) * 256) * 128;
    const u16* rlane = rbase + lr * 128 + 8 * q;
    const u16* vlane = vbase + lr * 128 + 8 * q;
#pragma unroll 1
    for (int it = 0; it < 2; ++it) {
        const int i = 32 * w + 16 * it + lr;
        bf16x8 qf[4];
#pragma unroll
        for (int ks = 0; ks < 4; ++ks) qf[ks] = ldf(p.Qr + ((size_t)h * S_ + n * 128 + i) * 128 + 32 * ks + 8 * q);
        f32x4 acc[16];
#pragma unroll
        for (int et = 0; et < 16; ++et) acc[et] = f32x4{0.f, 0.f, 0.f, 0.f};
#pragma unroll
        for (int et = 0; et < 16; ++et) {
            const u16* pe = rlane + et * 16 * 128; asm volatile("" : "+v"(pe));
#pragma unroll
            for (int ks = 0; ks < 4; ++ks) acc[et] = MFMA16(ldf(pe + 32 * ks), qf[ks], acc[et]);
        }
        {
            const float qd = ex2((float)(i + 1) * lg2);
#pragma unroll
            for (int et = 0; et < 16; ++et) acc[et] *= qd;
        }
        for (int jk = 0; jk <= w; ++jk) {
            f32x4 s[2];
#pragma unroll
            for (int jj = 0; jj < 2; ++jj) {
                const int krow = 32 * jk + 8 * (lr >> 2) + 4 * jj + (lr & 3);
                s[jj] = f32x4{0.f, 0.f, 0.f, 0.f};
#pragma unroll
                for (int ks = 0; ks < 4; ++ks) s[jj] = MFMA16(ldf(kbase + (size_t)krow * 128 + 32 * ks + 8 * q), qf[ks], s[jj]);
            }
#pragma unroll
            for (int jj = 0; jj < 2; ++jj)
#pragma unroll
                for (int r = 0; r < 4; ++r) {
                    const int j = 32 * jk + 8 * q + 4 * jj + r;
                    s[jj][r] = (i >= j) ? s[jj][r] * ex2((float)(i - j) * lg2) : 0.f;
                }
            const bf16x8 pb = packf(s[0], s[1]);
#pragma unroll
            for (int et = 0; et < 16; ++et) {
                const u16* pe = vlane + et * 16 * 128 + 32 * jk; asm volatile("" : "+v"(pe));
                acc[et] = MFMA16(ldf(pe), pb, acc[et]);
            }
        }
        float sm = 0.f;
#pragma unroll
        for (int et = 0; et < 16; ++et) sm += acc[et][0] + acc[et][1] + acc[et][2] + acc[et][3];
        sm += __shfl_xor(sm, 16); sm += __shfl_xor(sm, 32);
        const float mu = sm * (1.f / 256.f);
        float vs = 0.f;
#pragma unroll
        for (int et = 0; et < 16; ++et)
#pragma unroll
            for (int r = 0; r < 4; ++r) { const float d = acc[et][r] - mu; vs += d * d; }
        vs += __shfl_xor(vs, 16); vs += __shfl_xor(vs, 32);
        const float rs = rsqrtf(vs * (1.f / 256.f) + 1e-6f);
        u16* zlane = p.SZr + ((size_t)n * 128 + i) * 1024 + h * 256 + 4 * q;
#pragma unroll
        for (int et = 0; et < 16; ++et) {
            u16* zp = zlane + 16 * et; asm volatile("" : "+v"(zp));
            const u32x2 z = *(const u32x2*)zp;
            u32x2 o2;
            o2[0] = pack2((acc[et][0] - mu) * rs * bflo(z[0]), (acc[et][1] - mu) * rs * bfhi(z[0]));
            o2[1] = pack2((acc[et][2] - mu) * rs * bflo(z[1]), (acc[et][3] - mu) * rs * bfhi(z[1]));
            if (dowrite) *(u32x2*)zp = o2;
        }
    }
}

DI void p5_tile(const Params& p, int t, unsigned char* smem) {
    const int tid = TID();
    const int nt = t >> 7, mt = t & 127, tok0 = mt * 128;
    u16* lds = (u16*)smem; float* cst = (float*)smem;
    float* hold = (float*)p.H + (size_t)blockIdx.x * 16384;
    {
        f32x4 acc[4][4]; zero_acc(acc);
        gemm128_main(p.Qn + (size_t)(tok0 + (tid >> 3)) * 512 + (tid & 7) * 8, (size_t)32 * 512, 64,
                     p.WnoT + (size_t)(nt * 128 + (tid >> 3)) * 512 + (tid & 7) * 8, (size_t)32 * 512, 64, 8, lds, acc);
        stage_acc(cst, acc);
    }
    __syncthreads();
    emit_rows(cst, [&](int row, int c8, const float* v) {
        const u32x4 gm = ld16(p.Ma + (size_t)(tok0 + row) * 1024 + nt * 128 + c8 * 8);
        float4 a, b;
        a.x = v[0] * bflo(gm[0]); a.y = v[1] * bfhi(gm[0]); a.z = v[2] * bflo(gm[1]); a.w = v[3] * bfhi(gm[1]);
        b.x = v[4] * bflo(gm[2]); b.y = v[5] * bfhi(gm[2]); b.z = v[6] * bflo(gm[3]); b.w = v[7] * bfhi(gm[3]);
        *(float4*)(hold + row * 128 + c8 * 8) = a; *(float4*)(hold + row * 128 + c8 * 8 + 4) = b; });
    __syncthreads();
    {
        f32x4 acc[4][4]; zero_acc(acc);
        gemm128_main(p.SZr + (size_t)(tok0 + (tid >> 3)) * 1024 + (tid & 7) * 8, (size_t)32 * 1024, 64,
                     p.WroT + (size_t)(nt * 128 + (tid >> 3)) * 1024 + (tid & 7) * 8, (size_t)32 * 1024, 64, 16, lds, acc);
        stage_acc(cst, acc);
    }
    __syncthreads();
    u16* Mg = p.Qr;
    emit_rows(cst, [&](int row, int c8, const float* v) {
        const u32x4 gm = ld16(p.Mb + (size_t)(tok0 + row) * 1024 + nt * 128 + c8 * 8);
        const float4 a = *(const float4*)(hold + row * 128 + c8 * 8), b = *(const float4*)(hold + row * 128 + c8 * 8 + 4);
        float o[8];
        o[0] = a.x + v[0] * bflo(gm[0]); o[1] = a.y + v[1] * bfhi(gm[0]); o[2] = a.z + v[2] * bflo(gm[1]); o[3] = a.w + v[3] * bfhi(gm[1]);
        o[4] = b.x + v[4] * bflo(gm[2]); o[5] = b.y + v[5] * bfhi(gm[2]); o[6] = b.z + v[6] * bflo(gm[3]); o[7] = b.w + v[7] * bfhi(gm[3]);
        *(u32x4*)(Mg + (size_t)(tok0 + row) * 1024 + nt * 128 + c8 * 8) = pack8(o); });
    __syncthreads();
}

DI void p6_tile(const Params& p, int t, unsigned char* smem) {
    const int tid = TID();
    const int nt = t >> 7, mt = t & 127, tok0 = mt * 128;
    u16* lds = (u16*)smem; float* cst = (float*)smem;
    const u16* Mg = p.Qr; u16* Y2 = p.VrT;
    {
        f32x4 acc[4][4]; zero_acc(acc);
        gemm128_main(Mg + (size_t)(tok0 + (tid >> 3)) * 1024 + (tid & 7) * 8, (size_t)32 * 1024, 64,
                     p.WoutT + (size_t)(nt * 128 + (tid >> 3)) * 1024 + (tid & 7) * 8, (size_t)32 * 1024, 64, 16, lds, acc);
        stage_acc(cst, acc);
    }
    __syncthreads();
    emit_rows(cst, [&](int row, int c8, const float* v) {
        *(u32x4*)(Y2 + (size_t)(tok0 + row) * 1024 + nt * 128 + c8 * 8) = pack8(v);
        float ss = 0.f;
#pragma unroll
        for (int k = 0; k < 8; ++k) ss += v[k] * v[k];
        ss += __shfl_xor(ss, 1); ss += __shfl_xor(ss, 2); ss += __shfl_xor(ss, 4); ss += __shfl_xor(ss, 8);
        if (c8 == 0) p.rowss[(size_t)(tok0 + row) * 8 + nt] = ss; });
    __syncthreads();
}

DI void p7_all(const Params& p) {
    const u16* Y2 = p.VrT;
    const size_t n4 = (size_t)S_ * 256;
    for (size_t i = (size_t)blockIdx.x * 256 + TID(); i < n4; i += (size_t)gridDim.x * 256) {
        const size_t row = i >> 8; const int c4 = (int)(i & 255);
        const float4 a = *(const float4*)(p.rowss + row * 8), b = *(const float4*)(p.rowss + row * 8 + 4);
        const float ss = ((a.x + a.y) + (a.z + a.w)) + ((b.x + b.y) + (b.z + b.w));
        const float rs = rsqrtf(ss * (1.f / 1024.f) + 1e-6f);
        const float4 xv = *(const float4*)(p.x + i * 4);
        const float4 gv = *(const float4*)(p.norm_post + c4 * 4);
        const u32x2 y = *(const u32x2*)(Y2 + i * 4);
        float4 o;
        o.x = xv.x + bflo(y[0]) * rs * gv.x; o.y = xv.y + bfhi(y[0]) * rs * gv.y;
        o.z = xv.z + bflo(y[1]) * rs * gv.z; o.w = xv.w + bfhi(y[1]) * rs * gv.w;
        *(float4*)(p.out + i * 4) = o;
    }
}

#ifndef MK_PROBE
#define MK_PROBE 0
#endif
constexpr size_t al256(size_t x) { return (x + 255) & ~(size_t)255; }
constexpr size_t O_BAR   = 0;
constexpr size_t O_WINT  = O_BAR   + 16384;
constexpr size_t O_WNOT  = O_WINT  + al256((size_t)NPAD_ * 1024 * 2);
constexpr size_t O_WROT  = O_WNOT  + (size_t)1024 * 512 * 2;
constexpr size_t O_WOUTT = O_WROT  + (size_t)1024 * 1024 * 2;
constexpr size_t O_W1T0  = O_WOUTT + (size_t)1024 * 1024 * 2;
constexpr size_t O_W1T1  = O_W1T0  + (size_t)256 * 2048 * 2;
constexpr size_t O_W2T0  = O_W1T1  + (size_t)256 * 2048 * 2;
constexpr size_t O_W2T1  = O_W2T0  + (size_t)64 * 256 * 2;
constexpr size_t O_BPART = O_W2T1  + (size_t)64 * 256 * 2;
constexpr size_t O_ROPEN = O_BPART + (size_t)2 * 16 * 256 * 4;
constexpr size_t O_ROPER = O_ROPEN + (size_t)S_ * 8 * 8;
constexpr size_t O_H     = O_ROPER + (size_t)S_ * 64 * 8;
constexpr size_t O_QN    = O_H     + (size_t)S_ * 1024 * 2;
constexpr size_t O_RAW0  = O_QN    + (size_t)S_ * 512 * 2;
constexpr size_t O_RAW1  = O_RAW0  + (size_t)S_ * 128 * 2;
constexpr size_t O_KS    = O_RAW1  + (size_t)S_ * 128 * 2;
constexpr size_t O_VST   = O_KS    + (size_t)2 * S_ * 64 * 2;
constexpr size_t O_KW    = O_VST   + (size_t)2 * S_ * 64 * 2;
constexpr size_t O_VWT   = O_KW    + (size_t)2 * S_ * 64 * 2;
constexpr size_t O_SZN   = O_VWT   + (size_t)2 * S_ * 64 * 2;
constexpr size_t O_QR    = O_SZN   + (size_t)S_ * 512 * 2;
constexpr size_t O_KR    = O_QR    + (size_t)4 * S_ * 128 * 2;
constexpr size_t O_KRT   = O_KR    + (size_t)4 * S_ * 128 * 2;
constexpr size_t O_VRT   = O_KRT   + (size_t)4 * S_ * 128 * 2;
constexpr size_t O_SZR   = O_VRT   + (size_t)4 * S_ * 256 * 2;
constexpr size_t O_GN    = O_SZR   + (size_t)S_ * 1024 * 2;
constexpr size_t O_SLAB  = O_GN    + (size_t)S_ * 24 * 4;
constexpr size_t O_KC    = O_SLAB  + (size_t)4 * 2 * 2048 * 256 * 4;
constexpr size_t O_VCT   = O_KC    + (size_t)2 * 1024 * 64 * 2;
constexpr size_t O_ROWSS = O_VCT   + (size_t)2 * 1024 * 64 * 2;
constexpr size_t WS_BYTES = O_ROWSS + (size_t)S_ * 8 * 4;

struct KArgs {
    const float *x, *norm_pre, *w_in, *b_gate, *pe_k, *w1_k, *w2_k, *pe_v, *w1_v, *w2_v, *w_nsa_o, *w_ret_o, *w_out, *norm_post;
    float* out; char* ws; int use_cg; int probe;
};

__global__ void __launch_bounds__(256, 2) fwd_megakernel(KArgs ka) {
    Params p;
    p.x = ka.x; p.norm_pre = ka.norm_pre; p.w_in = ka.w_in; p.b_gate = ka.b_gate; p.pe_k = ka.pe_k; p.w1_k = ka.w1_k; p.w2_k = ka.w2_k;
    p.pe_v = ka.pe_v; p.w1_v = ka.w1_v; p.w2_v = ka.w2_v; p.w_nsa_o = ka.w_nsa_o; p.w_ret_o = ka.w_ret_o; p.w_out = ka.w_out; p.norm_post = ka.norm_post;
    p.out = ka.out; p.use_cg = ka.use_cg; p.probe = ka.probe;
    {
        char* ws = ka.ws;
        p.bar = (unsigned*)(ws + O_BAR);
        p.WinT = (u16*)(ws + O_WINT); p.WnoT = (u16*)(ws + O_WNOT); p.WroT = (u16*)(ws + O_WROT); p.WoutT = (u16*)(ws + O_WOUTT);
        p.W1T[0] = (u16*)(ws + O_W1T0); p.W1T[1] = (u16*)(ws + O_W1T1); p.W2T[0] = (u16*)(ws + O_W2T0); p.W2T[1] = (u16*)(ws + O_W2T1);
        p.bpart = (float*)(ws + O_BPART); p.ropeN = (float2*)(ws + O_ROPEN); p.ropeR = (float2*)(ws + O_ROPER);
        p.H = (u16*)(ws + O_H); p.Qn = (u16*)(ws + O_QN); p.Raw[0] = (u16*)(ws + O_RAW0); p.Raw[1] = (u16*)(ws + O_RAW1);
        p.Ks = (u16*)(ws + O_KS); p.VsT = (u16*)(ws + O_VST); p.Kw = (u16*)(ws + O_KW); p.VwT = (u16*)(ws + O_VWT);
        p.SZn = (u16*)(ws + O_SZN); p.Qr = (u16*)(ws + O_QR); p.Kr = (u16*)(ws + O_KR); p.KrT = (u16*)(ws + O_KRT); p.VrT = (u16*)(ws + O_VRT);
        p.SZr = (u16*)(ws + O_SZR); p.Gn = (float*)(ws + O_GN); p.slab = (float*)(ws + O_SLAB); p.Kc = (u16*)(ws + O_KC); p.VcT = (u16*)(ws + O_VCT);
        p.rowss = (float*)(ws + O_ROWSS);
        p.Ma = (u16*)ka.out; p.Mb = (u16*)ka.out + (size_t)S_ * 1024;
    }
    __shared__ __attribute__((aligned(16))) unsigned char smem[69632];
    __shared__ uint4 xb_words;
    if (threadIdx.x == 0) xb_words = make_uint4(0u, 0u, 0u, 0u);
    __syncthreads();
    XcdBarrier b = xcd_barrier_post(p.bar, (volatile LAS unsigned*)&xb_words);
    const int G = gridDim.x, B = blockIdx.x;
#define GRID_SYNC() do { if (p.use_cg) cg::this_grid().sync(); else xcd_barrier(b); } while (0)

    for (int rep = (MK_PROBE & 1) ? 0 : 1; rep < 2; ++rep)
    for (int u = B; u < P0_UNITS; u += G) p0_unit(p, u, smem);
    GRID_SYNC();
    for (int rep = (MK_PROBE & 2) ? 0 : 1; rep < 2; ++rep)
    for (int t = B; t < 55 * 128; t += G) p1_tile(p, t, smem);
    GRID_SYNC();
    for (int rep = (MK_PROBE & 4) ? 0 : 1; rep < 2; ++rep)
    for (int u = B; u < P2_UNITS; u += G) p2_unit(p, u, smem);
    GRID_SYNC();
    for (int rep = (MK_PROBE & 8) ? 0 : 1; rep < 2; ++rep)
    for (int u = B; u < P3_UNITS; u += G) p3_unit(p, u, smem);
    p3_scan(p);
    GRID_SYNC();
    for (int u = B; u < 1536; u += G) {
        if (u < 1024) nsa_item(p, (u < 512) ? 511 - (u >> 1) : ((u - 512) >> 1), u & 1, smem);
        else { if (MK_PROBE & 4096) ret_item(p, (u - 1024) >> 2, (u - 1024) & 3, false); ret_item(p, (u - 1024) >> 2, (u - 1024) & 3, true); }
    }
    GRID_SYNC();
    for (int rep = (MK_PROBE & 16) ? 0 : 1; rep < 2; ++rep)
    for (int t = B; t < 1024; t += G) p5_tile(p, t, smem);
    GRID_SYNC();
    for (int rep = (MK_PROBE & 32) ? 0 : 1; rep < 2; ++rep)
    for (int t = B; t < 1024; t += G) p6_tile(p, t, smem);
    GRID_SYNC();
    for (int rep = (MK_PROBE & 64) ? 0 : 1; rep < 2; ++rep)
    p7_all(p);
}

extern "C" void kernel_launch(void* const* d_in, const int* in_sizes, int n_in, void* d_out, int out_size,
                              void* d_ws, size_t ws_size, hipStream_t stream) {
    static int grid_blocks = 0;
    if (!grid_blocks) {
        int dev = 0, cus = 0, per_cu = 0;
        (void)hipGetDevice(&dev);
        (void)hipDeviceGetAttribute(&cus, hipDeviceAttributeMultiprocessorCount, dev);
        (void)hipOccupancyMaxActiveBlocksPerMultiprocessor(&per_cu, fwd_megakernel, 256, 0);
        if (per_cu > 2) per_cu = 2;
        if (per_cu < 1) per_cu = 1;
        grid_blocks = cus * per_cu;
    }
    KArgs ka{};
    ka.x = (const float*)d_in[0]; ka.norm_pre = (const float*)d_in[1]; ka.w_in = (const float*)d_in[2]; ka.b_gate = (const float*)d_in[3];
    ka.pe_k = (const float*)d_in[4]; ka.w1_k = (const float*)d_in[5]; ka.w2_k = (const float*)d_in[6];
    ka.pe_v = (const float*)d_in[7]; ka.w1_v = (const float*)d_in[8]; ka.w2_v = (const float*)d_in[9];
    ka.w_nsa_o = (const float*)d_in[10]; ka.w_ret_o = (const float*)d_in[11]; ka.w_out = (const float*)d_in[12]; ka.norm_post = (const float*)d_in[13];
    ka.out = (float*)d_out; ka.ws = (char*)d_ws; ka.use_cg = 0; ka.probe = MK_PROBE;
    if (WS_BYTES > ws_size) { fprintf(stderr, "workspace too small: need %zu have %zu\n", (size_t)WS_BYTES, ws_size); return; }
    (void)hipMemsetAsync(d_ws, 0, XCD_BAR_WORDS * 4, stream);
    void* args[] = {&ka};
    hipError_t e = hipLaunchCooperativeKernel((void*)fwd_megakernel, dim3(grid_blocks), dim3(256), args, 0, stream);
    if (e != hipSuccess) fprintf(stderr, "cooperative launch failed: %s (grid %d)\n", hipGetErrorString(e), grid_blocks);
}
```

```cpp
#include <hip/hip_runtime.h>
#include <hip/hip_cooperative_groups.h>
#include <cstdio>
namespace cg = cooperative_groups;

#define DI __device__ __forceinline__
#define LAS __attribute__((address_space(3)))

#define XB_TMO      128
#define XB_XCNT(j)  (256  + 64 * (j))
#define XB_XSUB(j)  (1280 + 64 * (j))
#define XB_XGEN(j)  (2304 + 64 * (j))
#define XB_TOP      3328
#define XB_TOPGEN   3392
#define XCD_BAR_WORDS 3456
#define XB_SPIN_CAP (1u << 22)

DI unsigned xb_ld(unsigned* p)              { return __hip_atomic_load(p, __ATOMIC_RELAXED, __HIP_MEMORY_SCOPE_AGENT); }
DI unsigned xb_add(unsigned* p, unsigned v) { return __hip_atomic_fetch_add(p, v, __ATOMIC_RELAXED, __HIP_MEMORY_SCOPE_AGENT); }
DI unsigned xb_xcc_id() { return (unsigned)__builtin_amdgcn_s_getreg((3 << 11) | 20) & 0xFu; }
#define XB_SPIN(cond, bar) do { unsigned _sp = 0; while (cond) { __builtin_amdgcn_s_sleep(1); \
    if ((++_sp & 255u) == 0u) { if (xb_ld(&(bar)[XB_TMO])) break; if (_sp > XB_SPIN_CAP) { atomicAdd(&(bar)[XB_TMO], 1u); break; } } } } while (0)

struct XcdBarrier { unsigned* bar; unsigned x; volatile LAS unsigned* st; };

DI XcdBarrier xcd_barrier_post(unsigned* bar, volatile LAS unsigned* st) {
    XcdBarrier b; b.bar = bar; b.x = xb_xcc_id(); b.st = st;
    if (threadIdx.x == 0) (void)xb_add(&bar[XB_XCNT(b.x)], 1u);
    return b;
}
DI void xcd_barrier_complete(unsigned* bar, unsigned x, unsigned& nloc, unsigned& nx) {
    const unsigned G = gridDim.x * gridDim.y * gridDim.z;
    unsigned sum, cnt, mine, sp = 0u;
    for (;;) {
        sum = 0u; cnt = 0u; mine = 0u;
#pragma unroll
        for (unsigned j = 0; j < 16; ++j) { const unsigned c = xb_ld(&bar[XB_XCNT(j)]); sum += c; cnt += (c > 0u) ? 1u : 0u; mine = (j == x) ? c : mine; }
        if (sum == G) break;
        __builtin_amdgcn_s_sleep(1);
        if ((++sp & 255u) == 0u) { if (xb_ld(&bar[XB_TMO])) break; if (sp > XB_SPIN_CAP) { atomicAdd(&bar[XB_TMO], 1u); break; } }
    }
    nloc = mine > 0u ? mine : 1u; nx = cnt > 0u ? cnt : 1u;
}
DI void xcd_barrier(const XcdBarrier& b) {
    asm volatile("s_waitcnt vmcnt(0)" ::: "memory");
    __syncthreads();
    if (threadIdx.x == 0) {
        unsigned* bar = b.bar;
        __builtin_amdgcn_s_waitcnt(0);
        unsigned nloc = b.st[0], nx = b.st[1];
        if (nloc == 0u) { xcd_barrier_complete(bar, b.x, nloc, nx); b.st[0] = nloc; b.st[1] = nx; }
        const unsigned old = xb_add(&bar[XB_XSUB(b.x)], 1u);
        const unsigned gen = old / nloc;
        if (old + 1u == (gen + 1u) * nloc) {
            __builtin_amdgcn_fence(__ATOMIC_RELEASE, "agent");
            asm volatile("s_waitcnt vmcnt(0)" ::: "memory");
            const unsigned og = xb_add(&bar[XB_TOP], 1u);
            const unsigned tg = og / nx;
            if (og + 1u == (tg + 1u) * nx) xb_add(&bar[XB_TOPGEN], 1u);
            else XB_SPIN(xb_ld(&bar[XB_TOPGEN]) == tg, bar);
            __builtin_amdgcn_fence(__ATOMIC_ACQUIRE, "agent");
            xb_add(&bar[XB_XGEN(b.x)], 1u);
            asm volatile("s_waitcnt vmcnt(0)" ::: "memory");
        } else {
            XB_SPIN(xb_ld(&bar[XB_XGEN(b.x)]) == gen, bar);
            __builtin_amdgcn_fence(__ATOMIC_ACQUIRE, "agent");
            asm volatile("s_waitcnt vmcnt(0)" ::: "memory");
        }
    }
    __syncthreads();
}


#ifndef MK_PROBE
#define MK_PROBE 0
#endif
#define MK_TS -1
typedef unsigned short u16;
using bf16x8 = __attribute__((ext_vector_type(8))) short;
using f32x4  = __attribute__((ext_vector_type(4))) float;
using u32x4  = __attribute__((ext_vector_type(4))) unsigned;
using u32x2  = __attribute__((ext_vector_type(2))) unsigned;
typedef __attribute__((ext_vector_type(2))) __bf16 bf2_t;
#define MFMA16(a, b, c) __builtin_amdgcn_mfma_f32_16x16x32_bf16((a), (b), (c), 0, 0, 0)

constexpr int S_ = 16384, DM_ = 1024, NPAD_ = 7168;
constexpr int LDT = 64;
DI int swzA(int row) { return row & 7; }
DI int swzK(int row) { return (((row >> 3) & 3) << 1) | ((row >> 1) & 1); }
constexpr int TILE_ELEMS = 128 * LDT;
constexpr int CST = 132;
constexpr float LOG2E = 1.4426950408889634f;

template <int N> struct IC { static constexpr int value = N; };
DI int TID() { int t = threadIdx.x & 255; asm volatile("" : "+v"(t)); return t; }
DI int TEAM() { return __builtin_amdgcn_readfirstlane((int)(threadIdx.x >> 8)); }
DI unsigned pack2(float a, float b) { bf2_t v = {(__bf16)a, (__bf16)b}; return __builtin_bit_cast(unsigned, v); }
DI float bflo(unsigned u) { return __uint_as_float(u << 16); }
DI float bfhi(unsigned u) { return __uint_as_float(u & 0xffff0000u); }
DI u32x4 ld16(const u16* p) { return *(const u32x4*)p; }
DI bf16x8 ldf(const u16* p) { return *(const bf16x8*)p; }
DI u32x4 pack8(const float* v) { u32x4 r; r[0] = pack2(v[0], v[1]); r[1] = pack2(v[2], v[3]); r[2] = pack2(v[4], v[5]); r[3] = pack2(v[6], v[7]); return r; }
DI bf16x8 packf(f32x4 a, f32x4 b) { u32x4 r; r[0] = pack2(a[0], a[1]); r[1] = pack2(a[2], a[3]); r[2] = pack2(b[0], b[1]); r[3] = pack2(b[2], b[3]); return __builtin_bit_cast(bf16x8, r); }
DI float ex2(float x) { return __builtin_amdgcn_exp2f(x); }
DI float sigmoidf_(float x) { return 1.f / (1.f + __expf(-x)); }
#define DPP_U(v, ctrl) ((unsigned)__builtin_amdgcn_update_dpp(0, (int)(v), (ctrl), 0xf, 0xf, true))
DI unsigned wave_umax(unsigned v) {
    v = max(v, DPP_U(v, 0xB1));
    v = max(v, DPP_U(v, 0x4E));
    v = max(v, DPP_U(v, 0x141));
    v = max(v, DPP_U(v, 0x140));
    auto r = __builtin_amdgcn_permlane16_swap(v, v, false, false);
    v = max(r[0], r[1]);
    auto s = __builtin_amdgcn_permlane32_swap(v, v, false, false);
    v = max(s[0], s[1]);
    return (unsigned)__builtin_amdgcn_readfirstlane((int)v);
}
DI float qmax(float x) {
    unsigned u = __float_as_uint(x);
    auto r = __builtin_amdgcn_permlane16_swap(u, u, false, false);
    x = fmaxf(__uint_as_float(r[0]), __uint_as_float(r[1]));
    u = __float_as_uint(x);
    auto s = __builtin_amdgcn_permlane32_swap(u, u, false, false);
    return fmaxf(__uint_as_float(s[0]), __uint_as_float(s[1]));
}
DI float qsum(float x) {
    unsigned u = __float_as_uint(x);
    auto r = __builtin_amdgcn_permlane16_swap(u, u, false, false);
    x = __uint_as_float(r[0]) + __uint_as_float(r[1]);
    u = __float_as_uint(x);
    auto s = __builtin_amdgcn_permlane32_swap(u, u, false, false);
    return __uint_as_float(s[0]) + __uint_as_float(s[1]);
}
DI float wave_max(float v) {
#pragma unroll
    for (int o = 32; o >= 1; o >>= 1) v = fmaxf(v, __shfl_xor(v, o));
    return v;
}
DI float wave_sum(float v) {
#pragma unroll
    for (int o = 32; o >= 1; o >>= 1) v += __shfl_xor(v, o);
    return v;
}

struct Params {
    const float *x, *norm_pre, *w_in, *b_gate, *pe_k, *w1_k, *w2_k, *pe_v, *w1_v, *w2_v, *w_nsa_o, *w_ret_o, *w_out, *norm_post;
    float* out;
    unsigned* bar;
    u16 *WinT, *WnoT, *WroT, *WoutT, *W1T[2], *W2T[2];
    float* bpart;
    float2 *ropeN, *ropeR;
    u16 *H;
    u16 *Qn;
    u16 *Raw[2];
    u16 *Ks, *VsT, *Kw, *VwT;
    u16 *SZn;
    u16 *Qr, *Kr;
    u16 *KrT;
    u16 *VrT;
    u16 *SZr;
    u16 *Ma, *Mb;
    float* Gn;
    float* slab;
    u16 *Kc, *VcT;
    float* rowss;
    int use_cg; int probe;
};

struct GemmPre { u32x4 ra[4], rb[4]; };
DI void gemm128_prefetch(const u16* a0, size_t a_r32, const u16* b0, size_t b_r32, GemmPre& pre) {
#pragma unroll
    for (int i = 0; i < 4; ++i) { pre.ra[i] = ld16(a0 + i * a_r32); pre.rb[i] = ld16(b0 + i * b_r32); }
}
DI void gemm128_main(const u16* a0, size_t a_r32, int astep, const u16* b0, size_t b_r32, int bstep, int nk,
                     u16* lds, f32x4 (&acc)[4][4], const GemmPre* pre = nullptr) {
    const int tid = TID(), lane = tid & 63, w = tid >> 6;
    const int wr = w >> 1, wc = w & 1, lr = lane & 15, q = lane >> 4;
    const int wofs = (tid >> 3) * LDT + (((tid & 7) ^ swzA(tid >> 3)) << 3);
    u32x4 ra0[4], rb0[4], ra1[4], rb1[4];
    auto gl = [&](int kt, u32x4 (&ra)[4], u32x4 (&rb)[4]) {
        const int k = kt < nk ? kt : nk - 1;
        const u16* ap = a0 + (size_t)k * astep; const u16* bp = b0 + (size_t)k * bstep;
#pragma unroll
        for (int i = 0; i < 4; ++i) { ra[i] = ld16(ap + i * a_r32); rb[i] = ld16(bp + i * b_r32); }
    };
    auto st = [&](u16* buf, const u32x4 (&ra)[4], const u32x4 (&rb)[4]) {
#pragma unroll
        for (int i = 0; i < 4; ++i) {
            *(u32x4*)(buf + wofs + i * 32 * LDT) = ra[i];
            *(u32x4*)(buf + TILE_ELEMS + wofs + i * 32 * LDT) = rb[i];
        }
    };
    auto mm = [&](const u16* As) {
        const u16* Bs = As + TILE_ELEMS;
#pragma unroll
        for (int ks = 0; ks < 2; ++ks) {
            bf16x8 af[4], bfr[4];
#pragma unroll
            for (int t = 0; t < 4; ++t) {
                af[t]  = ldf(As + (64 * wr + 16 * t + lr) * LDT + (((ks * 4 + q) ^ (lr & 7)) << 3));
                bfr[t] = ldf(Bs + (64 * wc + 16 * t + lr) * LDT + (((ks * 4 + q) ^ (lr & 7)) << 3));
            }
#pragma unroll
            for (int ti = 0; ti < 4; ++ti)
#pragma unroll
                for (int tj = 0; tj < 4; ++tj) acc[ti][tj] = MFMA16(af[ti], bfr[tj], acc[ti][tj]);
        }
    };
    u16* buf0 = lds; u16* buf1 = lds + 2 * TILE_ELEMS;
    if (pre) {
#pragma unroll
        for (int i = 0; i < 4; ++i) { ra0[i] = pre->ra[i]; rb0[i] = pre->rb[i]; }
    } else gl(0, ra0, rb0);
    st(buf0, ra0, rb0);
    gl(1, ra1, rb1);
    __syncthreads();
    for (int kt = 0; kt < nk; kt += 2) {
        gl(kt + 2, ra0, rb0);
        __builtin_amdgcn_sched_barrier(0);
        mm(buf0);
        __builtin_amdgcn_sched_barrier(0);
        st(buf1, ra1, rb1);
        __syncthreads();
        gl(kt + 3, ra1, rb1);
        __builtin_amdgcn_sched_barrier(0);
        mm(buf1);
        __builtin_amdgcn_sched_barrier(0);
        st(buf0, ra0, rb0);
        __syncthreads();
    }
}
DI void gemm256_main(const u16* a0, size_t a_r64, const u16* b0, size_t b_r64, int nk, u16* lds, f32x4 (&acc)[8][4]) {
    int tid = threadIdx.x; asm volatile("" : "+v"(tid));
    const int lane = tid & 63, w = tid >> 6, wr = w >> 2, wc = w & 3, lr = lane & 15, q = lane >> 4;
    const int wofs = (tid >> 3) * 64 + (((tid & 7) ^ ((tid >> 3) & 7)) << 3);
    u32x4 ra[4], rb[4];
    auto gl = [&](int kt) {
        const int k = kt < nk ? kt : nk - 1;
#pragma unroll
        for (int i = 0; i < 4; ++i) { ra[i] = ld16(a0 + (size_t)k * 64 + i * a_r64); rb[i] = ld16(b0 + (size_t)k * 64 + i * b_r64); }
    };
    auto st = [&](u16* buf) {
#pragma unroll
        for (int i = 0; i < 4; ++i) { *(u32x4*)(buf + wofs + i * 4096) = ra[i]; *(u32x4*)(buf + 16384 + wofs + i * 4096) = rb[i]; }
    };
    auto ktile = [&](const u16* As, u16* nxt) {
        const u16* Bs = As + 16384;
        const int co0 = (q ^ (lr & 7)) << 3, co1 = ((4 + q) ^ (lr & 7)) << 3;
        bf16x8 b0f[4], b1f[4], a0f[8], a1f[8];
#pragma unroll
        for (int t = 0; t < 4; ++t) b0f[t] = ldf(Bs + (64 * wc + 16 * t + lr) * 64 + co0);
#pragma unroll
        for (int t = 0; t < 3; ++t) a0f[t] = ldf(As + (128 * wr + 16 * t + lr) * 64 + co0);
#pragma unroll
        for (int ti = 0; ti < 8; ++ti) {
            if (ti + 3 < 8) a0f[ti + 3] = ldf(As + (128 * wr + 16 * (ti + 3) + lr) * 64 + co0);
            if (ti == 5) { b1f[0] = ldf(Bs + (64 * wc + lr) * 64 + co1); b1f[1] = ldf(Bs + (64 * wc + 16 + lr) * 64 + co1); }
            if (ti == 6) { b1f[2] = ldf(Bs + (64 * wc + 32 + lr) * 64 + co1); b1f[3] = ldf(Bs + (64 * wc + 48 + lr) * 64 + co1); }
            if (ti == 7) { a1f[0] = ldf(As + (128 * wr + lr) * 64 + co1); a1f[1] = ldf(As + (128 * wr + 16 + lr) * 64 + co1); }
#pragma unroll
            for (int tj = 0; tj < 4; ++tj) acc[ti][tj] = MFMA16(a0f[ti], b0f[tj], acc[ti][tj]);
        }
#pragma unroll
        for (int ti = 0; ti < 8; ++ti) {
            if (ti + 2 < 8) a1f[ti + 2] = ldf(As + (128 * wr + 16 * (ti + 2) + lr) * 64 + co1);
#pragma unroll
            for (int tj = 0; tj < 4; ++tj) acc[ti][tj] = MFMA16(a1f[ti], b1f[tj], acc[ti][tj]);
        }
        st(nxt);
        __builtin_amdgcn_sched_group_barrier(0x100, 7, 0);
#pragma unroll
        for (int ti = 0; ti < 8; ++ti) {
            if (ti < 5) __builtin_amdgcn_sched_group_barrier(0x100, 1, 0);
            if (ti >= 5) __builtin_amdgcn_sched_group_barrier(0x100, 2, 0);
            __builtin_amdgcn_sched_group_barrier(0x008, 4, 0);
        }
#pragma unroll
        for (int ti = 0; ti < 8; ++ti) {
            if (ti < 6) __builtin_amdgcn_sched_group_barrier(0x100, 1, 0);
            __builtin_amdgcn_sched_group_barrier(0x008, 4, 0);
            __builtin_amdgcn_sched_group_barrier(0x200, 1, 0);
        }
    };
    gl(0);
    st(lds);
    __syncthreads();
    for (int kt = 0; kt < nk; ++kt) {
        u16* cur = lds + (kt & 1) * 32768;
        u16* nxt = lds + ((kt + 1) & 1) * 32768;
        gl(kt + 1);
        __builtin_amdgcn_sched_barrier(0);
        ktile(cur, nxt);
        __syncthreads();
    }
}
DI void zero_acc8(f32x4 (&acc)[8][4]) {
#pragma unroll
    for (int i = 0; i < 8; ++i)
#pragma unroll
        for (int j = 0; j < 4; ++j) acc[i][j] = f32x4{0.f, 0.f, 0.f, 0.f};
}
DI void stage_acc8(unsigned char* smem_all, int pass, const f32x4 (&acc)[8][4]) {
    const int tid = threadIdx.x, lane = tid & 63, w = tid >> 6, wr = w >> 2, wc = w & 3, lr = lane & 15, q = lane >> 4;
    if (wr != pass) return;
    float* cst = (float*)(smem_all + (wc >> 1) * 69632);
#pragma unroll
    for (int ti = 0; ti < 8; ++ti)
#pragma unroll
        for (int tj = 0; tj < 4; ++tj)
#pragma unroll
            for (int r = 0; r < 4; ++r) cst[(16 * ti + 4 * q + r) * CST + (wc & 1) * 64 + 16 * tj + lr] = acc[ti][tj][r];
}
DI void zero_acc(f32x4 (&acc)[4][4]) {
#pragma unroll
    for (int i = 0; i < 4; ++i)
#pragma unroll
        for (int j = 0; j < 4; ++j) acc[i][j] = f32x4{0.f, 0.f, 0.f, 0.f};
}
DI void stage_acc(float* cst, const f32x4 (&acc)[4][4]) {
    const int lane = TID() & 63, w = TID() >> 6;
    const int wr = w >> 1, wc = w & 1, lr = lane & 15, q = lane >> 4;
#pragma unroll
    for (int ti = 0; ti < 4; ++ti)
#pragma unroll
        for (int tj = 0; tj < 4; ++tj)
#pragma unroll
            for (int r = 0; r < 4; ++r)
                cst[(64 * wr + 16 * ti + 4 * q + r) * CST + 64 * wc + 16 * tj + lr] = acc[ti][tj][r];
}
template <typename F> DI void emit_rows(const float* cst, F f) {
#pragma unroll 4
    for (int i = 0; i < 8; ++i) {
        const int item = TID() + 256 * i, row = item >> 4, c8 = item & 15;
        const float4 a = *(const float4*)(cst + row * CST + c8 * 8);
        const float4 b = *(const float4*)(cst + row * CST + c8 * 8 + 4);
        float v[8] = {a.x, a.y, a.z, a.w, b.x, b.y, b.z, b.w};
        f(row, c8, v);
    }
}
template <typename F> DI void emit_cols(const float* cst, F f) {
#pragma unroll 4
    for (int i = 0; i < 8; ++i) {
        const int item = TID() + 256 * i, rest = item >> 6;
        const int col = (item & 15) + 16 * (rest & 7), r8 = ((item >> 4) & 3) + 4 * (rest >> 3);
        float v[8];
#pragma unroll
        for (int k = 0; k < 8; ++k) v[k] = cst[(r8 * 8 + k) * CST + col];
        f(col, r8, v);
    }
}


DI void transpose_tile(const float* src, int ldsrc, int k0, int n0, u16* dst, int lddst, int map_in, float* tl) {
    const int tid = TID();
    const int c = tid & 63;
    int oc = n0 + c;
    if (map_in) oc = (oc < 1280) ? oc : (oc < 6912 ? oc + 24 : (oc < 6936 ? oc - 6912 + 1280 : -1));
#pragma unroll
    for (int i = 0; i < 16; ++i) {
        const int r = (tid >> 6) + 4 * i;
        tl[r * 65 + c] = (oc >= 0) ? src[(size_t)(k0 + r) * ldsrc + oc] : 0.f;
    }
    __syncthreads();
    const int nl = tid >> 2, kc = (tid & 3) * 16;
    float v[16];
#pragma unroll
    for (int i = 0; i < 16; ++i) v[i] = tl[(kc + i) * 65 + nl];
    u16* d = dst + (size_t)(n0 + nl) * lddst + k0 + kc;
    *(u32x4*)d = pack8(v);
    *(u32x4*)(d + 8) = pack8(v + 8);
    __syncthreads();
}

DI void transpose_tile4(const float* src, int ldsrc, int k0, int n0, u16* dst, int lddst, int map_in, float* tl) {
    const int tid = TID();
    const int c = tid & 63;
    int oc = n0 + c;
    if (map_in) oc = (oc < 1280) ? oc : (oc < 6912 ? oc + 24 : (oc < 6936 ? oc - 6912 + 1280 : -1));
    float ld[64];
#pragma unroll
    for (int i = 0; i < 64; ++i) {
        const int r = (tid >> 6) + 4 * i;
        ld[i] = (oc >= 0) ? src[(size_t)(k0 + r) * ldsrc + oc] : 0.f;
    }
#pragma unroll
    for (int i = 0; i < 64; ++i) tl[((tid >> 6) + 4 * i) * 65 + c] = ld[i];
    __syncthreads();
    const int nl = tid >> 2, kc = (tid & 3) * 64;
    u16* d = dst + (size_t)(n0 + nl) * lddst + k0 + kc;
#pragma unroll
    for (int h = 0; h < 8; ++h) {
        float v[8];
#pragma unroll
        for (int i = 0; i < 8; ++i) v[i] = tl[(kc + 8 * h + i) * 65 + nl];
        *(u32x4*)(d + 8 * h) = pack8(v);
    }
    __syncthreads();
}

DI void p0_unit(const Params& p, int u, unsigned char* smem) {
    const int tid = TID(), lane = tid & 63, w = tid >> 6;
    float* tl = (float*)smem;
    if (u < 1352) {
        int t = u;
        if (t < 448) { transpose_tile4(p.w_in, 6936, (t & 3) * 256, (t >> 2) * 64, p.WinT, 1024, 1, tl); return; }
        t -= 448;
        if (t < 128) { transpose_tile(p.w_nsa_o, 1024, (t & 7) * 64, (t >> 3) * 64, p.WnoT, 512, 0, tl); return; }
        t -= 128;
        if (t < 256) { transpose_tile(p.w_ret_o, 1024, (t & 15) * 64, (t >> 4) * 64, p.WroT, 1024, 0, tl); return; }
        t -= 256;
        if (t < 256) { transpose_tile(p.w_out, 1024, (t & 15) * 64, (t >> 4) * 64, p.WoutT, 1024, 0, tl); return; }
        t -= 256;
        if (t < 128) { transpose_tile(p.w1_k, 256, (t & 31) * 64, (t >> 5) * 64, p.W1T[0], 2048, 0, tl); return; }
        t -= 128;
        if (t < 128) { transpose_tile(p.w1_v, 256, (t & 31) * 64, (t >> 5) * 64, p.W1T[1], 2048, 0, tl); return; }
        t -= 128;
        if (t < 4) { transpose_tile(p.w2_k, 64, t * 64, 0, p.W2T[0], 256, 0, tl); return; }
        t -= 4;
        transpose_tile(p.w2_v, 64, t * 64, 0, p.W2T[1], 256, 0, tl);
        return;
    }
    u -= 1352;
    if (u < 512) {
        float4 v[8][4]; float ss[8];
#pragma unroll
        for (int rr = 0; rr < 8; ++rr) {
            const float* xr = p.x + (size_t)(u * 32 + w * 8 + rr) * 1024;
#pragma unroll
            for (int i = 0; i < 4; ++i) { const f32x4 t4 = __builtin_nontemporal_load((const f32x4*)(xr + lane * 4 + 256 * i)); v[rr][i] = make_float4(t4[0], t4[1], t4[2], t4[3]); }
        }
        float4 g[4];
#pragma unroll
        for (int i = 0; i < 4; ++i) g[i] = *(const float4*)(p.norm_pre + lane * 4 + 256 * i);
#pragma unroll
        for (int rr = 0; rr < 8; ++rr) {
            float s = 0.f;
#pragma unroll
            for (int i = 0; i < 4; ++i) s += v[rr][i].x * v[rr][i].x + v[rr][i].y * v[rr][i].y + v[rr][i].z * v[rr][i].z + v[rr][i].w * v[rr][i].w;
            ss[rr] = wave_sum(s);
        }
#pragma unroll
        for (int rr = 0; rr < 8; ++rr) {
            const float rs = rsqrtf(ss[rr] * (1.f / 1024.f) + 1e-6f);
            u16* hr = p.H + (size_t)(u * 32 + w * 8 + rr) * 1024;
#pragma unroll
            for (int i = 0; i < 4; ++i) {
                u32x2 o; o[0] = pack2(v[rr][i].x * rs * g[i].x, v[rr][i].y * rs * g[i].y); o[1] = pack2(v[rr][i].z * rs * g[i].z, v[rr][i].w * rs * g[i].w);
                *(u32x2*)(hr + lane * 4 + 256 * i) = o;
            }
        }
        return;
    }
    u -= 512;
    if (u < 4096) {
        const int e = u * 256 + tid, pos = e >> 6, i = e & 63;
        const float inv = 1.0f / powf(10000.0f, (float)i / 63.0f);
        const float ang = (float)pos * inv;
        float sn, cs; sincosf(ang, &sn, &cs);
        p.ropeR[e] = make_float2(cs, sn);
        return;
    }
    u -= 4096;
    if (u < 512) {
        const int e = u * 256 + tid, pos = e >> 3, i = e & 7;
        const float inv = 1.0f / powf(500000.0f, (float)(2 * i) / 16.0f);
        const float ang = (float)pos * inv;
        float sn, cs; sincosf(ang, &sn, &cs);
        p.ropeN[e] = make_float2(cs, sn);
        return;
    }
    u -= 512;
    {
        const int kv = u >> 4, ch = u & 15;
        const float* pe = kv ? p.pe_v : p.pe_k;
        const float* w1 = kv ? p.w1_v : p.w1_k;
        float s = 0.f;
        for (int k = ch * 128; k < ch * 128 + 128; ++k) s += pe[k] * w1[(size_t)k * 256 + tid];
        p.bpart[(kv * 16 + ch) * 256 + tid] = s;
    }
}
constexpr int P0_UNITS = 1352 + 512 + 4096 + 512 + 32;

DI void p1_epi(const Params& p, float* cst, int mt, int nt) {
    const int tid = TID();
    const int tok0 = mt * 128;
    if (nt <= 4 || nt == 6 || nt == 8) {
#pragma unroll 2
        for (int i = 0; i < 8; ++i) {
            const int item = tid + 256 * i, row = item >> 4, hh = (item >> 3) & 1, ii = item & 7;
            float* px = cst + row * CST + hh * 64 + ii;
            const float x1 = px[0], x2 = px[8];
            const float2 cs = p.ropeN[(size_t)(tok0 + row) * 8 + ii];
            px[0] = x1 * cs.x - x2 * cs.y; px[8] = x2 * cs.x + x1 * cs.y;
        }
    } else if (nt >= 14 && nt <= 21) {
        const float sc = (nt >= 18) ? 0.08838834764831845f : 1.0f;
#pragma unroll 2
        for (int i = 0; i < 32; ++i) {
            const int item = tid + 256 * i, row = item >> 6, ii = item & 63;
            float* px = cst + row * CST + ii;
            const float x1 = px[0], x2 = px[64];
            const float2 cs = p.ropeR[(size_t)(tok0 + row) * 64 + ii];
            px[0] = (x1 * cs.x - x2 * cs.y) * sc; px[64] = (x2 * cs.x + x1 * cs.y) * sc;
        }
    }
    __syncthreads();
    if (nt <= 3) {
        emit_rows(cst, [&](int row, int c8, const float* v) { __builtin_nontemporal_store(pack8(v), (u32x4*)(p.Qn + (size_t)(tok0 + row) * 512 + nt * 128 + c8 * 8)); });
    } else if (nt == 4 || nt == 5) {
        u16* dst = (nt == 4) ? p.Raw[0] : p.Raw[1];
        emit_rows(cst, [&](int row, int c8, const float* v) { __builtin_nontemporal_store(pack8(v), (u32x4*)(dst + (size_t)(tok0 + row) * 128 + c8 * 8)); });
    } else if (nt == 6 || nt == 8) {
        u16* dst = (nt == 6) ? p.Ks : p.Kw;
        emit_rows(cst, [&](int row, int c8, const float* v) { __builtin_nontemporal_store(pack8(v), (u32x4*)(dst + ((size_t)(c8 >> 3) * S_ + tok0 + row) * 64 + (c8 & 7) * 8)); });
    } else if (nt == 7 || nt == 9) {
        u16* dst = (nt == 7) ? p.VsT : p.VwT;
        emit_cols(cst, [&](int col, int r8, const float* v) {
            const int g = col >> 6, d = col & 63, tk = tok0 + r8 * 8;
            __builtin_nontemporal_store(pack8(v), (u32x4*)(dst + (((size_t)g * 256 + (tk >> 6)) * 64 + d) * 64 + (tk & 63))); });
    } else if (nt <= 13) {
        emit_rows(cst, [&](int row, int c8, const float* v) {
            float o[8];
#pragma unroll
            for (int k = 0; k < 8; ++k) o[k] = v[k] * sigmoidf_(v[k]);
            __builtin_nontemporal_store(pack8(o), (u32x4*)(p.SZn + (size_t)(tok0 + row) * 512 + (nt - 10) * 128 + c8 * 8)); });
    } else if (nt <= 17) {
        const int h = nt - 14;
        emit_rows(cst, [&](int row, int c8, const float* v) { __builtin_nontemporal_store(pack8(v), (u32x4*)(p.Qr + ((size_t)h * S_ + tok0 + row) * 128 + c8 * 8)); });
    } else if (nt <= 21) {
        const int h = nt - 18;
        emit_rows(cst, [&](int row, int c8, const float* v) { __builtin_nontemporal_store(pack8(v), (u32x4*)(p.Kr + ((size_t)h * S_ + tok0 + row) * 128 + c8 * 8)); });
        const float lg = logf(1.0f - exp2f(-5.0f - (float)h));
        emit_cols(cst, [&](int col, int r8, const float* v) {
            float o[8];
#pragma unroll
            for (int k = 0; k < 8; ++k) o[k] = v[k] * __expf((float)(127 - (r8 * 8 + k)) * lg);
            __builtin_nontemporal_store(pack8(o), (u32x4*)(p.KrT + (((size_t)h * 128 + mt) * 128 + col) * 128 + r8 * 8)); });
    } else if (nt <= 29) {
        const int h = (nt - 22) >> 1, e0 = ((nt - 22) & 1) * 128;
        emit_cols(cst, [&](int col, int r8, const float* v) {
            __builtin_nontemporal_store(pack8(v), (u32x4*)(p.VrT + (((size_t)h * 128 + mt) * 256 + e0 + col) * 128 + r8 * 8)); });
    } else if (nt <= 37) {
        emit_rows(cst, [&](int row, int c8, const float* v) {
            float o[8];
#pragma unroll
            for (int k = 0; k < 8; ++k) o[k] = v[k] * sigmoidf_(v[k]);
            __builtin_nontemporal_store(pack8(o), (u32x4*)(p.SZr + (size_t)(tok0 + row) * 1024 + (nt - 30) * 128 + c8 * 8)); });
    } else if (nt <= 53) {
        u16* dst = (nt <= 45) ? p.Ma : p.Mb;
        const int c0 = ((nt <= 45) ? (nt - 38) : (nt - 46)) * 128;
        emit_rows(cst, [&](int row, int c8, const float* v) {
            float o[8];
#pragma unroll
            for (int k = 0; k < 8; ++k) o[k] = sigmoidf_(v[k]);
            __builtin_nontemporal_store(pack8(o), (u32x4*)(dst + (size_t)(tok0 + row) * 1024 + c0 + c8 * 8)); });
    } else if (nt == 54) {
#pragma unroll 2
        for (int i = 0; i < 12; ++i) {
            const int item = tid + 256 * i, row = item / 24, c = item - row * 24;
            p.Gn[(size_t)(tok0 + row) * 24 + c] = sigmoidf_(cst[row * CST + c] + p.b_gate[c]);
        }
    }
    __syncthreads();
}

DI void p1_tile256(const Params& p, int t, unsigned char* smem_all) {
    const int tid = threadIdx.x, team = TEAM();
    const int nt = t >> 6, mt = t & 63;
    f32x4 acc[8][4]; zero_acc8(acc);
    gemm256_main(p.H + (size_t)(mt * 256 + (tid >> 3)) * 1024 + (tid & 7) * 8, (size_t)64 * 1024,
                 p.WinT + (size_t)(nt * 256 + (tid >> 3)) * 1024 + (tid & 7) * 8, (size_t)64 * 1024, 16, (u16*)smem_all, acc);
    float* cst = (float*)(smem_all + team * 69632);
#pragma unroll
    for (int pass = 0; pass < 2; ++pass) {
        stage_acc8(smem_all, pass, acc);
        __syncthreads();
        p1_epi(p, cst, mt * 2 + pass, nt * 2 + team);
    }
}


DI void p2_unit(const Params& p, int u, unsigned char* smem) {
    const int tid = TID(), lane = tid & 63, w = tid >> 6;
    u16* lds = (u16*)smem; float* cst = (float*)smem;
    f32x4 acc[4][4]; zero_acc(acc);
    if (u < 256) {
        const int nt = u & 1, mt = (u >> 1) & 15, ks = (u >> 5) & 3, kv = u >> 7;
        const int R = mt * 128 + (tid >> 3), c = R >> 1, g = R & 1;
        const u16* a0 = (kv ? p.Raw[1] : p.Raw[0]) + (size_t)(16 * c + ks * 8) * 128 + g * 64 + (tid & 7) * 8;
        const u16* b0 = (kv ? p.W1T[1] : p.W1T[0]) + (size_t)(nt * 128 + (tid >> 3)) * 2048 + ks * 512 + (tid & 7) * 8;
        gemm128_main(a0, (size_t)16 * 16 * 128, 128, b0, (size_t)32 * 2048, 64, 8, lds, acc);
        const int wr = w >> 1, wc = w & 1, lr = lane & 15, q = lane >> 4;
        float* dst = p.slab + ((size_t)(ks * 2 + kv) * 2048 + mt * 128) * 256 + nt * 128;
#pragma unroll
        for (int ti = 0; ti < 4; ++ti)
#pragma unroll
            for (int tj = 0; tj < 4; ++tj)
#pragma unroll
                for (int r = 0; r < 4; ++r)
                    dst[(size_t)(64 * wr + 16 * ti + 4 * q + r) * 256 + 64 * wc + 16 * tj + lr] = acc[ti][tj][r];
        return;
    }
    const int v = u - 256, half = v & 1, ch = v >> 1, n = ch >> 2, h = ch & 3;
    const u16* a0 = p.VrT + (((size_t)h * 128 + n) * 256 + half * 128 + (tid >> 3)) * 128 + (tid & 7) * 8;
    const u16* b0 = p.KrT + (((size_t)h * 128 + n) * 128 + (tid >> 3)) * 128 + (tid & 7) * 8;
    gemm128_main(a0, (size_t)32 * 128, 64, b0, (size_t)32 * 128, 64, 2, lds, acc);
    stage_acc(cst, acc);
    __syncthreads();
    u16* dst = p.H + (((size_t)n * 4 + h) * 256 + half * 128) * 128;
    emit_rows(cst, [&](int row, int c8, const float* vv) { *(u32x4*)(dst + (size_t)row * 128 + c8 * 8) = pack8(vv); });
    __syncthreads();
}
constexpr int P2_UNITS = 256 + 1024;

DI float gelu_tanh(float x) {
    const float u = 0.7978845608028654f * (x + 0.044715f * x * x * x);
    const float t = 1.f - 2.f / (1.f + __expf(2.f * u));
    return 0.5f * x * (1.f + t);
}
DI void p3_unit(const Params& p, int u, unsigned char* smem) {
    const int tid = TID(), lane = tid & 63, w = tid >> 6;
    const int v = u, kv = v & 1, rt = v >> 1;
    float* bias = (float*)smem;
    {
        float s = 0.f;
#pragma unroll
        for (int i = 0; i < 16; ++i) s += p.bpart[(kv * 16 + i) * 256 + tid];
        bias[tid] = s;
    }
    __syncthreads();
    const int lr = lane & 15, q = lane >> 4;
    const int R = rt * 16 + lr;
    f32x4 acc = {0.f, 0.f, 0.f, 0.f};
#pragma unroll
    for (int ks = 0; ks < 8; ++ks) {
        const int k0 = ks * 32 + q * 8;
        float hv[8];
#pragma unroll
        for (int k = 0; k < 8; ++k) hv[k] = bias[k0 + k];
#pragma unroll
        for (int s = 0; s < 4; ++s) {
            const float* sp = p.slab + ((size_t)(s * 2 + kv) * 2048 + R) * 256 + k0;
            const float4 a = *(const float4*)sp, b = *(const float4*)(sp + 4);
            hv[0] += a.x; hv[1] += a.y; hv[2] += a.z; hv[3] += a.w; hv[4] += b.x; hv[5] += b.y; hv[6] += b.z; hv[7] += b.w;
        }
#pragma unroll
        for (int k = 0; k < 8; ++k) hv[k] = gelu_tanh(hv[k]);
        const bf16x8 af = __builtin_bit_cast(bf16x8, pack8(hv));
        const bf16x8 bfr = ldf((kv ? p.W2T[1] : p.W2T[0]) + (size_t)(16 * w + lr) * 256 + k0);
        acc = MFMA16(af, bfr, acc);
    }
    const int d = 16 * w + lr;
#pragma unroll
    for (int r = 0; r < 4; ++r) {
        const int Ro = rt * 16 + 4 * q + r, c = Ro >> 1, g = Ro & 1;
        const float val = (c < 1023) ? acc[r] : 0.f;
        const u16 bv = (u16)(pack2(val, 0.f) & 0xffffu);
        if (kv == 0) p.Kc[((size_t)g * 1024 + c) * 64 + d] = bv;
        else p.VcT[(((size_t)g * 16 + (c >> 6)) * 64 + d) * 64 + (c & 63)] = bv;
    }
    __syncthreads();
}
constexpr int P3_UNITS = 256;
DI void p3_scan(const Params& p, bool dry) {
    const int nfree = (int)gridDim.x - P3_UNITS / 2;
    const bool split = nfree >= 64;
    if (split && (int)blockIdx.x < P3_UNITS / 2) return;
    const int sb = split ? (int)blockIdx.x - P3_UNITS / 2 : (int)blockIdx.x, sn = split ? nfree : (int)gridDim.x;
    for (int t = sb * 512 + threadIdx.x; t < 65536; t += sn * 512) {
        const int idx = 2 * t, h = idx >> 15;
        const float dec = __expf(128.0f * logf(1.0f - exp2f(-5.0f - (float)h)));
        unsigned* base = (unsigned*)(p.H + idx);
        float r0 = 0.f, r1 = 0.f;
#pragma unroll 16
        for (int n = 0; n < 128; ++n) {
            unsigned* pp = base + (size_t)n * 65536;
            const unsigned kv = *pp;
            unsigned* wp = dry ? (unsigned*)p.rowss + (size_t)n * 512 + (t & 511) : pp;
            *wp = pack2(r0, r1);
            r0 = dec * r0 + bflo(kv); r1 = dec * r1 + bfhi(kv);
        }
    }
}

constexpr int IMPS = 260;
DI int NTID() { int t = threadIdx.x; asm volatile("" : "+v"(t)); return t; }
DI void nsa_load_tile(const u16* src, u32x4& r) {
    r = ld16(src + NTID() * 8);
}
DI void nsa_store_k(u16* dst, const u32x4& r) {
    const int c0 = NTID(), r0 = c0 >> 3;
    *(u32x4*)(dst + r0 * LDT + (((c0 & 7) ^ swzK(r0)) << 3)) = r;
}
DI void nsa_store_v(u16* dst, const u32x4& r) {
    const int c0 = NTID(), r0 = c0 >> 3;
    *(u32x4*)(dst + r0 * LDT + (((c0 & 7) ^ swzA(r0)) << 3)) = r;
}
DI void nsa_scores(const u16* Kt, const bf16x8 (&qf)[2][2], f32x4 (&s)[4][2]) {
    const int lane = NTID() & 63, lr = lane & 15, q = lane >> 4;
#pragma unroll
    for (int kt = 0; kt < 4; ++kt) {
        const int krow = 32 * (kt >> 1) + 8 * (lr >> 2) + 4 * (kt & 1) + (lr & 3);
        s[kt][0] = f32x4{0.f, 0.f, 0.f, 0.f}; s[kt][1] = f32x4{0.f, 0.f, 0.f, 0.f};
#pragma unroll
        for (int ks = 0; ks < 2; ++ks) {
            const bf16x8 kf = ldf(Kt + krow * LDT + (((ks * 4 + q) ^ swzK(krow)) << 3));
            s[kt][0] = MFMA16(kf, qf[0][ks], s[kt][0]);
            s[kt][1] = MFMA16(kf, qf[1][ks], s[kt][1]);
        }
    }
    __builtin_amdgcn_sched_group_barrier(0x100, 3, 0);
#pragma unroll
    for (int i = 0; i < 8; ++i) {
        __builtin_amdgcn_sched_group_barrier(0x008, 2, 0);
        if (i + 3 < 8) __builtin_amdgcn_sched_group_barrier(0x100, 1, 0);
    }
}
DI void nsa_pv(const u16* Vt, const f32x4 (&s)[4][2], f32x4 (&o)[4][2]) {
    const int lane = NTID() & 63, lr = lane & 15, q = lane >> 4;
#pragma unroll
    for (int ks2 = 0; ks2 < 2; ++ks2) {
        const bf16x8 pb0 = packf(s[2 * ks2][0], s[2 * ks2 + 1][0]);
        const bf16x8 pb1 = packf(s[2 * ks2][1], s[2 * ks2 + 1][1]);
#pragma unroll
        for (int dt = 0; dt < 4; ++dt) {
            const bf16x8 vf = ldf(Vt + (16 * dt + lr) * LDT + (((ks2 * 4 + q) ^ (lr & 7)) << 3));
            o[dt][0] = MFMA16(vf, pb0, o[dt][0]);
            o[dt][1] = MFMA16(vf, pb1, o[dt][1]);
        }
    }
    __builtin_amdgcn_sched_group_barrier(0x100, 3, 0);
#pragma unroll
    for (int i = 0; i < 8; ++i) {
        __builtin_amdgcn_sched_group_barrier(0x008, 2, 0);
        if (i + 3 < 8) __builtin_amdgcn_sched_group_barrier(0x100, 1, 0);
    }
}

DI void nsa_item(const Params& p, int tb, int g, unsigned char* smem) {
    u16* Kt = (u16*)smem;
    u16* Vt = Kt + 64 * LDT;
    float* imp = (float*)(smem + 2 * 64 * LDT * 2);
    int* sel = (int*)(smem + 83968);
    const int tid = NTID(), lane = tid & 63, w = tid >> 6, lr = lane & 15, q = lane >> 4;
    const int t0 = tb * 64, cur = tb;
    const float SC = 0.125f * LOG2E;
    const float NEG = -1e30f;

    bf16x8 qf[2][2];
    int tokL[2]; float gc[2], gs[2], gw[2];
#pragma unroll
    for (int rt = 0; rt < 2; ++rt) {
        tokL[rt] = t0 + 8 * w + 4 * rt + (lr >> 2);
        const int head = 4 * g + (lr & 3);
#pragma unroll
        for (int ks = 0; ks < 2; ++ks) qf[rt][ks] = ldf(p.Qn + (size_t)tokL[rt] * 512 + head * 64 + 32 * ks + 8 * q);
        const float* gp = p.Gn + (size_t)tokL[rt] * 24 + head * 3;
        gc[rt] = gp[0]; gs[rt] = gp[1]; gw[rt] = gp[2];
    }
    f32x4 tot[4][2];
#pragma unroll
    for (int dt = 0; dt < 4; ++dt) { tot[dt][0] = f32x4{0.f, 0.f, 0.f, 0.f}; tot[dt][1] = f32x4{0.f, 0.f, 0.f, 0.f}; }

    for (int rep = (MK_PROBE & 256) ? 0 : 1; rep < 2; ++rep) {
        float m[2] = {NEG, NEG}, l[2] = {0.f, 0.f};
        f32x4 o[4][2];
#pragma unroll
        for (int dt = 0; dt < 4; ++dt) { o[dt][0] = f32x4{0.f, 0.f, 0.f, 0.f}; o[dt][1] = f32x4{0.f, 0.f, 0.f, 0.f}; }
        const int kb_lo = (t0 > 511 ? t0 - 511 : 0) >> 6, kb_hi = cur;
        u32x4 rk, rv;
        nsa_load_tile(p.Kw + ((size_t)g * S_ + kb_lo * 64) * 64, rk);
        nsa_load_tile(p.VwT + ((size_t)g * 256 + kb_lo) * 4096, rv);
        for (int kb = kb_lo; kb <= kb_hi; ++kb) {
            __syncthreads();
            nsa_store_k(Kt, rk); nsa_store_v(Vt, rv);
            __syncthreads();
            if (kb < kb_hi) {
                nsa_load_tile(p.Kw + ((size_t)g * S_ + (kb + 1) * 64) * 64, rk);
                nsa_load_tile(p.VwT + ((size_t)g * 256 + kb + 1) * 4096, rv);
            }
            f32x4 s[4][2];
            nsa_scores(Kt, qf, s);
            const bool interior = (kb * 64 + 63 <= t0) && (kb * 64 > t0 + 63 - 512);
#pragma unroll
            for (int rt = 0; rt < 2; ++rt) {
                if (interior) {
                    float mx = NEG;
#pragma unroll
                    for (int kt = 0; kt < 4; ++kt) mx = fmaxf(fmaxf(mx, fmaxf(s[kt][rt][0], s[kt][rt][1])), fmaxf(s[kt][rt][2], s[kt][rt][3]));
                    mx *= SC;
                    mx = qmax(mx);
                    const float mn = fmaxf(m[rt], mx), alpha = ex2(m[rt] - mn);
                    float rs = 0.f;
#pragma unroll
                    for (int kt = 0; kt < 4; ++kt)
#pragma unroll
                        for (int r = 0; r < 4; ++r) { const float pv = ex2(fmaf(s[kt][rt][r], SC, -mn)); s[kt][rt][r] = pv; rs += pv; }
                    l[rt] = l[rt] * alpha + rs; m[rt] = mn;
#pragma unroll
                    for (int dt = 0; dt < 4; ++dt) o[dt][rt] *= alpha;
                    continue;
                }
                const int t = tokL[rt];
                float mx = NEG;
#pragma unroll
                for (int kt = 0; kt < 4; ++kt)
#pragma unroll
                    for (int r = 0; r < 4; ++r) {
                        const int key = kb * 64 + 32 * (kt >> 1) + 8 * q + 4 * (kt & 1) + r;
                        const bool ok = (key <= t) && (key > t - 512);
                        const float v = ok ? s[kt][rt][r] * SC : NEG;
                        s[kt][rt][r] = v; mx = fmaxf(mx, v);
                    }
                mx = qmax(mx);
                const float mn = fmaxf(m[rt], mx), alpha = ex2(m[rt] - mn);
                float rs = 0.f;
#pragma unroll
                for (int kt = 0; kt < 4; ++kt)
#pragma unroll
                    for (int r = 0; r < 4; ++r) {
                        const float v = s[kt][rt][r];
                        const float pv = (v > -1e29f) ? ex2(v - mn) : 0.f;
                        s[kt][rt][r] = pv; rs += pv;
                    }
                l[rt] = l[rt] * alpha + rs; m[rt] = mn;
#pragma unroll
                for (int dt = 0; dt < 4; ++dt) o[dt][rt] *= alpha;
            }
            nsa_pv(Vt, s, o);
        }
#pragma unroll
        for (int rt = 0; rt < 2; ++rt) {
            float lt = l[rt]; lt = qsum(lt);
            const float f = (rep == 1) ? gw[rt] / fmaxf(lt, 1e-37f) : 0.f;
#pragma unroll
            for (int dt = 0; dt < 4; ++dt) tot[dt][rt] += o[dt][rt] * f;
        }
    }

    for (int rep = (MK_PROBE & 512) ? 0 : 1; rep < 2; ++rep) {
        const int nct = (((t0 + 32) >> 4) >> 6) + 1;
        int cmaxv[2]; cmaxv[0] = (tokL[0] - 31) >> 4; cmaxv[1] = (tokL[1] - 31) >> 4;
        const int cfull = (t0 - 31) >> 4;
        float m[2] = {NEG, NEG}, l[2] = {0.f, 0.f};
        u32x4 rk, rv;
        nsa_load_tile(p.Kc + ((size_t)g * 1024) * 64, rk);
        for (int ct = 0; ct < nct; ++ct) {
            __syncthreads();
            nsa_store_k(Kt, rk);
            __syncthreads();
            if (ct + 1 < nct) nsa_load_tile(p.Kc + ((size_t)g * 1024 + (ct + 1) * 64) * 64, rk);
            f32x4 s[4][2];
            nsa_scores(Kt, qf, s);
#pragma unroll
            for (int rt = 0; rt < 2; ++rt) {
                if (ct * 64 + 63 <= cfull) {
                    float mx = NEG;
#pragma unroll
                    for (int kt = 0; kt < 4; ++kt) mx = fmaxf(fmaxf(mx, fmaxf(s[kt][rt][0], s[kt][rt][1])), fmaxf(s[kt][rt][2], s[kt][rt][3]));
                    mx *= SC;
                    mx = qmax(mx);
                    const float mn = fmaxf(m[rt], mx), alpha = ex2(m[rt] - mn);
                    float rs = 0.f;
#pragma unroll
                    for (int kt = 0; kt < 4; ++kt)
#pragma unroll
                        for (int r = 0; r < 4; ++r) rs += ex2(fmaf(s[kt][rt][r], SC, -mn));
                    l[rt] = l[rt] * alpha + rs; m[rt] = mn;
                    continue;
                }
                float mx = NEG;
#pragma unroll
                for (int kt = 0; kt < 4; ++kt)
#pragma unroll
                    for (int r = 0; r < 4; ++r) {
                        const int c = ct * 64 + 32 * (kt >> 1) + 8 * q + 4 * (kt & 1) + r;
                        const float v = (c <= cmaxv[rt]) ? s[kt][rt][r] * SC : NEG;
                        s[kt][rt][r] = v; mx = fmaxf(mx, v);
                    }
                mx = qmax(mx);
                const float mn = fmaxf(m[rt], mx), alpha = ex2(m[rt] - mn);
                float rs = 0.f;
#pragma unroll
                for (int kt = 0; kt < 4; ++kt)
#pragma unroll
                    for (int r = 0; r < 4; ++r) { const float v = s[kt][rt][r]; rs += (v > -1e29f) ? ex2(v - mn) : 0.f; }
                l[rt] = l[rt] * alpha + rs; m[rt] = mn;
            }
        }
        float linv[2];
#pragma unroll
        for (int rt = 0; rt < 2; ++rt) {
            float lt = l[rt]; lt = qsum(lt);
            linv[rt] = 1.f / fmaxf(lt, 1e-37f);
        }
        f32x4 o[4][2];
#pragma unroll
        for (int dt = 0; dt < 4; ++dt) { o[dt][0] = f32x4{0.f, 0.f, 0.f, 0.f}; o[dt][1] = f32x4{0.f, 0.f, 0.f, 0.f}; }
        float carry[2] = {0.f, 0.f};
        nsa_load_tile(p.Kc + ((size_t)g * 1024) * 64, rk);
        nsa_load_tile(p.VcT + ((size_t)g * 16) * 4096, rv);
        for (int ct = 0; ct < nct; ++ct) {
            __syncthreads();
            nsa_store_k(Kt, rk); nsa_store_v(Vt, rv);
            __syncthreads();
            if (ct + 1 < nct) {
                nsa_load_tile(p.Kc + ((size_t)g * 1024 + (ct + 1) * 64) * 64, rk);
                nsa_load_tile(p.VcT + ((size_t)g * 16 + ct + 1) * 4096, rv);
            }
            f32x4 s[4][2];
            nsa_scores(Kt, qf, s);
#pragma unroll
            for (int rt = 0; rt < 2; ++rt) {
                if (ct * 64 + 63 <= cfull) {
#pragma unroll
                    for (int kt = 0; kt < 4; ++kt)
#pragma unroll
                        for (int r = 0; r < 4; ++r) s[kt][rt][r] = ex2(fmaf(s[kt][rt][r], SC, -m[rt])) * linv[rt];
                } else {
#pragma unroll
                    for (int kt = 0; kt < 4; ++kt)
#pragma unroll
                        for (int r = 0; r < 4; ++r) {
                            const int c = ct * 64 + 32 * (kt >> 1) + 8 * q + 4 * (kt & 1) + r;
                            s[kt][rt][r] = (c <= cmaxv[rt]) ? ex2(s[kt][rt][r] * SC - m[rt]) * linv[rt] : 0.f;
                        }
                }
                const float up1 = __shfl_up(s[1][rt][3], 16), up3 = __shfl_up(s[3][rt][3], 16);
                const float w1 = __shfl(s[1][rt][3], lr + 48), w3 = __shfl(s[3][rt][3], lr + 48);
                float e[4];
                e[0] = s[0][rt][0] + s[0][rt][1] + s[0][rt][2] + s[0][rt][3] + (q > 0 ? up1 : carry[rt]);
                e[1] = s[1][rt][0] + s[1][rt][1] + s[1][rt][2] + s[1][rt][3] + s[0][rt][3];
                e[2] = s[2][rt][0] + s[2][rt][1] + s[2][rt][2] + s[2][rt][3] + (q > 0 ? up3 : w1);
                e[3] = s[3][rt][0] + s[3][rt][1] + s[3][rt][2] + s[3][rt][3] + s[2][rt][3];
                carry[rt] = w3;
#pragma unroll
                for (int kt = 0; kt < 4; ++kt) {
                    float ev = e[kt];
                    ev += __shfl_xor(ev, 1); ev += __shfl_xor(ev, 2);
                    if ((lr & 3) == 0) imp[(8 * w + 4 * rt + (lr >> 2)) * IMPS + ct * 16 + 8 * (kt >> 1) + 2 * q + (kt & 1)] = ev;
                }
            }
            nsa_pv(Vt, s, o);
        }
#pragma unroll
        for (int rt = 0; rt < 2; ++rt)
#pragma unroll
            for (int dt = 0; dt < 4; ++dt) tot[dt][rt] += o[dt][rt] * ((rep == 1) ? gc[rt] : 0.f);
    }
    __syncthreads();

    for (int rep = (MK_PROBE & 1024) ? 0 : 1; rep < 2; ++rep)
    for (int tk = 0; tk < 8; tk += 2) {
        const int tl0 = 8 * w + tk, tl1 = tl0 + 1;
        unsigned va[4], vb[4];
#pragma unroll
        for (int i = 0; i < 4; ++i) {
            const int j = lane + 64 * i;
            const bool cand = (j <= cur) && (j != 0) && (j != cur) && (j != cur - 1);
            va[i] = cand ? (__float_as_uint(imp[tl0 * IMPS + j]) + 1u) : 0u;
            vb[i] = cand ? (__float_as_uint(imp[tl1 * IMPS + j]) + 1u) : 0u;
        }
        int sela = -1, selb = -1;
        if (lane == 0) { sela = 0; selb = 0; }
        if (cur > 0 && lane == 1) { sela = cur; selb = cur; }
        if (cur > 1 && lane == 2) { sela = cur - 1; selb = cur - 1; }
        const int nforced = 1 + (cur > 0 ? 1 : 0) + (cur > 1 ? 1 : 0);
        auto take = [&](unsigned (&v)[4], unsigned wm) -> int {
            const unsigned long long b0 = __ballot(v[0] == wm);
            if (b0) { const int ow = __builtin_ctzll(b0); if (lane == ow) v[0] = 0u; return ow; }
            const unsigned long long b1 = __ballot(v[1] == wm);
            if (b1) { const int ow = __builtin_ctzll(b1); if (lane == ow) v[1] = 0u; return ow + 64; }
            const unsigned long long b2 = __ballot(v[2] == wm);
            if (b2) { const int ow = __builtin_ctzll(b2); if (lane == ow) v[2] = 0u; return ow + 128; }
            const unsigned long long b3 = __ballot(v[3] == wm);
            if (b3) { const int ow = __builtin_ctzll(b3); if (lane == ow) v[3] = 0u; return ow + 192; }
            return -1;
        };
        for (int it = nforced; it < 16; ++it) {
            const unsigned wma = wave_umax(max(max(va[0], va[1]), max(va[2], va[3])));
            const unsigned wmb = wave_umax(max(max(vb[0], vb[1]), max(vb[2], vb[3])));
            if ((wma | wmb) == 0u) break;
            if (wma) { const int js = take(va, wma); if (lane == it) sela = js; }
            if (wmb) { const int js = take(vb, wmb); if (lane == it) selb = js; }
        }
        if (lane < 16) { sel[tl0 * 16 + lane] = sela; sel[tl1 * 16 + lane] = selb; }
    }
    __syncthreads();

    {
        unsigned long long* bmask = (unsigned long long*)(sel + 64 * 16);
        int* blist = (int*)(bmask + 256);
        if (tid < 256) bmask[tid] = 0ull;
        __syncthreads();
        for (int e = tid; e < 1024; e += 512) { const int j = sel[e]; if (j >= 0) atomicOr(&bmask[j], 1ull << (e >> 4)); }
        __syncthreads();
        if (w == 0) {
            int base = 0;
#pragma unroll
            for (int i = 0; i < 4; ++i) {
                const int j = lane + 64 * i;
                const bool nz = bmask[j] != 0ull;
                const unsigned long long b = __ballot(nz);
                const int pre = __builtin_popcountll(b & ((1ull << lane) - 1ull));
                if (nz) blist[base + pre] = j;
                base += __builtin_popcountll(b);
            }
            if (lane == 0) sel[0] = base;
        }
        __syncthreads();
        const int nl = sel[0];
        for (int rep = (MK_PROBE & (2048 | 16384)) ? 0 : 1; rep < 2; ++rep) {
        u16* st0 = (u16*)smem;
        u16* st1 = (u16*)(smem + 32768);
        float m[2] = {NEG, NEG}, l[2] = {0.f, 0.f};
        f32x4 o[4][2];
#pragma unroll
        for (int dt = 0; dt < 4; ++dt) { o[dt][0] = f32x4{0.f, 0.f, 0.f, 0.f}; o[dt][1] = f32x4{0.f, 0.f, 0.f, 0.f}; }
        u32x4 RA[4], RB[4];
        auto gloadS = [&](int st, u32x4 (&R)[4]) {
            const int j0 = blist[min(2 * st, nl - 1)], j1 = blist[min(2 * st + 1, nl - 1)];
            nsa_load_tile(p.Ks + ((size_t)g * S_ + (size_t)j0 * 64) * 64, R[0]);
            nsa_load_tile(p.VsT + ((size_t)g * 256 + j0) * 4096, R[1]);
            nsa_load_tile(p.Ks + ((size_t)g * S_ + (size_t)j1 * 64) * 64, R[2]);
            nsa_load_tile(p.VsT + ((size_t)g * 256 + j1) * 4096, R[3]);
        };
        auto storeS = [&](u16* stg, const u32x4 (&R)[4]) {
            nsa_store_k(stg, R[0]); nsa_store_v(stg + 4096, R[1]); nsa_store_k(stg + 8192, R[2]); nsa_store_v(stg + 12288, R[3]);
        };
        auto sel_rt = [&](auto RT, const u16* Kb, const u16* Vb, int j, unsigned long long mk) {
            constexpr int rt = decltype(RT)::value;
            f32x4 s[4];
#pragma unroll
            for (int kt = 0; kt < 4; ++kt) {
                const int krow = 32 * (kt >> 1) + 8 * (lr >> 2) + 4 * (kt & 1) + (lr & 3);
                s[kt] = f32x4{0.f, 0.f, 0.f, 0.f};
#pragma unroll
                for (int ks = 0; ks < 2; ++ks) s[kt] = MFMA16(ldf(Kb + krow * LDT + (((ks * 4 + q) ^ swzK(krow)) << 3)), qf[rt][ks], s[kt]);
            }
            __builtin_amdgcn_sched_group_barrier(0x100, 4, 0);
#pragma unroll
            for (int i = 0; i < 8; ++i) {
                __builtin_amdgcn_sched_group_barrier(0x008, 1, 0);
                if (i + 4 < 8) __builtin_amdgcn_sched_group_barrier(0x100, 1, 0);
            }
            const bool mine = ((mk >> (8 * w + 4 * rt + (lr >> 2))) & 1ull) != 0ull;
            float mx = NEG;
            if (j == cur) {
                const int dlim = mine ? (tokL[rt] - j * 64 - 8 * q) : -1;
#pragma unroll
                for (int kt = 0; kt < 4; ++kt)
#pragma unroll
                    for (int r = 0; r < 4; ++r) {
                        const float v = (32 * (kt >> 1) + 4 * (kt & 1) + r <= dlim) ? s[kt][r] * SC : NEG;
                        s[kt][r] = v; mx = fmaxf(mx, v);
                    }
                mx = qmax(mx);
                const float mn = fmaxf(m[rt], mx), alpha = ex2(m[rt] - mn);
                float rs = 0.f;
#pragma unroll
                for (int kt = 0; kt < 4; ++kt)
#pragma unroll
                    for (int r = 0; r < 4; ++r) {
                        const float v = s[kt][r];
                        const float pv = (v > -1e29f) ? ex2(v - mn) : 0.f;
                        s[kt][r] = pv; rs += pv;
                    }
                l[rt] = l[rt] * alpha + rs; m[rt] = mn;
#pragma unroll
                for (int dt = 0; dt < 4; ++dt) o[dt][rt] *= alpha;
            } else {
#pragma unroll
                for (int kt = 0; kt < 4; ++kt) mx = fmaxf(fmaxf(mx, fmaxf(s[kt][0], s[kt][1])), fmaxf(s[kt][2], s[kt][3]));
                mx = mine ? mx * SC : NEG;
                mx = qmax(mx);
                const float mn = fmaxf(m[rt], mx), alpha = ex2(m[rt] - mn);
                const float nb = mine ? -mn : NEG;
                float rs = 0.f;
#pragma unroll
                for (int kt = 0; kt < 4; ++kt)
#pragma unroll
                    for (int r = 0; r < 4; ++r) { const float pv = ex2(fmaf(s[kt][r], SC, nb)); s[kt][r] = pv; rs += pv; }
                l[rt] = l[rt] * alpha + rs; m[rt] = mn;
#pragma unroll
                for (int dt = 0; dt < 4; ++dt) o[dt][rt] *= alpha;
            }
#pragma unroll
            for (int ks2 = 0; ks2 < 2; ++ks2) {
                const bf16x8 pb = packf(s[2 * ks2], s[2 * ks2 + 1]);
#pragma unroll
                for (int dt = 0; dt < 4; ++dt) o[dt][rt] = MFMA16(ldf(Vb + (16 * dt + lr) * LDT + (((ks2 * 4 + q) ^ (lr & 7)) << 3)), pb, o[dt][rt]);
            }
            __builtin_amdgcn_sched_group_barrier(0x100, 4, 0);
#pragma unroll
            for (int i = 0; i < 8; ++i) {
                __builtin_amdgcn_sched_group_barrier(0x008, 1, 0);
                if (i + 4 < 8) __builtin_amdgcn_sched_group_barrier(0x100, 1, 0);
            }
        };
        auto compute = [&](const u16* Kb, const u16* Vb, int j) {
            if ((MK_PROBE & 16384) && rep == 0) return;
            const unsigned long long mk = bmask[j];
            const unsigned wb = (unsigned)(mk >> (8 * w)) & 0xffu;
            if (wb & 0x0fu) sel_rt(IC<0>{}, Kb, Vb, j, mk);
            if (wb & 0xf0u) sel_rt(IC<1>{}, Kb, Vb, j, mk);
        };
        auto computeS = [&](const u16* stg, int st) {
            compute(stg, stg + 4096, blist[2 * st]);
            if (2 * st + 1 < nl) compute(stg + 8192, stg + 12288, blist[2 * st + 1]);
        };
        const int nst = (nl + 1) >> 1;
        const int nstm = nst;
        gloadS(0, RA);
        storeS(st0, RA);
        gloadS(1, RB);
        __syncthreads();
        for (int st = 0; st < nstm; st += 2) {
            gloadS(st + 2, RA);
            if (st < nst) computeS(st0, st);
            storeS(st1, RB);
            __syncthreads();
            gloadS(st + 3, RB);
            if (st + 1 < nst) computeS(st1, st + 1);
            storeS(st0, RA);
            __syncthreads();
        }
#pragma unroll
        for (int rt = 0; rt < 2; ++rt) {
            float lt = l[rt]; lt = qsum(lt);
            const float f = (rep == 1) ? gs[rt] / fmaxf(lt, 1e-37f) : 0.f;
#pragma unroll
            for (int dt = 0; dt < 4; ++dt) tot[dt][rt] += o[dt][rt] * f;
        }
        __syncthreads();
        }
    }

#pragma unroll
    for (int rt = 0; rt < 2; ++rt) {
        const int head = 4 * g + (lr & 3);
#pragma unroll
        for (int dt = 0; dt < 4; ++dt) {
            const size_t off = (size_t)tokL[rt] * 512 + head * 64 + 16 * dt + 4 * q;
            const u32x2 z = *(const u32x2*)(p.SZn + off);
            u32x2 o2;
            o2[0] = pack2(tot[dt][rt][0] * bflo(z[0]), tot[dt][rt][1] * bfhi(z[0]));
            o2[1] = pack2(tot[dt][rt][2] * bflo(z[1]), tot[dt][rt][3] * bfhi(z[1]));
            *(u32x2*)(p.Qn + off) = o2;
        }
    }
    __syncthreads();
}


DI void ret_item(const Params& p, int n, int h, bool dowrite) {
    const int lane = TID() & 63, w = TID() >> 6, lr = lane & 15, q = lane >> 4;
    const float lg2 = logf(1.0f - exp2f(-5.0f - (float)h)) * LOG2E;
    const u16* rbase = p.H + (((size_t)n * 4 + h) * 256) * 128;
    const u16* kbase = p.Kr + ((size_t)h * S_ + n * 128) * 128;
    const u16* vbase = p.VrT + (((size_t)h * 128 + n) * 256) * 128;
    const u16* rlane = rbase + lr * 128 + 8 * q;
    const u16* vlane = vbase + lr * 128 + 8 * q;
#pragma unroll 1
    for (int it = 0; it < 2; ++it) {
        const int i = 32 * w + 16 * it + lr;
        bf16x8 qf[4];
#pragma unroll
        for (int ks = 0; ks < 4; ++ks) qf[ks] = ldf(p.Qr + ((size_t)h * S_ + n * 128 + i) * 128 + 32 * ks + 8 * q);
        f32x4 acc[16];
#pragma unroll
        for (int et = 0; et < 16; ++et) acc[et] = f32x4{0.f, 0.f, 0.f, 0.f};
#pragma unroll
        for (int et = 0; et < 16; ++et) {
            const u16* pe = rlane + et * 16 * 128; asm volatile("" : "+v"(pe));
#pragma unroll
            for (int ks = 0; ks < 4; ++ks) acc[et] = MFMA16(ldf(pe + 32 * ks), qf[ks], acc[et]);
        }
        {
            const float qd = ex2((float)(i + 1) * lg2);
#pragma unroll
            for (int et = 0; et < 16; ++et) acc[et] *= qd;
        }
        for (int jk = 0; jk <= w; ++jk) {
            f32x4 s[2];
#pragma unroll
            for (int jj = 0; jj < 2; ++jj) {
                const int krow = 32 * jk + 8 * (lr >> 2) + 4 * jj + (lr & 3);
                s[jj] = f32x4{0.f, 0.f, 0.f, 0.f};
#pragma unroll
                for (int ks = 0; ks < 4; ++ks) s[jj] = MFMA16(ldf(kbase + (size_t)krow * 128 + 32 * ks + 8 * q), qf[ks], s[jj]);
            }
#pragma unroll
            for (int jj = 0; jj < 2; ++jj)
#pragma unroll
                for (int r = 0; r < 4; ++r) {
                    const int j = 32 * jk + 8 * q + 4 * jj + r;
                    s[jj][r] = (i >= j) ? s[jj][r] * ex2((float)(i - j) * lg2) : 0.f;
                }
            const bf16x8 pb = packf(s[0], s[1]);
#pragma unroll
            for (int et = 0; et < 16; ++et) {
                const u16* pe = vlane + et * 16 * 128 + 32 * jk; asm volatile("" : "+v"(pe));
                acc[et] = MFMA16(ldf(pe), pb, acc[et]);
            }
        }
        float sm = 0.f;
#pragma unroll
        for (int et = 0; et < 16; ++et) sm += acc[et][0] + acc[et][1] + acc[et][2] + acc[et][3];
        sm = qsum(sm);
        const float mu = sm * (1.f / 256.f);
        float vs = 0.f;
#pragma unroll
        for (int et = 0; et < 16; ++et)
#pragma unroll
            for (int r = 0; r < 4; ++r) { const float d = acc[et][r] - mu; vs += d * d; }
        vs = qsum(vs);
        const float rs = rsqrtf(vs * (1.f / 256.f) + 1e-6f);
        u16* zlane = p.SZr + ((size_t)n * 128 + i) * 1024 + h * 256 + 4 * q;
#pragma unroll
        for (int et = 0; et < 16; ++et) {
            u16* zp = zlane + 16 * et; asm volatile("" : "+v"(zp));
            const u32x2 z = *(const u32x2*)zp;
            u32x2 o2;
            o2[0] = pack2((acc[et][0] - mu) * rs * bflo(z[0]), (acc[et][1] - mu) * rs * bfhi(z[0]));
            o2[1] = pack2((acc[et][2] - mu) * rs * bflo(z[1]), (acc[et][3] - mu) * rs * bfhi(z[1]));
            if (dowrite) *(u32x2*)zp = o2;
        }
    }
}

DI void p5_tile(const Params& p, int t, unsigned char* smem_all) {
    const int tid = threadIdx.x, team = TEAM();
    const int nt = t >> 6, mt = t & 63;
    u16* Mg = p.Qr;
    const float* cst = (const float*)(smem_all + team * 69632);
    f32x4 acc[8][4];
    zero_acc8(acc);
    gemm256_main(p.Qn + (size_t)(mt * 256 + (tid >> 3)) * 512 + (tid & 7) * 8, (size_t)64 * 512,
                 p.WnoT + (size_t)(nt * 256 + (tid >> 3)) * 512 + (tid & 7) * 8, (size_t)64 * 512, 8, (u16*)smem_all, acc);
#pragma unroll
    for (int pass = 0; pass < 2; ++pass) {
        stage_acc8(smem_all, pass, acc);
        __syncthreads();
        const int tok0 = mt * 256 + pass * 128, c0 = (nt * 2 + team) * 128;
        emit_rows(cst, [&](int row, int c8, const float* v) {
            const u32x4 gm = ld16(p.Ma + (size_t)(tok0 + row) * 1024 + c0 + c8 * 8);
            float o[8];
            o[0] = v[0] * bflo(gm[0]); o[1] = v[1] * bfhi(gm[0]); o[2] = v[2] * bflo(gm[1]); o[3] = v[3] * bfhi(gm[1]);
            o[4] = v[4] * bflo(gm[2]); o[5] = v[5] * bfhi(gm[2]); o[6] = v[6] * bflo(gm[3]); o[7] = v[7] * bfhi(gm[3]);
            *(u32x4*)(Mg + (size_t)(tok0 + row) * 1024 + c0 + c8 * 8) = pack8(o); });
        __syncthreads();
    }
    zero_acc8(acc);
    gemm256_main(p.SZr + (size_t)(mt * 256 + (tid >> 3)) * 1024 + (tid & 7) * 8, (size_t)64 * 1024,
                 p.WroT + (size_t)(nt * 256 + (tid >> 3)) * 1024 + (tid & 7) * 8, (size_t)64 * 1024, 16, (u16*)smem_all, acc);
#pragma unroll
    for (int pass = 0; pass < 2; ++pass) {
        stage_acc8(smem_all, pass, acc);
        __syncthreads();
        const int tok0 = mt * 256 + pass * 128, c0 = (nt * 2 + team) * 128;
        emit_rows(cst, [&](int row, int c8, const float* v) {
            u16* mp = Mg + (size_t)(tok0 + row) * 1024 + c0 + c8 * 8;
            const u32x4 gm = ld16(p.Mb + (size_t)(tok0 + row) * 1024 + c0 + c8 * 8);
            const u32x4 ya = ld16(mp);
            float o[8];
            o[0] = bflo(ya[0]) + v[0] * bflo(gm[0]); o[1] = bfhi(ya[0]) + v[1] * bfhi(gm[0]); o[2] = bflo(ya[1]) + v[2] * bflo(gm[1]); o[3] = bfhi(ya[1]) + v[3] * bfhi(gm[1]);
            o[4] = bflo(ya[2]) + v[4] * bflo(gm[2]); o[5] = bfhi(ya[2]) + v[5] * bfhi(gm[2]); o[6] = bflo(ya[3]) + v[6] * bflo(gm[3]); o[7] = bfhi(ya[3]) + v[7] * bfhi(gm[3]);
            *(u32x4*)mp = pack8(o); });
        __syncthreads();
    }
}

DI void p6_tile(const Params& p, int t, unsigned char* smem_all) {
    const int tid = threadIdx.x, team = TEAM();
    const int nt = t >> 6, mt = t & 63;
    const u16* Mg = p.Qr; u16* Y2 = p.VrT;
    f32x4 acc[8][4]; zero_acc8(acc);
    gemm256_main(Mg + (size_t)(mt * 256 + (tid >> 3)) * 1024 + (tid & 7) * 8, (size_t)64 * 1024,
                 p.WoutT + (size_t)(nt * 256 + (tid >> 3)) * 1024 + (tid & 7) * 8, (size_t)64 * 1024, 16, (u16*)smem_all, acc);
    const float* cst = (const float*)(smem_all + team * 69632);
#pragma unroll
    for (int pass = 0; pass < 2; ++pass) {
        stage_acc8(smem_all, pass, acc);
        __syncthreads();
        const int tok0 = mt * 256 + pass * 128, nt128 = nt * 2 + team;
        emit_rows(cst, [&](int row, int c8, const float* v) {
            *(u32x4*)(Y2 + (size_t)(tok0 + row) * 1024 + nt128 * 128 + c8 * 8) = pack8(v);
            float ss = 0.f;
#pragma unroll
            for (int k = 0; k < 8; ++k) ss += v[k] * v[k];
            ss += __shfl_xor(ss, 1); ss += __shfl_xor(ss, 2); ss += __shfl_xor(ss, 4); ss += __shfl_xor(ss, 8);
            if (c8 == 0) p.rowss[(size_t)(tok0 + row) * 8 + nt128] = ss; });
        __syncthreads();
    }
}

DI void p7_all(const Params& p) {
    const u16* Y2 = p.VrT;
    const size_t n4 = (size_t)S_ * 256;
    for (size_t i = (size_t)blockIdx.x * 512 + threadIdx.x; i < n4; i += (size_t)gridDim.x * 512) {
        const size_t row = i >> 8; const int c4 = (int)(i & 255);
        const float4 a = *(const float4*)(p.rowss + row * 8), b = *(const float4*)(p.rowss + row * 8 + 4);
        const float ss = ((a.x + a.y) + (a.z + a.w)) + ((b.x + b.y) + (b.z + b.w));
        const float rs = rsqrtf(ss * (1.f / 1024.f) + 1e-6f);
        const float4 xv = *(const float4*)(p.x + i * 4);
        const float4 gv = *(const float4*)(p.norm_post + c4 * 4);
        const u32x2 y = *(const u32x2*)(Y2 + i * 4);
        float4 o;
        o.x = xv.x + bflo(y[0]) * rs * gv.x; o.y = xv.y + bfhi(y[0]) * rs * gv.y;
        o.z = xv.z + bflo(y[1]) * rs * gv.z; o.w = xv.w + bfhi(y[1]) * rs * gv.w;
        *(float4*)(p.out + i * 4) = o;
    }
}

#ifndef MK_PROBE
#define MK_PROBE 0
#endif
constexpr size_t al256(size_t x) { return (x + 255) & ~(size_t)255; }
constexpr size_t O_BAR   = 0;
constexpr size_t O_WINT  = O_BAR   + 16384;
constexpr size_t O_WNOT  = O_WINT  + al256((size_t)NPAD_ * 1024 * 2);
constexpr size_t O_WROT  = O_WNOT  + (size_t)1024 * 512 * 2;
constexpr size_t O_WOUTT = O_WROT  + (size_t)1024 * 1024 * 2;
constexpr size_t O_W1T0  = O_WOUTT + (size_t)1024 * 1024 * 2;
constexpr size_t O_W1T1  = O_W1T0  + (size_t)256 * 2048 * 2;
constexpr size_t O_W2T0  = O_W1T1  + (size_t)256 * 2048 * 2;
constexpr size_t O_W2T1  = O_W2T0  + (size_t)64 * 256 * 2;
constexpr size_t O_BPART = O_W2T1  + (size_t)64 * 256 * 2;
constexpr size_t O_ROPEN = O_BPART + (size_t)2 * 16 * 256 * 4;
constexpr size_t O_ROPER = O_ROPEN + (size_t)S_ * 8 * 8;
constexpr size_t O_H     = O_ROPER + (size_t)S_ * 64 * 8;
constexpr size_t O_QN    = O_H     + (size_t)S_ * 1024 * 2;
constexpr size_t O_RAW0  = O_QN    + (size_t)S_ * 512 * 2;
constexpr size_t O_RAW1  = O_RAW0  + (size_t)S_ * 128 * 2;
constexpr size_t O_KS    = O_RAW1  + (size_t)S_ * 128 * 2;
constexpr size_t O_VST   = O_KS    + (size_t)2 * S_ * 64 * 2;
constexpr size_t O_KW    = O_VST   + (size_t)2 * S_ * 64 * 2;
constexpr size_t O_VWT   = O_KW    + (size_t)2 * S_ * 64 * 2;
constexpr size_t O_SZN   = O_VWT   + (size_t)2 * S_ * 64 * 2;
constexpr size_t O_QR    = O_SZN   + (size_t)S_ * 512 * 2;
constexpr size_t O_KR    = O_QR    + (size_t)4 * S_ * 128 * 2;
constexpr size_t O_KRT   = O_KR    + (size_t)4 * S_ * 128 * 2;
constexpr size_t O_VRT   = O_KRT   + (size_t)4 * S_ * 128 * 2;
constexpr size_t O_SZR   = O_VRT   + (size_t)4 * S_ * 256 * 2;
constexpr size_t O_GN    = O_SZR   + (size_t)S_ * 1024 * 2;
constexpr size_t O_SLAB  = O_GN    + (size_t)S_ * 24 * 4;
constexpr size_t O_KC    = O_SLAB  + (size_t)4 * 2 * 2048 * 256 * 4;
constexpr size_t O_VCT   = O_KC    + (size_t)2 * 1024 * 64 * 2;
constexpr size_t O_ROWSS = O_VCT   + (size_t)2 * 1024 * 64 * 2;
constexpr size_t WS_BYTES = O_ROWSS + (size_t)S_ * 8 * 4;

struct KArgs {
    const float *x, *norm_pre, *w_in, *b_gate, *pe_k, *w1_k, *w2_k, *pe_v, *w1_v, *w2_v, *w_nsa_o, *w_ret_o, *w_out, *norm_post;
    float* out; char* ws; int use_cg; int probe;
};

__global__ void __launch_bounds__(512, 2) fwd_megakernel(KArgs ka) {
    Params p;
    p.x = ka.x; p.norm_pre = ka.norm_pre; p.w_in = ka.w_in; p.b_gate = ka.b_gate; p.pe_k = ka.pe_k; p.w1_k = ka.w1_k; p.w2_k = ka.w2_k;
    p.pe_v = ka.pe_v; p.w1_v = ka.w1_v; p.w2_v = ka.w2_v; p.w_nsa_o = ka.w_nsa_o; p.w_ret_o = ka.w_ret_o; p.w_out = ka.w_out; p.norm_post = ka.norm_post;
    p.out = ka.out; p.use_cg = ka.use_cg; p.probe = ka.probe;
    {
        char* ws = ka.ws;
        p.bar = (unsigned*)(ws + O_BAR);
        p.WinT = (u16*)(ws + O_WINT); p.WnoT = (u16*)(ws + O_WNOT); p.WroT = (u16*)(ws + O_WROT); p.WoutT = (u16*)(ws + O_WOUTT);
        p.W1T[0] = (u16*)(ws + O_W1T0); p.W1T[1] = (u16*)(ws + O_W1T1); p.W2T[0] = (u16*)(ws + O_W2T0); p.W2T[1] = (u16*)(ws + O_W2T1);
        p.bpart = (float*)(ws + O_BPART); p.ropeN = (float2*)(ws + O_ROPEN); p.ropeR = (float2*)(ws + O_ROPER);
        p.H = (u16*)(ws + O_H); p.Qn = (u16*)(ws + O_QN); p.Raw[0] = (u16*)(ws + O_RAW0); p.Raw[1] = (u16*)(ws + O_RAW1);
        p.Ks = (u16*)(ws + O_KS); p.VsT = (u16*)(ws + O_VST); p.Kw = (u16*)(ws + O_KW); p.VwT = (u16*)(ws + O_VWT);
        p.SZn = (u16*)(ws + O_SZN); p.Qr = (u16*)(ws + O_QR); p.Kr = (u16*)(ws + O_KR); p.KrT = (u16*)(ws + O_KRT); p.VrT = (u16*)(ws + O_VRT);
        p.SZr = (u16*)(ws + O_SZR); p.Gn = (float*)(ws + O_GN); p.slab = (float*)(ws + O_SLAB); p.Kc = (u16*)(ws + O_KC); p.VcT = (u16*)(ws + O_VCT);
        p.rowss = (float*)(ws + O_ROWSS);
        p.Ma = (u16*)ka.out; p.Mb = (u16*)ka.out + (size_t)S_ * 1024;
    }
    __shared__ __attribute__((aligned(16))) unsigned char smem_all[2 * 69632];
    __shared__ int xch[2];
    const int team = TEAM();
    unsigned char* smem = smem_all + team * 69632;
    __shared__ uint4 xb_words;
    if (threadIdx.x == 0) xb_words = make_uint4(0u, 0u, 0u, 0u);
    __syncthreads();
    XcdBarrier b = xcd_barrier_post(p.bar, (volatile LAS unsigned*)&xb_words);
    const int G = gridDim.x, B = blockIdx.x;
    __shared__ unsigned long long ts[12]; int tsn = 1;
    if (MK_TS >= 0 && threadIdx.x == 0) ts[0] = __builtin_amdgcn_s_memrealtime();
    if (MK_TS == 201 && threadIdx.x == 0) atomicMax((unsigned long long*)(p.bar + 66), ~(unsigned long long)__builtin_amdgcn_s_memrealtime());
#define GRID_SYNC() do { if (p.use_cg) cg::this_grid().sync(); else { xcd_barrier(b); if (MK_PROBE & 32768) xcd_barrier(b); } if (MK_TS >= 0 && threadIdx.x == 0) ts[tsn++] = __builtin_amdgcn_s_memrealtime(); } while (0)

    for (int u = 2 * B + team; u < P0_UNITS; u += 2 * G) { if (u >= 448 && u < 1088) continue; p0_unit(p, u, smem); }
    GRID_SYNC();
    for (int t = B; t < 28 * 64; t += G) p1_tile256(p, t, smem_all);
    GRID_SYNC();
    if (G == 256) {
        const int T = 2 * B + team;
        if (T < 256) { p2_unit(p, T, smem); p2_unit(p, 256 + 768 + T, smem); }
        else { for (int k = 0; k < 3; ++k) p2_unit(p, 256 + 3 * (T - 256) + k, smem); }
    } else {
        for (int u = 2 * B + team; u < P2_UNITS; u += 2 * G) p2_unit(p, u, smem);
    }
    for (int u = 448 + 2 * B + team; u < 1088; u += 2 * G) p0_unit(p, u, smem);
    GRID_SYNC();
    for (int u = 2 * B + team; u < P3_UNITS; u += 2 * G) p3_unit(p, u, smem);
    p3_scan(p, false);
    GRID_SYNC();
    for (int i = B; i < 512; i += G) {
        const int r = i / G, k = i - r * G;
        nsa_item(p, (r & 1) ? (k >> 1) : 255 - (k >> 1), k & 1, smem_all);
    }
    for (int u = 2 * B + team; u < 512; u += 2 * G) ret_item(p, u >> 2, u & 3, true);
    GRID_SYNC();
    for (int t = B; t < 256; t += G) p5_tile(p, t, smem_all);
    GRID_SYNC();
    for (int t = B; t < 256; t += G) p6_tile(p, t, smem_all);
    GRID_SYNC();
    p7_all(p);
    if (MK_TS >= 0) {
        GRID_SYNC();
        __syncthreads();
        if (B == 0) {
            const unsigned long long d = (MK_TS == 201) ? (ts[0] - ~__hip_atomic_load((unsigned long long*)(p.bar + 66), __ATOMIC_RELAXED, __HIP_MEMORY_SCOPE_AGENT)) / 4ull : (MK_TS == 200) ? (ts[8] - ts[0]) / 16ull : (MK_TS >= 100) ? 10000ull : (ts[(MK_TS + 1) % 12] - ts[MK_TS % 12]) / 4ull;
            const int K = (int)(d > 60000ull ? 60000ull : d);
            for (int i = threadIdx.x; i < K; i += 512) p.out[(size_t)i * 64 + 7] += 0.2f;
        }
    }
}

extern "C" void kernel_launch(void* const* d_in, const int* in_sizes, int n_in, void* d_out, int out_size,
                              void* d_ws, size_t ws_size, hipStream_t stream) {
    static int grid_blocks = 0;
    if (!grid_blocks) {
        int dev = 0, cus = 0, per_cu = 0;
        (void)hipGetDevice(&dev);
        (void)hipDeviceGetAttribute(&cus, hipDeviceAttributeMultiprocessorCount, dev);
        (void)hipOccupancyMaxActiveBlocksPerMultiprocessor(&per_cu, fwd_megakernel, 512, 0);
        if (per_cu > 1) per_cu = 1;
        if (per_cu < 1) per_cu = 1;
        grid_blocks = cus * per_cu;
    }
    KArgs ka{};
    ka.x = (const float*)d_in[0]; ka.norm_pre = (const float*)d_in[1]; ka.w_in = (const float*)d_in[2]; ka.b_gate = (const float*)d_in[3];
    ka.pe_k = (const float*)d_in[4]; ka.w1_k = (const float*)d_in[5]; ka.w2_k = (const float*)d_in[6];
    ka.pe_v = (const float*)d_in[7]; ka.w1_v = (const float*)d_in[8]; ka.w2_v = (const float*)d_in[9];
    ka.w_nsa_o = (const float*)d_in[10]; ka.w_ret_o = (const float*)d_in[11]; ka.w_out = (const float*)d_in[12]; ka.norm_post = (const float*)d_in[13];
    ka.out = (float*)d_out; ka.ws = (char*)d_ws; ka.use_cg = 0; ka.probe = MK_PROBE;
    if (WS_BYTES > ws_size) { fprintf(stderr, "workspace too small: need %zu have %zu\n", (size_t)WS_BYTES, ws_size); return; }
    (void)hipMemsetAsync(d_ws, 0, XCD_BAR_WORDS * 4, stream);
    void* args[] = {&ka};
    hipError_t e = hipLaunchCooperativeKernel((void*)fwd_megakernel, dim3(grid_blocks), dim3(512), args, 0, stream);
    if (e != hipSuccess) fprintf(stderr, "cooperative launch failed: %s (grid %d)\n", hipGetErrorString(e), grid_blocks);
}
```

```cpp
#include <hip/hip_runtime.h>
#include <hip/hip_cooperative_groups.h>
#include <cstdio>
namespace cg = cooperative_groups;

#define DI __device__ __forceinline__
#define LAS __attribute__((address_space(3)))

#define XB_TMO      128
#define XB_XCNT(j)  (256  + 64 * (j))
#define XB_XSUB(j)  (1280 + 64 * (j))
#define XB_XGEN(j)  (2304 + 64 * (j))
#define XB_TOP      3328
#define XB_TOPGEN   3392
#define XCD_BAR_WORDS 3456
#define XB_SPIN_CAP (1u << 22)

DI unsigned xb_ld(unsigned* p)              { return __hip_atomic_load(p, __ATOMIC_RELAXED, __HIP_MEMORY_SCOPE_AGENT); }
DI unsigned xb_add(unsigned* p, unsigned v) { return __hip_atomic_fetch_add(p, v, __ATOMIC_RELAXED, __HIP_MEMORY_SCOPE_AGENT); }
DI unsigned xb_xcc_id() { return (unsigned)__builtin_amdgcn_s_getreg((3 << 11) | 20) & 0xFu; }
#define XB_SPIN(cond, bar) do { unsigned _sp = 0; while (cond) { __builtin_amdgcn_s_sleep(1); \
    if ((++_sp & 255u) == 0u) { if (xb_ld(&(bar)[XB_TMO])) break; if (_sp > XB_SPIN_CAP) { atomicAdd(&(bar)[XB_TMO], 1u); break; } } } } while (0)

struct XcdBarrier { unsigned* bar; unsigned x; volatile LAS unsigned* st; };

DI XcdBarrier xcd_barrier_post(unsigned* bar, volatile LAS unsigned* st) {
    XcdBarrier b; b.bar = bar; b.x = xb_xcc_id(); b.st = st;
    if (threadIdx.x == 0) (void)xb_add(&bar[XB_XCNT(b.x)], 1u);
    return b;
}
DI void xcd_barrier_complete(unsigned* bar, unsigned x, unsigned& nloc, unsigned& nx) {
    const unsigned G = gridDim.x * gridDim.y * gridDim.z;
    unsigned sum, cnt, mine, sp = 0u;
    for (;;) {
        sum = 0u; cnt = 0u; mine = 0u;
#pragma unroll
        for (unsigned j = 0; j < 16; ++j) { const unsigned c = xb_ld(&bar[XB_XCNT(j)]); sum += c; cnt += (c > 0u) ? 1u : 0u; mine = (j == x) ? c : mine; }
        if (sum == G) break;
        __builtin_amdgcn_s_sleep(1);
        if ((++sp & 255u) == 0u) { if (xb_ld(&bar[XB_TMO])) break; if (sp > XB_SPIN_CAP) { atomicAdd(&bar[XB_TMO], 1u); break; } }
    }
    nloc = mine > 0u ? mine : 1u; nx = cnt > 0u ? cnt : 1u;
}
DI void xcd_barrier(const XcdBarrier& b) {
    asm volatile("s_waitcnt vmcnt(0)" ::: "memory");
    __syncthreads();
    if (threadIdx.x == 0) {
        unsigned* bar = b.bar;
        __builtin_amdgcn_s_waitcnt(0);
        unsigned nloc = b.st[0], nx = b.st[1];
        if (nloc == 0u) { xcd_barrier_complete(bar, b.x, nloc, nx); b.st[0] = nloc; b.st[1] = nx; }
        const unsigned old = xb_add(&bar[XB_XSUB(b.x)], 1u);
        const unsigned gen = old / nloc;
        if (old + 1u == (gen + 1u) * nloc) {
            __builtin_amdgcn_fence(__ATOMIC_RELEASE, "agent");
            asm volatile("s_waitcnt vmcnt(0)" ::: "memory");
            const unsigned og = xb_add(&bar[XB_TOP], 1u);
            const unsigned tg = og / nx;
            if (og + 1u == (tg + 1u) * nx) xb_add(&bar[XB_TOPGEN], 1u);
            else XB_SPIN(xb_ld(&bar[XB_TOPGEN]) == tg, bar);
            __builtin_amdgcn_fence(__ATOMIC_ACQUIRE, "agent");
            xb_add(&bar[XB_XGEN(b.x)], 1u);
            asm volatile("s_waitcnt vmcnt(0)" ::: "memory");
        } else {
            XB_SPIN(xb_ld(&bar[XB_XGEN(b.x)]) == gen, bar);
            __builtin_amdgcn_fence(__ATOMIC_ACQUIRE, "agent");
            asm volatile("s_waitcnt vmcnt(0)" ::: "memory");
        }
    }
    __syncthreads();
}


#ifndef MK_PROBE
#define MK_PROBE 0
#endif
#define MK_TS -1
typedef unsigned short u16;
using bf16x8 = __attribute__((ext_vector_type(8))) short;
using f32x4  = __attribute__((ext_vector_type(4))) float;
using u32x4  = __attribute__((ext_vector_type(4))) unsigned;
using u32x2  = __attribute__((ext_vector_type(2))) unsigned;
typedef __attribute__((ext_vector_type(2))) __bf16 bf2_t;
#define MFMA16(a, b, c) __builtin_amdgcn_mfma_f32_16x16x32_bf16((a), (b), (c), 0, 0, 0)

constexpr int S_ = 16384, DM_ = 1024, NPAD_ = 7168;
constexpr int LDT = 64;
DI int swzA(int row) { return row & 7; }
DI int swzK(int row) { return (((row >> 3) & 3) << 1) | ((row >> 1) & 1); }
constexpr int TILE_ELEMS = 128 * LDT;
constexpr int CST = 132;
constexpr float LOG2E = 1.4426950408889634f;

template <int N> struct IC { static constexpr int value = N; };
DI int TID() { int t = threadIdx.x & 255; asm volatile("" : "+v"(t)); return t; }
DI int TEAM() { return __builtin_amdgcn_readfirstlane((int)(threadIdx.x >> 8)); }
DI unsigned pack2(float a, float b) { bf2_t v = {(__bf16)a, (__bf16)b}; return __builtin_bit_cast(unsigned, v); }
DI float bflo(unsigned u) { return __uint_as_float(u << 16); }
DI float bfhi(unsigned u) { return __uint_as_float(u & 0xffff0000u); }
DI u32x4 ld16(const u16* p) { return *(const u32x4*)p; }
DI bf16x8 ldf(const u16* p) { return *(const bf16x8*)p; }
DI u32x4 pack8(const float* v) { u32x4 r; r[0] = pack2(v[0], v[1]); r[1] = pack2(v[2], v[3]); r[2] = pack2(v[4], v[5]); r[3] = pack2(v[6], v[7]); return r; }
DI bf16x8 packf(f32x4 a, f32x4 b) { u32x4 r; r[0] = pack2(a[0], a[1]); r[1] = pack2(a[2], a[3]); r[2] = pack2(b[0], b[1]); r[3] = pack2(b[2], b[3]); return __builtin_bit_cast(bf16x8, r); }
DI float ex2(float x) { return __builtin_amdgcn_exp2f(x); }
DI float sigmoidf_(float x) { return 1.f / (1.f + __expf(-x)); }
#define DPP_U(v, ctrl) ((unsigned)__builtin_amdgcn_update_dpp(0, (int)(v), (ctrl), 0xf, 0xf, true))
DI unsigned wave_umax(unsigned v) {
    v = max(v, DPP_U(v, 0xB1));
    v = max(v, DPP_U(v, 0x4E));
    v = max(v, DPP_U(v, 0x141));
    v = max(v, DPP_U(v, 0x140));
    auto r = __builtin_amdgcn_permlane16_swap(v, v, false, false);
    v = max(r[0], r[1]);
    auto s = __builtin_amdgcn_permlane32_swap(v, v, false, false);
    v = max(s[0], s[1]);
    return (unsigned)__builtin_amdgcn_readfirstlane((int)v);
}
DI float qmax(float x) {
    unsigned u = __float_as_uint(x);
    auto r = __builtin_amdgcn_permlane16_swap(u, u, false, false);
    x = fmaxf(__uint_as_float(r[0]), __uint_as_float(r[1]));
    u = __float_as_uint(x);
    auto s = __builtin_amdgcn_permlane32_swap(u, u, false, false);
    return fmaxf(__uint_as_float(s[0]), __uint_as_float(s[1]));
}
DI float qsum(float x) {
    unsigned u = __float_as_uint(x);
    auto r = __builtin_amdgcn_permlane16_swap(u, u, false, false);
    x = __uint_as_float(r[0]) + __uint_as_float(r[1]);
    u = __float_as_uint(x);
    auto s = __builtin_amdgcn_permlane32_swap(u, u, false, false);
    return __uint_as_float(s[0]) + __uint_as_float(s[1]);
}
DI float wave_max(float v) {
#pragma unroll
    for (int o = 32; o >= 1; o >>= 1) v = fmaxf(v, __shfl_xor(v, o));
    return v;
}
DI float wave_sum(float v) {
#pragma unroll
    for (int o = 32; o >= 1; o >>= 1) v += __shfl_xor(v, o);
    return v;
}

struct Params {
    const float *x, *norm_pre, *w_in, *b_gate, *pe_k, *w1_k, *w2_k, *pe_v, *w1_v, *w2_v, *w_nsa_o, *w_ret_o, *w_out, *norm_post;
    float* out;
    unsigned* bar;
    u16 *WinT, *WnoT, *WroT, *WoutT, *W1T[2], *W2T[2];
    float* bpart;
    float2 *ropeN, *ropeR;
    u16 *H;
    u16 *Qn;
    u16 *Raw[2];
    u16 *Ks, *VsT, *Kw, *VwT;
    u16 *SZn;
    u16 *Qr, *Kr;
    u16 *KrT;
    u16 *VrT;
    u16 *SZr;
    u16 *Ma, *Mb;
    float* Gn;
    float* slab;
    u16 *Kc, *VcT;
    float* rowss;
    int use_cg; int probe;
};

struct GemmPre { u32x4 ra[4], rb[4]; };
DI void gemm128_prefetch(const u16* a0, size_t a_r32, const u16* b0, size_t b_r32, GemmPre& pre) {
#pragma unroll
    for (int i = 0; i < 4; ++i) { pre.ra[i] = ld16(a0 + i * a_r32); pre.rb[i] = ld16(b0 + i * b_r32); }
}
DI void gemm128_main(const u16* a0, size_t a_r32, int astep, const u16* b0, size_t b_r32, int bstep, int nk,
                     u16* lds, f32x4 (&acc)[4][4], const GemmPre* pre = nullptr) {
    const int tid = TID(), lane = tid & 63, w = tid >> 6;
    const int wr = w >> 1, wc = w & 1, lr = lane & 15, q = lane >> 4;
    const int wofs = (tid >> 3) * LDT + (((tid & 7) ^ swzA(tid >> 3)) << 3);
    u32x4 ra0[4], rb0[4], ra1[4], rb1[4];
    auto gl = [&](int kt, u32x4 (&ra)[4], u32x4 (&rb)[4]) {
        const int k = kt < nk ? kt : nk - 1;
        const u16* ap = a0 + (size_t)k * astep; const u16* bp = b0 + (size_t)k * bstep;
#pragma unroll
        for (int i = 0; i < 4; ++i) { ra[i] = ld16(ap + i * a_r32); rb[i] = ld16(bp + i * b_r32); }
    };
    auto st = [&](u16* buf, const u32x4 (&ra)[4], const u32x4 (&rb)[4]) {
#pragma unroll
        for (int i = 0; i < 4; ++i) {
            *(u32x4*)(buf + wofs + i * 32 * LDT) = ra[i];
            *(u32x4*)(buf + TILE_ELEMS + wofs + i * 32 * LDT) = rb[i];
        }
    };
    auto mm = [&](const u16* As) {
        const u16* Bs = As + TILE_ELEMS;
#pragma unroll
        for (int ks = 0; ks < 2; ++ks) {
            bf16x8 af[4], bfr[4];
#pragma unroll
            for (int t = 0; t < 4; ++t) {
                af[t]  = ldf(As + (64 * wr + 16 * t + lr) * LDT + (((ks * 4 + q) ^ (lr & 7)) << 3));
                bfr[t] = ldf(Bs + (64 * wc + 16 * t + lr) * LDT + (((ks * 4 + q) ^ (lr & 7)) << 3));
            }
#pragma unroll
            for (int ti = 0; ti < 4; ++ti)
#pragma unroll
                for (int tj = 0; tj < 4; ++tj) acc[ti][tj] = MFMA16(af[ti], bfr[tj], acc[ti][tj]);
        }
    };
    u16* buf0 = lds; u16* buf1 = lds + 2 * TILE_ELEMS;
    if (pre) {
#pragma unroll
        for (int i = 0; i < 4; ++i) { ra0[i] = pre->ra[i]; rb0[i] = pre->rb[i]; }
    } else gl(0, ra0, rb0);
    st(buf0, ra0, rb0);
    gl(1, ra1, rb1);
    __syncthreads();
    for (int kt = 0; kt < nk; kt += 2) {
        gl(kt + 2, ra0, rb0);
        __builtin_amdgcn_sched_barrier(0);
        mm(buf0);
        __builtin_amdgcn_sched_barrier(0);
        st(buf1, ra1, rb1);
        __syncthreads();
        gl(kt + 3, ra1, rb1);
        __builtin_amdgcn_sched_barrier(0);
        mm(buf1);
        __builtin_amdgcn_sched_barrier(0);
        st(buf0, ra0, rb0);
        __syncthreads();
    }
}
DI void gemm256_main(const u16* a0, size_t a_r64, const u16* b0, size_t b_r64, int nk, u16* lds, f32x4 (&acc)[8][4]) {
    int tid = threadIdx.x; asm volatile("" : "+v"(tid));
    const int lane = tid & 63, w = tid >> 6, wr = w >> 2, wc = w & 3, lr = lane & 15, q = lane >> 4;
    const int wofs = (tid >> 3) * 64 + (((tid & 7) ^ ((tid >> 3) & 7)) << 3);
    u32x4 ra[4], rb[4];
    auto gl = [&](int kt) {
        const int k = kt < nk ? kt : nk - 1;
#pragma unroll
        for (int i = 0; i < 4; ++i) { ra[i] = ld16(a0 + (size_t)k * 64 + i * a_r64); rb[i] = ld16(b0 + (size_t)k * 64 + i * b_r64); }
    };
    auto st = [&](u16* buf) {
#pragma unroll
        for (int i = 0; i < 4; ++i) { *(u32x4*)(buf + wofs + i * 4096) = ra[i]; *(u32x4*)(buf + 16384 + wofs + i * 4096) = rb[i]; }
    };
    auto ktile = [&](const u16* As, u16* nxt) {
        const u16* Bs = As + 16384;
        const int co0 = (q ^ (lr & 7)) << 3, co1 = ((4 + q) ^ (lr & 7)) << 3;
        bf16x8 b0f[4], b1f[4], a0f[8], a1f[8];
#pragma unroll
        for (int t = 0; t < 4; ++t) b0f[t] = ldf(Bs + (64 * wc + 16 * t + lr) * 64 + co0);
#pragma unroll
        for (int t = 0; t < 3; ++t) a0f[t] = ldf(As + (128 * wr + 16 * t + lr) * 64 + co0);
#pragma unroll
        for (int ti = 0; ti < 8; ++ti) {
            if (ti + 3 < 8) a0f[ti + 3] = ldf(As + (128 * wr + 16 * (ti + 3) + lr) * 64 + co0);
            if (ti == 5) { b1f[0] = ldf(Bs + (64 * wc + lr) * 64 + co1); b1f[1] = ldf(Bs + (64 * wc + 16 + lr) * 64 + co1); }
            if (ti == 6) { b1f[2] = ldf(Bs + (64 * wc + 32 + lr) * 64 + co1); b1f[3] = ldf(Bs + (64 * wc + 48 + lr) * 64 + co1); }
            if (ti == 7) { a1f[0] = ldf(As + (128 * wr + lr) * 64 + co1); a1f[1] = ldf(As + (128 * wr + 16 + lr) * 64 + co1); }
#pragma unroll
            for (int tj = 0; tj < 4; ++tj) acc[ti][tj] = MFMA16(a0f[ti], b0f[tj], acc[ti][tj]);
        }
#pragma unroll
        for (int ti = 0; ti < 8; ++ti) {
            if (ti + 2 < 8) a1f[ti + 2] = ldf(As + (128 * wr + 16 * (ti + 2) + lr) * 64 + co1);
#pragma unroll
            for (int tj = 0; tj < 4; ++tj) acc[ti][tj] = MFMA16(a1f[ti], b1f[tj], acc[ti][tj]);
        }
        st(nxt);
        __builtin_amdgcn_sched_group_barrier(0x100, 7, 0);
#pragma unroll
        for (int ti = 0; ti < 8; ++ti) {
            if (ti < 5) __builtin_amdgcn_sched_group_barrier(0x100, 1, 0);
            if (ti >= 5) __builtin_amdgcn_sched_group_barrier(0x100, 2, 0);
            __builtin_amdgcn_sched_group_barrier(0x008, 4, 0);
        }
#pragma unroll
        for (int ti = 0; ti < 8; ++ti) {
            if (ti < 6) __builtin_amdgcn_sched_group_barrier(0x100, 1, 0);
            __builtin_amdgcn_sched_group_barrier(0x008, 4, 0);
            __builtin_amdgcn_sched_group_barrier(0x200, 1, 0);
        }
    };
    gl(0);
    st(lds);
    __syncthreads();
    for (int kt = 0; kt < nk; ++kt) {
        u16* cur = lds + (kt & 1) * 32768;
        u16* nxt = lds + ((kt + 1) & 1) * 32768;
        gl(kt + 1);
        __builtin_amdgcn_sched_barrier(0);
        ktile(cur, nxt);
        __syncthreads();
    }
}
DI void zero_acc8(f32x4 (&acc)[8][4]) {
#pragma unroll
    for (int i = 0; i < 8; ++i)
#pragma unroll
        for (int j = 0; j < 4; ++j) acc[i][j] = f32x4{0.f, 0.f, 0.f, 0.f};
}
DI void stage_acc8(unsigned char* smem_all, int pass, const f32x4 (&acc)[8][4]) {
    const int tid = threadIdx.x, lane = tid & 63, w = tid >> 6, wr = w >> 2, wc = w & 3, lr = lane & 15, q = lane >> 4;
    if (wr != pass) return;
    float* cst = (float*)(smem_all + (wc >> 1) * 69632);
#pragma unroll
    for (int ti = 0; ti < 8; ++ti)
#pragma unroll
        for (int tj = 0; tj < 4; ++tj)
#pragma unroll
            for (int r = 0; r < 4; ++r) cst[(16 * ti + 4 * q + r) * CST + (wc & 1) * 64 + 16 * tj + lr] = acc[ti][tj][r];
}
DI void zero_acc(f32x4 (&acc)[4][4]) {
#pragma unroll
    for (int i = 0; i < 4; ++i)
#pragma unroll
        for (int j = 0; j < 4; ++j) acc[i][j] = f32x4{0.f, 0.f, 0.f, 0.f};
}
DI void stage_acc(float* cst, const f32x4 (&acc)[4][4]) {
    const int lane = TID() & 63, w = TID() >> 6;
    const int wr = w >> 1, wc = w & 1, lr = lane & 15, q = lane >> 4;
#pragma unroll
    for (int ti = 0; ti < 4; ++ti)
#pragma unroll
        for (int tj = 0; tj < 4; ++tj)
#pragma unroll
            for (int r = 0; r < 4; ++r)
                cst[(64 * wr + 16 * ti + 4 * q + r) * CST + 64 * wc + 16 * tj + lr] = acc[ti][tj][r];
}
template <typename F> DI void emit_rows(const float* cst, F f) {
#pragma unroll 4
    for (int i = 0; i < 8; ++i) {
        const int item = TID() + 256 * i, row = item >> 4, c8 = item & 15;
        const float4 a = *(const float4*)(cst + row * CST + c8 * 8);
        const float4 b = *(const float4*)(cst + row * CST + c8 * 8 + 4);
        float v[8] = {a.x, a.y, a.z, a.w, b.x, b.y, b.z, b.w};
        f(row, c8, v);
    }
}
template <typename F> DI void emit_cols(const float* cst, F f) {
#pragma unroll 4
    for (int i = 0; i < 8; ++i) {
        const int item = TID() + 256 * i, rest = item >> 6;
        const int col = (item & 15) + 16 * (rest & 7), r8 = ((item >> 4) & 3) + 4 * (rest >> 3);
        float v[8];
#pragma unroll
        for (int k = 0; k < 8; ++k) v[k] = cst[(r8 * 8 + k) * CST + col];
        f(col, r8, v);
    }
}


DI void transpose_tile(const float* src, int ldsrc, int k0, int n0, u16* dst, int lddst, int map_in, float* tl) {
    const int tid = TID();
    const int c = tid & 63;
    int oc = n0 + c;
    if (map_in) oc = (oc < 1280) ? oc : (oc < 6912 ? oc + 24 : (oc < 6936 ? oc - 6912 + 1280 : -1));
#pragma unroll
    for (int i = 0; i < 16; ++i) {
        const int r = (tid >> 6) + 4 * i;
        tl[r * 65 + c] = (oc >= 0) ? src[(size_t)(k0 + r) * ldsrc + oc] : 0.f;
    }
    __syncthreads();
    const int nl = tid >> 2, kc = (tid & 3) * 16;
    float v[16];
#pragma unroll
    for (int i = 0; i < 16; ++i) v[i] = tl[(kc + i) * 65 + nl];
    u16* d = dst + (size_t)(n0 + nl) * lddst + k0 + kc;
    *(u32x4*)d = pack8(v);
    *(u32x4*)(d + 8) = pack8(v + 8);
    __syncthreads();
}

DI void transpose_tile2(const float* src, int ldsrc, int k0, int n0, u16* dst, int lddst, int map_in, float* tl) {
    const int tid = TID();
    const int c = tid & 63;
    int oc = n0 + c;
    if (map_in) oc = (oc < 1280) ? oc : (oc < 6912 ? oc + 24 : (oc < 6936 ? oc - 6912 + 1280 : -1));
    float ld[32];
#pragma unroll
    for (int i = 0; i < 32; ++i) {
        const int r = (tid >> 6) + 4 * i;
        ld[i] = (oc >= 0) ? src[(size_t)(k0 + r) * ldsrc + oc] : 0.f;
    }
#pragma unroll
    for (int i = 0; i < 32; ++i) tl[((tid >> 6) + 4 * i) * 65 + c] = ld[i];
    __syncthreads();
    const int nl = tid >> 2, kc = (tid & 3) * 32;
    u16* d = dst + (size_t)(n0 + nl) * lddst + k0 + kc;
#pragma unroll
    for (int h = 0; h < 4; ++h) {
        float v[8];
#pragma unroll
        for (int i = 0; i < 8; ++i) v[i] = tl[(kc + 8 * h + i) * 65 + nl];
        *(u32x4*)(d + 8 * h) = pack8(v);
    }
    __syncthreads();
}

DI void p0_unit(const Params& p, int u, unsigned char* smem) {
    const int tid = TID(), lane = tid & 63, w = tid >> 6;
    float* tl = (float*)smem;
    if (u < 1800) {
        int t = u;
        if (t < 896) { transpose_tile2(p.w_in, 6936, (t & 7) * 128, (t >> 3) * 64, p.WinT, 1024, 1, tl); return; }
        t -= 896;
        if (t < 128) { transpose_tile(p.w_nsa_o, 1024, (t & 7) * 64, (t >> 3) * 64, p.WnoT, 512, 0, tl); return; }
        t -= 128;
        if (t < 256) { transpose_tile(p.w_ret_o, 1024, (t & 15) * 64, (t >> 4) * 64, p.WroT, 1024, 0, tl); return; }
        t -= 256;
        if (t < 256) { transpose_tile(p.w_out, 1024, (t & 15) * 64, (t >> 4) * 64, p.WoutT, 1024, 0, tl); return; }
        t -= 256;
        if (t < 128) { transpose_tile(p.w1_k, 256, (t & 31) * 64, (t >> 5) * 64, p.W1T[0], 2048, 0, tl); return; }
        t -= 128;
        if (t < 128) { transpose_tile(p.w1_v, 256, (t & 31) * 64, (t >> 5) * 64, p.W1T[1], 2048, 0, tl); return; }
        t -= 128;
        if (t < 4) { transpose_tile(p.w2_k, 64, t * 64, 0, p.W2T[0], 256, 0, tl); return; }
        t -= 4;
        transpose_tile(p.w2_v, 64, t * 64, 0, p.W2T[1], 256, 0, tl);
        return;
    }
    u -= 1800;
    if (u < 1024) {
        float4 v[4][4]; float ss[4];
#pragma unroll
        for (int rr = 0; rr < 4; ++rr) {
            const float* xr = p.x + (size_t)(u * 16 + w * 4 + rr) * 1024;
#pragma unroll
            for (int i = 0; i < 4; ++i) { const f32x4 t4 = __builtin_nontemporal_load((const f32x4*)(xr + lane * 4 + 256 * i)); v[rr][i] = make_float4(t4[0], t4[1], t4[2], t4[3]); }
        }
        float4 g[4];
#pragma unroll
        for (int i = 0; i < 4; ++i) g[i] = *(const float4*)(p.norm_pre + lane * 4 + 256 * i);
#pragma unroll
        for (int rr = 0; rr < 4; ++rr) {
            float s = 0.f;
#pragma unroll
            for (int i = 0; i < 4; ++i) s += v[rr][i].x * v[rr][i].x + v[rr][i].y * v[rr][i].y + v[rr][i].z * v[rr][i].z + v[rr][i].w * v[rr][i].w;
            ss[rr] = wave_sum(s);
        }
#pragma unroll
        for (int rr = 0; rr < 4; ++rr) {
            const float rs = rsqrtf(ss[rr] * (1.f / 1024.f) + 1e-6f);
            u16* hr = p.H + (size_t)(u * 16 + w * 4 + rr) * 1024;
#pragma unroll
            for (int i = 0; i < 4; ++i) {
                u32x2 o; o[0] = pack2(v[rr][i].x * rs * g[i].x, v[rr][i].y * rs * g[i].y); o[1] = pack2(v[rr][i].z * rs * g[i].z, v[rr][i].w * rs * g[i].w);
                *(u32x2*)(hr + lane * 4 + 256 * i) = o;
            }
        }
        return;
    }
    u -= 1024;
    if (u < 1024) {
        const int i = tid & 63;
        const float inv = 1.0f / powf(10000.0f, (float)i / 63.0f);
#pragma unroll
        for (int k = 0; k < 4; ++k) {
            const int e = u * 1024 + tid + 256 * k, pos = e >> 6;
            const float ang = (float)pos * inv;
            float sn, cs; sincosf(ang, &sn, &cs);
            p.ropeR[e] = make_float2(cs, sn);
        }
        return;
    }
    u -= 1024;
    if (u < 128) {
        const int i = tid & 7;
        const float inv = 1.0f / powf(500000.0f, (float)(2 * i) / 16.0f);
#pragma unroll
        for (int k = 0; k < 4; ++k) {
            const int e = u * 1024 + tid + 256 * k, pos = e >> 3;
            const float ang = (float)pos * inv;
            float sn, cs; sincosf(ang, &sn, &cs);
            p.ropeN[e] = make_float2(cs, sn);
        }
        return;
    }
    u -= 128;
    {
        const int kv = u >> 4, ch = u & 15;
        const float* pe = kv ? p.pe_v : p.pe_k;
        const float* w1 = kv ? p.w1_v : p.w1_k;
        float s = 0.f;
        for (int k = ch * 128; k < ch * 128 + 128; ++k) s += pe[k] * w1[(size_t)k * 256 + tid];
        p.bpart[(kv * 16 + ch) * 256 + tid] = s;
    }
}
constexpr int P0_UNITS = 1800 + 1024 + 1024 + 128 + 32;

DI void p1_epi(const Params& p, float* cst, int mt, int nt) {
    const int tid = TID();
    const int tok0 = mt * 128;
    if (nt <= 4 || nt == 6 || nt == 8) {
#pragma unroll 2
        for (int i = 0; i < 8; ++i) {
            const int item = tid + 256 * i, row = item >> 4, hh = (item >> 3) & 1, ii = item & 7;
            float* px = cst + row * CST + hh * 64 + ii;
            const float x1 = px[0], x2 = px[8];
            const float2 cs = p.ropeN[(size_t)(tok0 + row) * 8 + ii];
            px[0] = x1 * cs.x - x2 * cs.y; px[8] = x2 * cs.x + x1 * cs.y;
        }
    } else if (nt >= 14 && nt <= 21) {
        const float sc = (nt >= 18) ? 0.08838834764831845f : 1.0f;
#pragma unroll 2
        for (int i = 0; i < 32; ++i) {
            const int item = tid + 256 * i, row = item >> 6, ii = item & 63;
            float* px = cst + row * CST + ii;
            const float x1 = px[0], x2 = px[64];
            const float2 cs = p.ropeR[(size_t)(tok0 + row) * 64 + ii];
            px[0] = (x1 * cs.x - x2 * cs.y) * sc; px[64] = (x2 * cs.x + x1 * cs.y) * sc;
        }
    }
    __syncthreads();
    if (nt <= 3) {
        emit_rows(cst, [&](int row, int c8, const float* v) { __builtin_nontemporal_store(pack8(v), (u32x4*)(p.Qn + (size_t)(tok0 + row) * 512 + nt * 128 + c8 * 8)); });
    } else if (nt == 4 || nt == 5) {
        u16* dst = (nt == 4) ? p.Raw[0] : p.Raw[1];
        emit_rows(cst, [&](int row, int c8, const float* v) { __builtin_nontemporal_store(pack8(v), (u32x4*)(dst + (size_t)(tok0 + row) * 128 + c8 * 8)); });
    } else if (nt == 6 || nt == 8) {
        u16* dst = (nt == 6) ? p.Ks : p.Kw;
        emit_rows(cst, [&](int row, int c8, const float* v) { __builtin_nontemporal_store(pack8(v), (u32x4*)(dst + ((size_t)(c8 >> 3) * S_ + tok0 + row) * 64 + (c8 & 7) * 8)); });
    } else if (nt == 7 || nt == 9) {
        u16* dst = (nt == 7) ? p.VsT : p.VwT;
        emit_cols(cst, [&](int col, int r8, const float* v) {
            const int g = col >> 6, d = col & 63, tk = tok0 + r8 * 8;
            __builtin_nontemporal_store(pack8(v), (u32x4*)(dst + (((size_t)g * 256 + (tk >> 6)) * 64 + d) * 64 + (tk & 63))); });
    } else if (nt <= 13) {
        emit_rows(cst, [&](int row, int c8, const float* v) {
            float o[8];
#pragma unroll
            for (int k = 0; k < 8; ++k) o[k] = v[k] * sigmoidf_(v[k]);
            __builtin_nontemporal_store(pack8(o), (u32x4*)(p.SZn + (size_t)(tok0 + row) * 512 + (nt - 10) * 128 + c8 * 8)); });
    } else if (nt <= 17) {
        const int h = nt - 14;
        emit_rows(cst, [&](int row, int c8, const float* v) { __builtin_nontemporal_store(pack8(v), (u32x4*)(p.Qr + ((size_t)h * S_ + tok0 + row) * 128 + c8 * 8)); });
    } else if (nt <= 21) {
        const int h = nt - 18;
        emit_rows(cst, [&](int row, int c8, const float* v) { __builtin_nontemporal_store(pack8(v), (u32x4*)(p.Kr + ((size_t)h * S_ + tok0 + row) * 128 + c8 * 8)); });
        const float lg = logf(1.0f - exp2f(-5.0f - (float)h));
        emit_cols(cst, [&](int col, int r8, const float* v) {
            float o[8];
#pragma unroll
            for (int k = 0; k < 8; ++k) o[k] = v[k] * __expf((float)(127 - (r8 * 8 + k)) * lg);
            __builtin_nontemporal_store(pack8(o), (u32x4*)(p.KrT + (((size_t)h * 128 + mt) * 128 + col) * 128 + r8 * 8)); });
    } else if (nt <= 29) {
        const int h = (nt - 22) >> 1, e0 = ((nt - 22) & 1) * 128;
        emit_cols(cst, [&](int col, int r8, const float* v) {
            __builtin_nontemporal_store(pack8(v), (u32x4*)(p.VrT + (((size_t)h * 128 + mt) * 256 + e0 + col) * 128 + r8 * 8)); });
    } else if (nt <= 37) {
        emit_rows(cst, [&](int row, int c8, const float* v) {
            float o[8];
#pragma unroll
            for (int k = 0; k < 8; ++k) o[k] = v[k] * sigmoidf_(v[k]);
            __builtin_nontemporal_store(pack8(o), (u32x4*)(p.SZr + (size_t)(tok0 + row) * 1024 + (nt - 30) * 128 + c8 * 8)); });
    } else if (nt <= 53) {
        u16* dst = (nt <= 45) ? p.Ma : p.Mb;
        const int c0 = ((nt <= 45) ? (nt - 38) : (nt - 46)) * 128;
        emit_rows(cst, [&](int row, int c8, const float* v) {
            float o[8];
#pragma unroll
            for (int k = 0; k < 8; ++k) o[k] = sigmoidf_(v[k]);
            __builtin_nontemporal_store(pack8(o), (u32x4*)(dst + (size_t)(tok0 + row) * 1024 + c0 + c8 * 8)); });
    } else if (nt == 54) {
#pragma unroll 2
        for (int i = 0; i < 12; ++i) {
            const int item = tid + 256 * i, row = item / 24, c = item - row * 24;
            p.Gn[(size_t)(tok0 + row) * 24 + c] = sigmoidf_(cst[row * CST + c] + p.b_gate[c]);
        }
    }
    __syncthreads();
}

DI void p1_tile256(const Params& p, int t, unsigned char* smem_all) {
    const int tid = threadIdx.x, team = TEAM();
    const int nt = t >> 6, mt = t & 63;
    f32x4 acc[8][4]; zero_acc8(acc);
    gemm256_main(p.H + (size_t)(mt * 256 + (tid >> 3)) * 1024 + (tid & 7) * 8, (size_t)64 * 1024,
                 p.WinT + (size_t)(nt * 256 + (tid >> 3)) * 1024 + (tid & 7) * 8, (size_t)64 * 1024, 16, (u16*)smem_all, acc);
    float* cst = (float*)(smem_all + team * 69632);
#pragma unroll
    for (int pass = 0; pass < 2; ++pass) {
        stage_acc8(smem_all, pass, acc);
        __syncthreads();
        p1_epi(p, cst, mt * 2 + pass, nt * 2 + team);
    }
}


DI void p2_unit(const Params& p, int u, unsigned char* smem) {
    const int tid = TID(), lane = tid & 63, w = tid >> 6;
    u16* lds = (u16*)smem; float* cst = (float*)smem;
    f32x4 acc[4][4]; zero_acc(acc);
    if (u < 256) {
        const int nt = u & 1, mt = (u >> 1) & 15, ks = (u >> 5) & 3, kv = u >> 7;
        const int R = mt * 128 + (tid >> 3), c = R >> 1, g = R & 1;
        const u16* a0 = (kv ? p.Raw[1] : p.Raw[0]) + (size_t)(16 * c + ks * 8) * 128 + g * 64 + (tid & 7) * 8;
        const u16* b0 = (kv ? p.W1T[1] : p.W1T[0]) + (size_t)(nt * 128 + (tid >> 3)) * 2048 + ks * 512 + (tid & 7) * 8;
        gemm128_main(a0, (size_t)16 * 16 * 128, 128, b0, (size_t)32 * 2048, 64, 8, lds, acc);
        const int wr = w >> 1, wc = w & 1, lr = lane & 15, q = lane >> 4;
        float* dst = p.slab + ((size_t)(ks * 2 + kv) * 2048 + mt * 128) * 256 + nt * 128;
#pragma unroll
        for (int ti = 0; ti < 4; ++ti)
#pragma unroll
            for (int tj = 0; tj < 4; ++tj)
#pragma unroll
                for (int r = 0; r < 4; ++r)
                    dst[(size_t)(64 * wr + 16 * ti + 4 * q + r) * 256 + 64 * wc + 16 * tj + lr] = acc[ti][tj][r];
        return;
    }
    const int v = u - 256, half = v & 1, ch = v >> 1, n = ch >> 2, h = ch & 3;
    const u16* a0 = p.VrT + (((size_t)h * 128 + n) * 256 + half * 128 + (tid >> 3)) * 128 + (tid & 7) * 8;
    const u16* b0 = p.KrT + (((size_t)h * 128 + n) * 128 + (tid >> 3)) * 128 + (tid & 7) * 8;
    gemm128_main(a0, (size_t)32 * 128, 64, b0, (size_t)32 * 128, 64, 2, lds, acc);
    stage_acc(cst, acc);
    __syncthreads();
    u16* dst = p.H + (((size_t)n * 4 + h) * 256 + half * 128) * 128;
    emit_rows(cst, [&](int row, int c8, const float* vv) { *(u32x4*)(dst + (size_t)row * 128 + c8 * 8) = pack8(vv); });
    __syncthreads();
}
constexpr int P2_UNITS = 256 + 1024;

DI float gelu_tanh(float x) {
    const float u = 0.7978845608028654f * (x + 0.044715f * x * x * x);
    const float t = 1.f - 2.f / (1.f + __expf(2.f * u));
    return 0.5f * x * (1.f + t);
}
DI void p3_unit(const Params& p, int u, unsigned char* smem) {
    const int tid = TID(), lane = tid & 63, w = tid >> 6;
    const int v = u, kv = v & 1, rt = v >> 1;
    float* bias = (float*)smem;
    {
        float s = 0.f;
#pragma unroll
        for (int i = 0; i < 16; ++i) s += p.bpart[(kv * 16 + i) * 256 + tid];
        bias[tid] = s;
    }
    __syncthreads();
    const int lr = lane & 15, q = lane >> 4;
    const int R = rt * 16 + lr;
    f32x4 acc = {0.f, 0.f, 0.f, 0.f};
#pragma unroll
    for (int ks = 0; ks < 8; ++ks) {
        const int k0 = ks * 32 + q * 8;
        float hv[8];
#pragma unroll
        for (int k = 0; k < 8; ++k) hv[k] = bias[k0 + k];
#pragma unroll
        for (int s = 0; s < 4; ++s) {
            const float* sp = p.slab + ((size_t)(s * 2 + kv) * 2048 + R) * 256 + k0;
            const float4 a = *(const float4*)sp, b = *(const float4*)(sp + 4);
            hv[0] += a.x; hv[1] += a.y; hv[2] += a.z; hv[3] += a.w; hv[4] += b.x; hv[5] += b.y; hv[6] += b.z; hv[7] += b.w;
        }
#pragma unroll
        for (int k = 0; k < 8; ++k) hv[k] = gelu_tanh(hv[k]);
        const bf16x8 af = __builtin_bit_cast(bf16x8, pack8(hv));
        const bf16x8 bfr = ldf((kv ? p.W2T[1] : p.W2T[0]) + (size_t)(16 * w + lr) * 256 + k0);
        acc = MFMA16(af, bfr, acc);
    }
    const int d = 16 * w + lr;
#pragma unroll
    for (int r = 0; r < 4; ++r) {
        const int Ro = rt * 16 + 4 * q + r, c = Ro >> 1, g = Ro & 1;
        const float val = (c < 1023) ? acc[r] : 0.f;
        const u16 bv = (u16)(pack2(val, 0.f) & 0xffffu);
        if (kv == 0) p.Kc[((size_t)g * 1024 + c) * 64 + d] = bv;
        else p.VcT[(((size_t)g * 16 + (c >> 6)) * 64 + d) * 64 + (c & 63)] = bv;
    }
    __syncthreads();
}
constexpr int P3_UNITS = 256;
DI void p3_scan(const Params& p, bool dry) {
    const int nfree = (int)gridDim.x - P3_UNITS / 2;
    const bool split = nfree >= 64;
    if (split && (int)blockIdx.x < P3_UNITS / 2) return;
    const int sb = split ? (int)blockIdx.x - P3_UNITS / 2 : (int)blockIdx.x, sn = split ? nfree : (int)gridDim.x;
    for (int t = sb * 512 + threadIdx.x; t < 65536; t += sn * 512) {
        const int idx = 2 * t, h = idx >> 15;
        const float dec = __expf(128.0f * logf(1.0f - exp2f(-5.0f - (float)h)));
        unsigned* base = (unsigned*)(p.H + idx);
        float r0 = 0.f, r1 = 0.f;
#pragma unroll 16
        for (int n = 0; n < 128; ++n) {
            unsigned* pp = base + (size_t)n * 65536;
            const unsigned kv = *pp;
            unsigned* wp = dry ? (unsigned*)p.rowss + (size_t)n * 512 + (t & 511) : pp;
            *wp = pack2(r0, r1);
            r0 = dec * r0 + bflo(kv); r1 = dec * r1 + bfhi(kv);
        }
    }
}

constexpr int IMPS = 260;
DI int NTID() { int t = threadIdx.x; asm volatile("" : "+v"(t)); return t; }
DI void nsa_load_tile(const u16* src, u32x4& r) {
    r = ld16(src + NTID() * 8);
}
DI void nsa_store_k(u16* dst, const u32x4& r) {
    const int c0 = NTID(), r0 = c0 >> 3;
    *(u32x4*)(dst + r0 * LDT + (((c0 & 7) ^ swzK(r0)) << 3)) = r;
}
DI void nsa_store_v(u16* dst, const u32x4& r) {
    const int c0 = NTID(), r0 = c0 >> 3;
    *(u32x4*)(dst + r0 * LDT + (((c0 & 7) ^ swzA(r0)) << 3)) = r;
}
DI void nsa_scores(const u16* Kt, const bf16x8 (&qf)[2][2], f32x4 (&s)[4][2]) {
    const int lane = NTID() & 63, lr = lane & 15, q = lane >> 4;
#pragma unroll
    for (int kt = 0; kt < 4; ++kt) {
        const int krow = 32 * (kt >> 1) + 8 * (lr >> 2) + 4 * (kt & 1) + (lr & 3);
        s[kt][0] = f32x4{0.f, 0.f, 0.f, 0.f}; s[kt][1] = f32x4{0.f, 0.f, 0.f, 0.f};
#pragma unroll
        for (int ks = 0; ks < 2; ++ks) {
            const bf16x8 kf = ldf(Kt + krow * LDT + (((ks * 4 + q) ^ swzK(krow)) << 3));
            s[kt][0] = MFMA16(kf, qf[0][ks], s[kt][0]);
            s[kt][1] = MFMA16(kf, qf[1][ks], s[kt][1]);
        }
    }
    __builtin_amdgcn_sched_group_barrier(0x100, 3, 0);
#pragma unroll
    for (int i = 0; i < 8; ++i) {
        __builtin_amdgcn_sched_group_barrier(0x008, 2, 0);
        if (i + 3 < 8) __builtin_amdgcn_sched_group_barrier(0x100, 1, 0);
    }
}
DI void nsa_pv(const u16* Vt, const f32x4 (&s)[4][2], f32x4 (&o)[4][2]) {
    const int lane = NTID() & 63, lr = lane & 15, q = lane >> 4;
#pragma unroll
    for (int ks2 = 0; ks2 < 2; ++ks2) {
        const bf16x8 pb0 = packf(s[2 * ks2][0], s[2 * ks2 + 1][0]);
        const bf16x8 pb1 = packf(s[2 * ks2][1], s[2 * ks2 + 1][1]);
#pragma unroll
        for (int dt = 0; dt < 4; ++dt) {
            const bf16x8 vf = ldf(Vt + (16 * dt + lr) * LDT + (((ks2 * 4 + q) ^ (lr & 7)) << 3));
            o[dt][0] = MFMA16(vf, pb0, o[dt][0]);
            o[dt][1] = MFMA16(vf, pb1, o[dt][1]);
        }
    }
    __builtin_amdgcn_sched_group_barrier(0x100, 3, 0);
#pragma unroll
    for (int i = 0; i < 8; ++i) {
        __builtin_amdgcn_sched_group_barrier(0x008, 2, 0);
        if (i + 3 < 8) __builtin_amdgcn_sched_group_barrier(0x100, 1, 0);
    }
}

DI void nsa_item(const Params& p, int tb, int g, unsigned char* smem) {
    u16* Kt = (u16*)smem;
    u16* Vt = Kt + 64 * LDT;
    float* imp = (float*)(smem + 2 * 64 * LDT * 2);
    int* sel = (int*)(smem + 83968);
    const int tid = NTID(), lane = tid & 63, w = tid >> 6, lr = lane & 15, q = lane >> 4;
    const int t0 = tb * 64, cur = tb;
    const float SC = 0.125f * LOG2E;
    const float NEG = -1e30f;

    bf16x8 qf[2][2];
    int tokL[2]; float gc[2], gs[2], gw[2];
#pragma unroll
    for (int rt = 0; rt < 2; ++rt) {
        tokL[rt] = t0 + 8 * w + 4 * rt + (lr >> 2);
        const int head = 4 * g + (lr & 3);
#pragma unroll
        for (int ks = 0; ks < 2; ++ks) qf[rt][ks] = ldf(p.Qn + (size_t)tokL[rt] * 512 + head * 64 + 32 * ks + 8 * q);
        const float* gp = p.Gn + (size_t)tokL[rt] * 24 + head * 3;
        gc[rt] = gp[0]; gs[rt] = gp[1]; gw[rt] = gp[2];
    }
    f32x4 tot[4][2];
#pragma unroll
    for (int dt = 0; dt < 4; ++dt) { tot[dt][0] = f32x4{0.f, 0.f, 0.f, 0.f}; tot[dt][1] = f32x4{0.f, 0.f, 0.f, 0.f}; }

    for (int rep = (MK_PROBE & 256) ? 0 : 1; rep < 2; ++rep) {
        float m[2] = {NEG, NEG}, l[2] = {0.f, 0.f};
        f32x4 o[4][2];
#pragma unroll
        for (int dt = 0; dt < 4; ++dt) { o[dt][0] = f32x4{0.f, 0.f, 0.f, 0.f}; o[dt][1] = f32x4{0.f, 0.f, 0.f, 0.f}; }
        const int kb_lo = (t0 > 511 ? t0 - 511 : 0) >> 6, kb_hi = cur;
        u32x4 rk, rv;
        nsa_load_tile(p.Kw + ((size_t)g * S_ + kb_lo * 64) * 64, rk);
        nsa_load_tile(p.VwT + ((size_t)g * 256 + kb_lo) * 4096, rv);
        for (int kb = kb_lo; kb <= kb_hi; ++kb) {
            __syncthreads();
            nsa_store_k(Kt, rk); nsa_store_v(Vt, rv);
            __syncthreads();
            if (kb < kb_hi) {
                nsa_load_tile(p.Kw + ((size_t)g * S_ + (kb + 1) * 64) * 64, rk);
                nsa_load_tile(p.VwT + ((size_t)g * 256 + kb + 1) * 4096, rv);
            }
            f32x4 s[4][2];
            nsa_scores(Kt, qf, s);
            const bool interior = (kb * 64 + 63 <= t0) && (kb * 64 > t0 + 63 - 512);
#pragma unroll
            for (int rt = 0; rt < 2; ++rt) {
                if (interior) {
                    float mx = NEG;
#pragma unroll
                    for (int kt = 0; kt < 4; ++kt) mx = fmaxf(fmaxf(mx, fmaxf(s[kt][rt][0], s[kt][rt][1])), fmaxf(s[kt][rt][2], s[kt][rt][3]));
                    mx *= SC;
                    mx = qmax(mx);
                    const float mn = fmaxf(m[rt], mx), alpha = ex2(m[rt] - mn);
                    float rs = 0.f;
#pragma unroll
                    for (int kt = 0; kt < 4; ++kt)
#pragma unroll
                        for (int r = 0; r < 4; ++r) { const float pv = ex2(fmaf(s[kt][rt][r], SC, -mn)); s[kt][rt][r] = pv; rs += pv; }
                    l[rt] = l[rt] * alpha + rs; m[rt] = mn;
#pragma unroll
                    for (int dt = 0; dt < 4; ++dt) o[dt][rt] *= alpha;
                    continue;
                }
                const int t = tokL[rt];
                float mx = NEG;
#pragma unroll
                for (int kt = 0; kt < 4; ++kt)
#pragma unroll
                    for (int r = 0; r < 4; ++r) {
                        const int key = kb * 64 + 32 * (kt >> 1) + 8 * q + 4 * (kt & 1) + r;
                        const bool ok = (key <= t) && (key > t - 512);
                        const float v = ok ? s[kt][rt][r] * SC : NEG;
                        s[kt][rt][r] = v; mx = fmaxf(mx, v);
                    }
                mx = qmax(mx);
                const float mn = fmaxf(m[rt], mx), alpha = ex2(m[rt] - mn);
                float rs = 0.f;
#pragma unroll
                for (int kt = 0; kt < 4; ++kt)
#pragma unroll
                    for (int r = 0; r < 4; ++r) {
                        const float v = s[kt][rt][r];
                        const float pv = (v > -1e29f) ? ex2(v - mn) : 0.f;
                        s[kt][rt][r] = pv; rs += pv;
                    }
                l[rt] = l[rt] * alpha + rs; m[rt] = mn;
#pragma unroll
                for (int dt = 0; dt < 4; ++dt) o[dt][rt] *= alpha;
            }
            nsa_pv(Vt, s, o);
        }
#pragma unroll
        for (int rt = 0; rt < 2; ++rt) {
            float lt = l[rt]; lt = qsum(lt);
            const float f = (rep == 1) ? gw[rt] / fmaxf(lt, 1e-37f) : 0.f;
#pragma unroll
            for (int dt = 0; dt < 4; ++dt) tot[dt][rt] += o[dt][rt] * f;
        }
    }

    for (int rep = (MK_PROBE & 512) ? 0 : 1; rep < 2; ++rep) {
        const int nct = (((t0 + 32) >> 4) >> 6) + 1;
        int cmaxv[2]; cmaxv[0] = (tokL[0] - 31) >> 4; cmaxv[1] = (tokL[1] - 31) >> 4;
        const int cfull = (t0 - 31) >> 4;
        float m[2] = {NEG, NEG}, l[2] = {0.f, 0.f};
        u32x4 rk, rv;
        nsa_load_tile(p.Kc + ((size_t)g * 1024) * 64, rk);
        for (int ct = 0; ct < nct; ++ct) {
            __syncthreads();
            nsa_store_k(Kt, rk);
            __syncthreads();
            if (ct + 1 < nct) nsa_load_tile(p.Kc + ((size_t)g * 1024 + (ct + 1) * 64) * 64, rk);
            f32x4 s[4][2];
            nsa_scores(Kt, qf, s);
#pragma unroll
            for (int rt = 0; rt < 2; ++rt) {
                if (ct * 64 + 63 <= cfull) {
                    float mx = NEG;
#pragma unroll
                    for (int kt = 0; kt < 4; ++kt) mx = fmaxf(fmaxf(mx, fmaxf(s[kt][rt][0], s[kt][rt][1])), fmaxf(s[kt][rt][2], s[kt][rt][3]));
                    mx *= SC;
                    mx = qmax(mx);
                    const float mn = fmaxf(m[rt], mx), alpha = ex2(m[rt] - mn);
                    float rs = 0.f;
#pragma unroll
                    for (int kt = 0; kt < 4; ++kt)
#pragma unroll
                        for (int r = 0; r < 4; ++r) rs += ex2(fmaf(s[kt][rt][r], SC, -mn));
                    l[rt] = l[rt] * alpha + rs; m[rt] = mn;
                    continue;
                }
                float mx = NEG;
#pragma unroll
                for (int kt = 0; kt < 4; ++kt)
#pragma unroll
                    for (int r = 0; r < 4; ++r) {
                        const int c = ct * 64 + 32 * (kt >> 1) + 8 * q + 4 * (kt & 1) + r;
                        const float v = (c <= cmaxv[rt]) ? s[kt][rt][r] * SC : NEG;
                        s[kt][rt][r] = v; mx = fmaxf(mx, v);
                    }
                mx = qmax(mx);
                const float mn = fmaxf(m[rt], mx), alpha = ex2(m[rt] - mn);
                float rs = 0.f;
#pragma unroll
                for (int kt = 0; kt < 4; ++kt)
#pragma unroll
                    for (int r = 0; r < 4; ++r) { const float v = s[kt][rt][r]; rs += (v > -1e29f) ? ex2(v - mn) : 0.f; }
                l[rt] = l[rt] * alpha + rs; m[rt] = mn;
            }
        }
        float linv[2];
#pragma unroll
        for (int rt = 0; rt < 2; ++rt) {
            float lt = l[rt]; lt = qsum(lt);
            linv[rt] = 1.f / fmaxf(lt, 1e-37f);
        }
        f32x4 o[4][2];
#pragma unroll
        for (int dt = 0; dt < 4; ++dt) { o[dt][0] = f32x4{0.f, 0.f, 0.f, 0.f}; o[dt][1] = f32x4{0.f, 0.f, 0.f, 0.f}; }
        float carry[2] = {0.f, 0.f};
        nsa_load_tile(p.Kc + ((size_t)g * 1024) * 64, rk);
        nsa_load_tile(p.VcT + ((size_t)g * 16) * 4096, rv);
        for (int ct = 0; ct < nct; ++ct) {
            __syncthreads();
            nsa_store_k(Kt, rk); nsa_store_v(Vt, rv);
            __syncthreads();
            if (ct + 1 < nct) {
                nsa_load_tile(p.Kc + ((size_t)g * 1024 + (ct + 1) * 64) * 64, rk);
                nsa_load_tile(p.VcT + ((size_t)g * 16 + ct + 1) * 4096, rv);
            }
            f32x4 s[4][2];
            nsa_scores(Kt, qf, s);
#pragma unroll
            for (int rt = 0; rt < 2; ++rt) {
                if (ct * 64 + 63 <= cfull) {
#pragma unroll
                    for (int kt = 0; kt < 4; ++kt)
#pragma unroll
                        for (int r = 0; r < 4; ++r) s[kt][rt][r] = ex2(fmaf(s[kt][rt][r], SC, -m[rt])) * linv[rt];
                } else {
#pragma unroll
                    for (int kt = 0; kt < 4; ++kt)
#pragma unroll
                        for (int r = 0; r < 4; ++r) {
                            const int c = ct * 64 + 32 * (kt >> 1) + 8 * q + 4 * (kt & 1) + r;
                            s[kt][rt][r] = (c <= cmaxv[rt]) ? ex2(s[kt][rt][r] * SC - m[rt]) * linv[rt] : 0.f;
                        }
                }
                const float up1 = __shfl_up(s[1][rt][3], 16), up3 = __shfl_up(s[3][rt][3], 16);
                const float w1 = __shfl(s[1][rt][3], lr + 48), w3 = __shfl(s[3][rt][3], lr + 48);
                float e[4];
                e[0] = s[0][rt][0] + s[0][rt][1] + s[0][rt][2] + s[0][rt][3] + (q > 0 ? up1 : carry[rt]);
                e[1] = s[1][rt][0] + s[1][rt][1] + s[1][rt][2] + s[1][rt][3] + s[0][rt][3];
                e[2] = s[2][rt][0] + s[2][rt][1] + s[2][rt][2] + s[2][rt][3] + (q > 0 ? up3 : w1);
                e[3] = s[3][rt][0] + s[3][rt][1] + s[3][rt][2] + s[3][rt][3] + s[2][rt][3];
                carry[rt] = w3;
#pragma unroll
                for (int kt = 0; kt < 4; ++kt) {
                    float ev = e[kt];
                    ev += __shfl_xor(ev, 1); ev += __shfl_xor(ev, 2);
                    if ((lr & 3) == 0) imp[(8 * w + 4 * rt + (lr >> 2)) * IMPS + ct * 16 + 8 * (kt >> 1) + 2 * q + (kt & 1)] = ev;
                }
            }
            nsa_pv(Vt, s, o);
        }
#pragma unroll
        for (int rt = 0; rt < 2; ++rt)
#pragma unroll
            for (int dt = 0; dt < 4; ++dt) tot[dt][rt] += o[dt][rt] * ((rep == 1) ? gc[rt] : 0.f);
    }
    __syncthreads();

    for (int rep = (MK_PROBE & 1024) ? 0 : 1; rep < 2; ++rep)
    for (int tk = 0; tk < 8; tk += 2) {
        const int tl0 = 8 * w + tk, tl1 = tl0 + 1;
        unsigned va[4], vb[4];
#pragma unroll
        for (int i = 0; i < 4; ++i) {
            const int j = lane + 64 * i;
            const bool cand = (j <= cur) && (j != 0) && (j != cur) && (j != cur - 1);
            va[i] = cand ? (__float_as_uint(imp[tl0 * IMPS + j]) + 1u) : 0u;
            vb[i] = cand ? (__float_as_uint(imp[tl1 * IMPS + j]) + 1u) : 0u;
        }
        int sela = -1, selb = -1;
        if (lane == 0) { sela = 0; selb = 0; }
        if (cur > 0 && lane == 1) { sela = cur; selb = cur; }
        if (cur > 1 && lane == 2) { sela = cur - 1; selb = cur - 1; }
        const int nforced = 1 + (cur > 0 ? 1 : 0) + (cur > 1 ? 1 : 0);
        auto take = [&](unsigned (&v)[4], unsigned wm) -> int {
            const unsigned long long b0 = __ballot(v[0] == wm);
            if (b0) { const int ow = __builtin_ctzll(b0); if (lane == ow) v[0] = 0u; return ow; }
            const unsigned long long b1 = __ballot(v[1] == wm);
            if (b1) { const int ow = __builtin_ctzll(b1); if (lane == ow) v[1] = 0u; return ow + 64; }
            const unsigned long long b2 = __ballot(v[2] == wm);
            if (b2) { const int ow = __builtin_ctzll(b2); if (lane == ow) v[2] = 0u; return ow + 128; }
            const unsigned long long b3 = __ballot(v[3] == wm);
            if (b3) { const int ow = __builtin_ctzll(b3); if (lane == ow) v[3] = 0u; return ow + 192; }
            return -1;
        };
        for (int it = nforced; it < 16; ++it) {
            const unsigned wma = wave_umax(max(max(va[0], va[1]), max(va[2], va[3])));
            const unsigned wmb = wave_umax(max(max(vb[0], vb[1]), max(vb[2], vb[3])));
            if ((wma | wmb) == 0u) break;
            if (wma) { const int js = take(va, wma); if (lane == it) sela = js; }
            if (wmb) { const int js = take(vb, wmb); if (lane == it) selb = js; }
        }
        if (lane < 16) { sel[tl0 * 16 + lane] = sela; sel[tl1 * 16 + lane] = selb; }
    }
    __syncthreads();

    {
        unsigned long long* bmask = (unsigned long long*)(sel + 64 * 16);
        int* blist = (int*)(bmask + 256);
        if (tid < 256) bmask[tid] = 0ull;
        __syncthreads();
        for (int e = tid; e < 1024; e += 512) { const int j = sel[e]; if (j >= 0) atomicOr(&bmask[j], 1ull << (e >> 4)); }
        __syncthreads();
        if (w == 0) {
            int base = 0;
#pragma unroll
            for (int i = 0; i < 4; ++i) {
                const int j = lane + 64 * i;
                const bool nz = bmask[j] != 0ull;
                const unsigned long long b = __ballot(nz);
                const int pre = __builtin_popcountll(b & ((1ull << lane) - 1ull));
                if (nz) blist[base + pre] = j;
                base += __builtin_popcountll(b);
            }
            if (lane == 0) sel[0] = base;
        }
        __syncthreads();
        const int nl = sel[0];
        for (int rep = (MK_PROBE & (2048 | 16384)) ? 0 : 1; rep < 2; ++rep) {
        u16* st0 = (u16*)smem;
        u16* st1 = (u16*)(smem + 32768);
        float m[2] = {NEG, NEG}, l[2] = {0.f, 0.f};
        f32x4 o[4][2];
#pragma unroll
        for (int dt = 0; dt < 4; ++dt) { o[dt][0] = f32x4{0.f, 0.f, 0.f, 0.f}; o[dt][1] = f32x4{0.f, 0.f, 0.f, 0.f}; }
        u32x4 RA[4], RB[4];
        auto gloadS = [&](int st, u32x4 (&R)[4]) {
            const int j0 = blist[min(2 * st, nl - 1)], j1 = blist[min(2 * st + 1, nl - 1)];
            nsa_load_tile(p.Ks + ((size_t)g * S_ + (size_t)j0 * 64) * 64, R[0]);
            nsa_load_tile(p.VsT + ((size_t)g * 256 + j0) * 4096, R[1]);
            nsa_load_tile(p.Ks + ((size_t)g * S_ + (size_t)j1 * 64) * 64, R[2]);
            nsa_load_tile(p.VsT + ((size_t)g * 256 + j1) * 4096, R[3]);
        };
        auto storeS = [&](u16* stg, const u32x4 (&R)[4]) {
            nsa_store_k(stg, R[0]); nsa_store_v(stg + 4096, R[1]); nsa_store_k(stg + 8192, R[2]); nsa_store_v(stg + 12288, R[3]);
        };
        auto sel_rt = [&](auto RT, const u16* Kb, const u16* Vb, int j, unsigned long long mk) {
            constexpr int rt = decltype(RT)::value;
            f32x4 s[4];
#pragma unroll
            for (int kt = 0; kt < 4; ++kt) {
                const int krow = 32 * (kt >> 1) + 8 * (lr >> 2) + 4 * (kt & 1) + (lr & 3);
                s[kt] = f32x4{0.f, 0.f, 0.f, 0.f};
#pragma unroll
                for (int ks = 0; ks < 2; ++ks) s[kt] = MFMA16(ldf(Kb + krow * LDT + (((ks * 4 + q) ^ swzK(krow)) << 3)), qf[rt][ks], s[kt]);
            }
            __builtin_amdgcn_sched_group_barrier(0x100, 4, 0);
#pragma unroll
            for (int i = 0; i < 8; ++i) {
                __builtin_amdgcn_sched_group_barrier(0x008, 1, 0);
                if (i + 4 < 8) __builtin_amdgcn_sched_group_barrier(0x100, 1, 0);
            }
            const bool mine = ((mk >> (8 * w + 4 * rt + (lr >> 2))) & 1ull) != 0ull;
            float mx = NEG;
            if (j == cur) {
                const int dlim = mine ? (tokL[rt] - j * 64 - 8 * q) : -1;
#pragma unroll
                for (int kt = 0; kt < 4; ++kt)
#pragma unroll
                    for (int r = 0; r < 4; ++r) {
                        const float v = (32 * (kt >> 1) + 4 * (kt & 1) + r <= dlim) ? s[kt][r] * SC : NEG;
                        s[kt][r] = v; mx = fmaxf(mx, v);
                    }
                mx = qmax(mx);
                const float mn = fmaxf(m[rt], mx), alpha = ex2(m[rt] - mn);
                float rs = 0.f;
#pragma unroll
                for (int kt = 0; kt < 4; ++kt)
#pragma unroll
                    for (int r = 0; r < 4; ++r) {
                        const float v = s[kt][r];
                        const float pv = (v > -1e29f) ? ex2(v - mn) : 0.f;
                        s[kt][r] = pv; rs += pv;
                    }
                l[rt] = l[rt] * alpha + rs; m[rt] = mn;
#pragma unroll
                for (int dt = 0; dt < 4; ++dt) o[dt][rt] *= alpha;
            } else {
#pragma unroll
                for (int kt = 0; kt < 4; ++kt) mx = fmaxf(fmaxf(mx, fmaxf(s[kt][0], s[kt][1])), fmaxf(s[kt][2], s[kt][3]));
                mx = mine ? mx * SC : NEG;
                mx = qmax(mx);
                const float mn = fmaxf(m[rt], mx), alpha = ex2(m[rt] - mn);
                const float nb = mine ? -mn : NEG;
                float rs = 0.f;
#pragma unroll
                for (int kt = 0; kt < 4; ++kt)
#pragma unroll
                    for (int r = 0; r < 4; ++r) { const float pv = ex2(fmaf(s[kt][r], SC, nb)); s[kt][r] = pv; rs += pv; }
                l[rt] = l[rt] * alpha + rs; m[rt] = mn;
#pragma unroll
                for (int dt = 0; dt < 4; ++dt) o[dt][rt] *= alpha;
            }
#pragma unroll
            for (int ks2 = 0; ks2 < 2; ++ks2) {
                const bf16x8 pb = packf(s[2 * ks2], s[2 * ks2 + 1]);
#pragma unroll
                for (int dt = 0; dt < 4; ++dt) o[dt][rt] = MFMA16(ldf(Vb + (16 * dt + lr) * LDT + (((ks2 * 4 + q) ^ (lr & 7)) << 3)), pb, o[dt][rt]);
            }
            __builtin_amdgcn_sched_group_barrier(0x100, 4, 0);
#pragma unroll
            for (int i = 0; i < 8; ++i) {
                __builtin_amdgcn_sched_group_barrier(0x008, 1, 0);
                if (i + 4 < 8) __builtin_amdgcn_sched_group_barrier(0x100, 1, 0);
            }
        };
        auto compute = [&](const u16* Kb, const u16* Vb, int j) {
            if ((MK_PROBE & 16384) && rep == 0) return;
            const unsigned long long mk = bmask[j];
            const unsigned wb = (unsigned)(mk >> (8 * w)) & 0xffu;
            if (wb & 0x0fu) sel_rt(IC<0>{}, Kb, Vb, j, mk);
            if (wb & 0xf0u) sel_rt(IC<1>{}, Kb, Vb, j, mk);
        };
        auto computeS = [&](const u16* stg, int st) {
            compute(stg, stg + 4096, blist[2 * st]);
            if (2 * st + 1 < nl) compute(stg + 8192, stg + 12288, blist[2 * st + 1]);
        };
        const int nst = (nl + 1) >> 1;
        const int nstm = nst;
        gloadS(0, RA);
        storeS(st0, RA);
        gloadS(1, RB);
        __syncthreads();
        for (int st = 0; st < nstm; st += 2) {
            gloadS(st + 2, RA);
            if (st < nst) computeS(st0, st);
            storeS(st1, RB);
            __syncthreads();
            gloadS(st + 3, RB);
            if (st + 1 < nst) computeS(st1, st + 1);
            storeS(st0, RA);
            __syncthreads();
        }
#pragma unroll
        for (int rt = 0; rt < 2; ++rt) {
            float lt = l[rt]; lt = qsum(lt);
            const float f = (rep == 1) ? gs[rt] / fmaxf(lt, 1e-37f) : 0.f;
#pragma unroll
            for (int dt = 0; dt < 4; ++dt) tot[dt][rt] += o[dt][rt] * f;
        }
        __syncthreads();
        }
    }

#pragma unroll
    for (int rt = 0; rt < 2; ++rt) {
        const int head = 4 * g + (lr & 3);
#pragma unroll
        for (int dt = 0; dt < 4; ++dt) {
            const size_t off = (size_t)tokL[rt] * 512 + head * 64 + 16 * dt + 4 * q;
            const u32x2 z = *(const u32x2*)(p.SZn + off);
            u32x2 o2;
            o2[0] = pack2(tot[dt][rt][0] * bflo(z[0]), tot[dt][rt][1] * bfhi(z[0]));
            o2[1] = pack2(tot[dt][rt][2] * bflo(z[1]), tot[dt][rt][3] * bfhi(z[1]));
            *(u32x2*)(p.Qn + off) = o2;
        }
    }
    __syncthreads();
}


DI void ret_item(const Params& p, int n, int h, bool dowrite) {
    const int lane = TID() & 63, w = TID() >> 6, lr = lane & 15, q = lane >> 4;
    const float lg2 = logf(1.0f - exp2f(-5.0f - (float)h)) * LOG2E;
    const u16* rbase = p.H + (((size_t)n * 4 + h) * 256) * 128;
    const u16* kbase = p.Kr + ((size_t)h * S_ + n * 128) * 128;
    const u16* vbase = p.VrT + (((size_t)h * 128 + n) * 256) * 128;
    const u16* rlane = rbase + lr * 128 + 8 * q;
    const u16* vlane = vbase + lr * 128 + 8 * q;
#pragma unroll 1
    for (int it = 0; it < 2; ++it) {
        const int i = 32 * w + 16 * it + lr;
        bf16x8 qf[4];
#pragma unroll
        for (int ks = 0; ks < 4; ++ks) qf[ks] = ldf(p.Qr + ((size_t)h * S_ + n * 128 + i) * 128 + 32 * ks + 8 * q);
        f32x4 acc[16];
#pragma unroll
        for (int et = 0; et < 16; ++et) acc[et] = f32x4{0.f, 0.f, 0.f, 0.f};
#pragma unroll
        for (int et = 0; et < 16; ++et) {
            const u16* pe = rlane + et * 16 * 128; asm volatile("" : "+v"(pe));
#pragma unroll
            for (int ks = 0; ks < 4; ++ks) acc[et] = MFMA16(ldf(pe + 32 * ks), qf[ks], acc[et]);
        }
        {
            const float qd = ex2((float)(i + 1) * lg2);
#pragma unroll
            for (int et = 0; et < 16; ++et) acc[et] *= qd;
        }
        for (int jk = 0; jk <= w; ++jk) {
            f32x4 s[2];
#pragma unroll
            for (int jj = 0; jj < 2; ++jj) {
                const int krow = 32 * jk + 8 * (lr >> 2) + 4 * jj + (lr & 3);
                s[jj] = f32x4{0.f, 0.f, 0.f, 0.f};
#pragma unroll
                for (int ks = 0; ks < 4; ++ks) s[jj] = MFMA16(ldf(kbase + (size_t)krow * 128 + 32 * ks + 8 * q), qf[ks], s[jj]);
            }
#pragma unroll
            for (int jj = 0; jj < 2; ++jj)
#pragma unroll
                for (int r = 0; r < 4; ++r) {
                    const int j = 32 * jk + 8 * q + 4 * jj + r;
                    s[jj][r] = (i >= j) ? s[jj][r] * ex2((float)(i - j) * lg2) : 0.f;
                }
            const bf16x8 pb = packf(s[0], s[1]);
#pragma unroll
            for (int et = 0; et < 16; ++et) {
                const u16* pe = vlane + et * 16 * 128 + 32 * jk; asm volatile("" : "+v"(pe));
                acc[et] = MFMA16(ldf(pe), pb, acc[et]);
            }
        }
        float sm = 0.f;
#pragma unroll
        for (int et = 0; et < 16; ++et) sm += acc[et][0] + acc[et][1] + acc[et][2] + acc[et][3];
        sm = qsum(sm);
        const float mu = sm * (1.f / 256.f);
        float vs = 0.f;
#pragma unroll
        for (int et = 0; et < 16; ++et)
#pragma unroll
            for (int r = 0; r < 4; ++r) { const float d = acc[et][r] - mu; vs += d * d; }
        vs = qsum(vs);
        const float rs = rsqrtf(vs * (1.f / 256.f) + 1e-6f);
        u16* zlane = p.SZr + ((size_t)n * 128 + i) * 1024 + h * 256 + 4 * q;
#pragma unroll
        for (int et = 0; et < 16; ++et) {
            u16* zp = zlane + 16 * et; asm volatile("" : "+v"(zp));
            const u32x2 z = *(const u32x2*)zp;
            u32x2 o2;
            o2[0] = pack2((acc[et][0] - mu) * rs * bflo(z[0]), (acc[et][1] - mu) * rs * bfhi(z[0]));
            o2[1] = pack2((acc[et][2] - mu) * rs * bflo(z[1]), (acc[et][3] - mu) * rs * bfhi(z[1]));
            if (dowrite) *(u32x2*)zp = o2;
        }
    }
}

DI void p5_tile(const Params& p, int t, unsigned char* smem_all) {
    const int tid = threadIdx.x, team = TEAM();
    const int nt = t >> 6, mt = t & 63;
    u16* Mg = p.Qr;
    const float* cst = (const float*)(smem_all + team * 69632);
    f32x4 acc[8][4];
    zero_acc8(acc);
    gemm256_main(p.Qn + (size_t)(mt * 256 + (tid >> 3)) * 512 + (tid & 7) * 8, (size_t)64 * 512,
                 p.WnoT + (size_t)(nt * 256 + (tid >> 3)) * 512 + (tid & 7) * 8, (size_t)64 * 512, 8, (u16*)smem_all, acc);
#pragma unroll
    for (int pass = 0; pass < 2; ++pass) {
        stage_acc8(smem_all, pass, acc);
        __syncthreads();
        const int tok0 = mt * 256 + pass * 128, c0 = (nt * 2 + team) * 128;
        emit_rows(cst, [&](int row, int c8, const float* v) {
            const u32x4 gm = ld16(p.Ma + (size_t)(tok0 + row) * 1024 + c0 + c8 * 8);
            float o[8];
            o[0] = v[0] * bflo(gm[0]); o[1] = v[1] * bfhi(gm[0]); o[2] = v[2] * bflo(gm[1]); o[3] = v[3] * bfhi(gm[1]);
            o[4] = v[4] * bflo(gm[2]); o[5] = v[5] * bfhi(gm[2]); o[6] = v[6] * bflo(gm[3]); o[7] = v[7] * bfhi(gm[3]);
            *(u32x4*)(Mg + (size_t)(tok0 + row) * 1024 + c0 + c8 * 8) = pack8(o); });
        __syncthreads();
    }
    zero_acc8(acc);
    gemm256_main(p.SZr + (size_t)(mt * 256 + (tid >> 3)) * 1024 + (tid & 7) * 8, (size_t)64 * 1024,
                 p.WroT + (size_t)(nt * 256 + (tid >> 3)) * 1024 + (tid & 7) * 8, (size_t)64 * 1024, 16, (u16*)smem_all, acc);
#pragma unroll
    for (int pass = 0; pass < 2; ++pass) {
        stage_acc8(smem_all, pass, acc);
        __syncthreads();
        const int tok0 = mt * 256 + pass * 128, c0 = (nt * 2 + team) * 128;
        emit_rows(cst, [&](int row, int c8, const float* v) {
            u16* mp = Mg + (size_t)(tok0 + row) * 1024 + c0 + c8 * 8;
            const u32x4 gm = ld16(p.Mb + (size_t)(tok0 + row) * 1024 + c0 + c8 * 8);
            const u32x4 ya = ld16(mp);
            float o[8];
            o[0] = bflo(ya[0]) + v[0] * bflo(gm[0]); o[1] = bfhi(ya[0]) + v[1] * bfhi(gm[0]); o[2] = bflo(ya[1]) + v[2] * bflo(gm[1]); o[3] = bfhi(ya[1]) + v[3] * bfhi(gm[1]);
            o[4] = bflo(ya[2]) + v[4] * bflo(gm[2]); o[5] = bfhi(ya[2]) + v[5] * bfhi(gm[2]); o[6] = bflo(ya[3]) + v[6] * bflo(gm[3]); o[7] = bfhi(ya[3]) + v[7] * bfhi(gm[3]);
            *(u32x4*)mp = pack8(o); });
        __syncthreads();
    }
}

DI void p6_tile(const Params& p, int t, unsigned char* smem_all) {
    const int tid = threadIdx.x, team = TEAM();
    const int nt = t >> 6, mt = t & 63;
    const u16* Mg = p.Qr; u16* Y2 = p.VrT;
    f32x4 acc[8][4]; zero_acc8(acc);
    gemm256_main(Mg + (size_t)(mt * 256 + (tid >> 3)) * 1024 + (tid & 7) * 8, (size_t)64 * 1024,
                 p.WoutT + (size_t)(nt * 256 + (tid >> 3)) * 1024 + (tid & 7) * 8, (size_t)64 * 1024, 16, (u16*)smem_all, acc);
    const float* cst = (const float*)(smem_all + team * 69632);
#pragma unroll
    for (int pass = 0; pass < 2; ++pass) {
        stage_acc8(smem_all, pass, acc);
        __syncthreads();
        const int tok0 = mt * 256 + pass * 128, nt128 = nt * 2 + team;
        emit_rows(cst, [&](int row, int c8, const float* v) {
            *(u32x4*)(Y2 + (size_t)(tok0 + row) * 1024 + nt128 * 128 + c8 * 8) = pack8(v);
            float ss = 0.f;
#pragma unroll
            for (int k = 0; k < 8; ++k) ss += v[k] * v[k];
            ss += __shfl_xor(ss, 1); ss += __shfl_xor(ss, 2); ss += __shfl_xor(ss, 4); ss += __shfl_xor(ss, 8);
            if (c8 == 0) p.rowss[(size_t)(tok0 + row) * 8 + nt128] = ss; });
        __syncthreads();
    }
}

DI void p7_all(const Params& p) {
    const u16* Y2 = p.VrT;
    const size_t n4 = (size_t)S_ * 256;
    for (size_t i = (size_t)blockIdx.x * 512 + threadIdx.x; i < n4; i += (size_t)gridDim.x * 512) {
        const size_t row = i >> 8; const int c4 = (int)(i & 255);
        const float4 a = *(const float4*)(p.rowss + row * 8), b = *(const float4*)(p.rowss + row * 8 + 4);
        const float ss = ((a.x + a.y) + (a.z + a.w)) + ((b.x + b.y) + (b.z + b.w));
        const float rs = rsqrtf(ss * (1.f / 1024.f) + 1e-6f);
        const float4 xv = *(const float4*)(p.x + i * 4);
        const float4 gv = *(const float4*)(p.norm_post + c4 * 4);
        const u32x2 y = *(const u32x2*)(Y2 + i * 4);
        float4 o;
        o.x = xv.x + bflo(y[0]) * rs * gv.x; o.y = xv.y + bfhi(y[0]) * rs * gv.y;
        o.z = xv.z + bflo(y[1]) * rs * gv.z; o.w = xv.w + bfhi(y[1]) * rs * gv.w;
        *(float4*)(p.out + i * 4) = o;
    }
}

#ifndef MK_PROBE
#define MK_PROBE 0
#endif
constexpr size_t al256(size_t x) { return (x + 255) & ~(size_t)255; }
constexpr size_t O_BAR   = 0;
constexpr size_t O_WINT  = O_BAR   + 16384;
constexpr size_t O_WNOT  = O_WINT  + al256((size_t)NPAD_ * 1024 * 2);
constexpr size_t O_WROT  = O_WNOT  + (size_t)1024 * 512 * 2;
constexpr size_t O_WOUTT = O_WROT  + (size_t)1024 * 1024 * 2;
constexpr size_t O_W1T0  = O_WOUTT + (size_t)1024 * 1024 * 2;
constexpr size_t O_W1T1  = O_W1T0  + (size_t)256 * 2048 * 2;
constexpr size_t O_W2T0  = O_W1T1  + (size_t)256 * 2048 * 2;
constexpr size_t O_W2T1  = O_W2T0  + (size_t)64 * 256 * 2;
constexpr size_t O_BPART = O_W2T1  + (size_t)64 * 256 * 2;
constexpr size_t O_ROPEN = O_BPART + (size_t)2 * 16 * 256 * 4;
constexpr size_t O_ROPER = O_ROPEN + (size_t)S_ * 8 * 8;
constexpr size_t O_H     = O_ROPER + (size_t)S_ * 64 * 8;
constexpr size_t O_QN    = O_H     + (size_t)S_ * 1024 * 2;
constexpr size_t O_RAW0  = O_QN    + (size_t)S_ * 512 * 2;
constexpr size_t O_RAW1  = O_RAW0  + (size_t)S_ * 128 * 2;
constexpr size_t O_KS    = O_RAW1  + (size_t)S_ * 128 * 2;
constexpr size_t O_VST   = O_KS    + (size_t)2 * S_ * 64 * 2;
constexpr size_t O_KW    = O_VST   + (size_t)2 * S_ * 64 * 2;
constexpr size_t O_VWT   = O_KW    + (size_t)2 * S_ * 64 * 2;
constexpr size_t O_SZN   = O_VWT   + (size_t)2 * S_ * 64 * 2;
constexpr size_t O_QR    = O_SZN   + (size_t)S_ * 512 * 2;
constexpr size_t O_KR    = O_QR    + (size_t)4 * S_ * 128 * 2;
constexpr size_t O_KRT   = O_KR    + (size_t)4 * S_ * 128 * 2;
constexpr size_t O_VRT   = O_KRT   + (size_t)4 * S_ * 128 * 2;
constexpr size_t O_SZR   = O_VRT   + (size_t)4 * S_ * 256 * 2;
constexpr size_t O_GN    = O_SZR   + (size_t)S_ * 1024 * 2;
constexpr size_t O_SLAB  = O_GN    + (size_t)S_ * 24 * 4;
constexpr size_t O_KC    = O_SLAB  + (size_t)4 * 2 * 2048 * 256 * 4;
constexpr size_t O_VCT   = O_KC    + (size_t)2 * 1024 * 64 * 2;
constexpr size_t O_ROWSS = O_VCT   + (size_t)2 * 1024 * 64 * 2;
constexpr size_t WS_BYTES = O_ROWSS + (size_t)S_ * 8 * 4;

struct KArgs {
    const float *x, *norm_pre, *w_in, *b_gate, *pe_k, *w1_k, *w2_k, *pe_v, *w1_v, *w2_v, *w_nsa_o, *w_ret_o, *w_out, *norm_post;
    float* out; char* ws; int use_cg; int probe;
};

__global__ void __launch_bounds__(512, 2) fwd_megakernel(KArgs ka) {
    Params p;
    p.x = ka.x; p.norm_pre = ka.norm_pre; p.w_in = ka.w_in; p.b_gate = ka.b_gate; p.pe_k = ka.pe_k; p.w1_k = ka.w1_k; p.w2_k = ka.w2_k;
    p.pe_v = ka.pe_v; p.w1_v = ka.w1_v; p.w2_v = ka.w2_v; p.w_nsa_o = ka.w_nsa_o; p.w_ret_o = ka.w_ret_o; p.w_out = ka.w_out; p.norm_post = ka.norm_post;
    p.out = ka.out; p.use_cg = ka.use_cg; p.probe = ka.probe;
    {
        char* ws = ka.ws;
        p.bar = (unsigned*)(ws + O_BAR);
        p.WinT = (u16*)(ws + O_WINT); p.WnoT = (u16*)(ws + O_WNOT); p.WroT = (u16*)(ws + O_WROT); p.WoutT = (u16*)(ws + O_WOUTT);
        p.W1T[0] = (u16*)(ws + O_W1T0); p.W1T[1] = (u16*)(ws + O_W1T1); p.W2T[0] = (u16*)(ws + O_W2T0); p.W2T[1] = (u16*)(ws + O_W2T1);
        p.bpart = (float*)(ws + O_BPART); p.ropeN = (float2*)(ws + O_ROPEN); p.ropeR = (float2*)(ws + O_ROPER);
        p.H = (u16*)(ws + O_H); p.Qn = (u16*)(ws + O_QN); p.Raw[0] = (u16*)(ws + O_RAW0); p.Raw[1] = (u16*)(ws + O_RAW1);
        p.Ks = (u16*)(ws + O_KS); p.VsT = (u16*)(ws + O_VST); p.Kw = (u16*)(ws + O_KW); p.VwT = (u16*)(ws + O_VWT);
        p.SZn = (u16*)(ws + O_SZN); p.Qr = (u16*)(ws + O_QR); p.Kr = (u16*)(ws + O_KR); p.KrT = (u16*)(ws + O_KRT); p.VrT = (u16*)(ws + O_VRT);
        p.SZr = (u16*)(ws + O_SZR); p.Gn = (float*)(ws + O_GN); p.slab = (float*)(ws + O_SLAB); p.Kc = (u16*)(ws + O_KC); p.VcT = (u16*)(ws + O_VCT);
        p.rowss = (float*)(ws + O_ROWSS);
        p.Ma = (u16*)ka.out; p.Mb = (u16*)ka.out + (size_t)S_ * 1024;
    }
    __shared__ __attribute__((aligned(16))) unsigned char smem_all[2 * 69632];
    __shared__ int xch[2];
    const int team = TEAM();
    unsigned char* smem = smem_all + team * 69632;
    __shared__ uint4 xb_words;
    if (threadIdx.x == 0) xb_words = make_uint4(0u, 0u, 0u, 0u);
    __syncthreads();
    XcdBarrier b = xcd_barrier_post(p.bar, (volatile LAS unsigned*)&xb_words);
    const int G = gridDim.x, B = blockIdx.x;
    __shared__ unsigned long long ts[12]; int tsn = 1;
    if (MK_TS >= 0 && threadIdx.x == 0) ts[0] = __builtin_amdgcn_s_memrealtime();
    if (MK_TS == 201 && threadIdx.x == 0) atomicMax((unsigned long long*)(p.bar + 66), ~(unsigned long long)__builtin_amdgcn_s_memrealtime());
#define GRID_SYNC() do { if (p.use_cg) cg::this_grid().sync(); else { xcd_barrier(b); if (MK_PROBE & 32768) xcd_barrier(b); } if (MK_TS >= 0 && threadIdx.x == 0) ts[tsn++] = __builtin_amdgcn_s_memrealtime(); } while (0)

    for (int u = 2 * B + team; u < P0_UNITS; u += 2 * G) { if (u >= 896 && u < 1536) continue; p0_unit(p, u, smem); }
    GRID_SYNC();
    for (int t = B; t < 28 * 64; t += G) p1_tile256(p, t, smem_all);
    GRID_SYNC();
    if (G == 256) {
        const int T = 2 * B + team;
        if (T < 256) { p2_unit(p, T, smem); p2_unit(p, 256 + 768 + T, smem); }
        else { for (int k = 0; k < 3; ++k) p2_unit(p, 256 + 3 * (T - 256) + k, smem); }
    } else {
        for (int u = 2 * B + team; u < P2_UNITS; u += 2 * G) p2_unit(p, u, smem);
    }
    for (int u = 896 + 2 * B + team; u < 1536; u += 2 * G) p0_unit(p, u, smem);
    GRID_SYNC();
    for (int u = 2 * B + team; u < P3_UNITS; u += 2 * G) p3_unit(p, u, smem);
    p3_scan(p, false);
    GRID_SYNC();
    for (int i = B; i < 512; i += G) {
        const int r = i / G, k = i - r * G;
        nsa_item(p, (r & 1) ? (k >> 1) : 255 - (k >> 1), k & 1, smem_all);
    }
    for (int u = 2 * B + team; u < 512; u += 2 * G) ret_item(p, u >> 2, u & 3, true);
    GRID_SYNC();
    for (int t = B; t < 256; t += G) p5_tile(p, t, smem_all);
    GRID_SYNC();
    for (int t = B; t < 256; t += G) p6_tile(p, t, smem_all);
    GRID_SYNC();
    p7_all(p);
    if (MK_TS >= 0) {
        GRID_SYNC();
        __syncthreads();
        if (B == 0) {
            const unsigned long long d = (MK_TS == 201) ? (ts[0] - ~__hip_atomic_load((unsigned long long*)(p.bar + 66), __ATOMIC_RELAXED, __HIP_MEMORY_SCOPE_AGENT)) / 4ull : (MK_TS == 200) ? (ts[8] - ts[0]) / 16ull : (MK_TS >= 100) ? 10000ull : (ts[(MK_TS + 1) % 12] - ts[MK_TS % 12]) / 4ull;
            const int K = (int)(d > 60000ull ? 60000ull : d);
            for (int i = threadIdx.x; i < K; i += 512) p.out[(size_t)i * 64 + 7] += 0.2f;
        }
    }
}

extern "C" void kernel_launch(void* const* d_in, const int* in_sizes, int n_in, void* d_out, int out_size,
                              void* d_ws, size_t ws_size, hipStream_t stream) {
    static int grid_blocks = 0;
    if (!grid_blocks) {
        int dev = 0, cus = 0, per_cu = 0;
        (void)hipGetDevice(&dev);
        (void)hipDeviceGetAttribute(&cus, hipDeviceAttributeMultiprocessorCount, dev);
        (void)hipOccupancyMaxActiveBlocksPerMultiprocessor(&per_cu, fwd_megakernel, 512, 0);
        if (per_cu > 1) per_cu = 1;
        if (per_cu < 1) per_cu = 1;
        grid_blocks = cus * per_cu;
    }
    KArgs ka{};
    ka.x = (const float*)d_in[0]; ka.norm_pre = (const float*)d_in[1]; ka.w_in = (const float*)d_in[2]; ka.b_gate = (const float*)d_in[3];
    ka.pe_k = (const float*)d_in[4]; ka.w1_k = (const float*)d_in[5]; ka.w2_k = (const float*)d_in[6];
    ka.pe_v = (const float*)d_in[7]; ka.w1_v = (const float*)d_in[8]; ka.w2_v = (const float*)d_in[9];
    ka.w_nsa_o = (const float*)d_in[10]; ka.w_ret_o = (const float*)d_in[11]; ka.w_out = (const float*)d_in[12]; ka.norm_post = (const float*)d_in[13];
    ka.out = (float*)d_out; ka.ws = (char*)d_ws; ka.use_cg = 0; ka.probe = MK_PROBE;
    if (WS_BYTES > ws_size) { fprintf(stderr, "workspace too small: need %zu have %zu\n", (size_t)WS_BYTES, ws_size); return; }
    (void)hipMemsetAsync(d_ws, 0, XCD_BAR_WORDS * 4, stream);
    void* args[] = {&ka};
    hipError_t e = hipLaunchCooperativeKernel((void*)fwd_megakernel, dim3(grid_blocks), dim3(512), args, 0, stream);
    if (e != hipSuccess) fprintf(stderr, "cooperative launch failed: %s (grid %d)\n", hipGetErrorString(e), grid_blocks);
}
```

```cpp
#include <hip/hip_runtime.h>
#include <hip/hip_cooperative_groups.h>
#include <cstdio>
namespace cg = cooperative_groups;

#define DI __device__ __forceinline__
#define LAS __attribute__((address_space(3)))

#define XB_TMO      128
#define XB_XCNT(j)  (256  + 64 * (j))
#define XB_XSUB(j)  (1280 + 64 * (j))
#define XB_XGEN(j)  (2304 + 64 * (j))
#define XB_TOP      3328
#define XB_TOPGEN   3392
#define XCD_BAR_WORDS 3456
#define XB_SPIN_CAP (1u << 22)

DI unsigned xb_ld(unsigned* p)              { return __hip_atomic_load(p, __ATOMIC_RELAXED, __HIP_MEMORY_SCOPE_AGENT); }
DI unsigned xb_add(unsigned* p, unsigned v) { return __hip_atomic_fetch_add(p, v, __ATOMIC_RELAXED, __HIP_MEMORY_SCOPE_AGENT); }
DI unsigned xb_xcc_id() { return (unsigned)__builtin_amdgcn_s_getreg((3 << 11) | 20) & 0xFu; }
#define XB_SPIN(cond, bar) do { unsigned _sp = 0; while (cond) { __builtin_amdgcn_s_sleep(1); \
    if ((++_sp & 255u) == 0u) { if (xb_ld(&(bar)[XB_TMO])) break; if (_sp > XB_SPIN_CAP) { atomicAdd(&(bar)[XB_TMO], 1u); break; } } } } while (0)

struct XcdBarrier { unsigned* bar; unsigned x; volatile LAS unsigned* st; };

DI XcdBarrier xcd_barrier_post(unsigned* bar, volatile LAS unsigned* st) {
    XcdBarrier b; b.bar = bar; b.x = xb_xcc_id(); b.st = st;
    if (threadIdx.x == 0) (void)xb_add(&bar[XB_XCNT(b.x)], 1u);
    return b;
}
DI void xcd_barrier_complete(unsigned* bar, unsigned x, unsigned& nloc, unsigned& nx) {
    const unsigned G = gridDim.x * gridDim.y * gridDim.z;
    unsigned sum, cnt, mine, sp = 0u;
    for (;;) {
        sum = 0u; cnt = 0u; mine = 0u;
#pragma unroll
        for (unsigned j = 0; j < 16; ++j) { const unsigned c = xb_ld(&bar[XB_XCNT(j)]); sum += c; cnt += (c > 0u) ? 1u : 0u; mine = (j == x) ? c : mine; }
        if (sum == G) break;
        __builtin_amdgcn_s_sleep(1);
        if ((++sp & 255u) == 0u) { if (xb_ld(&bar[XB_TMO])) break; if (sp > XB_SPIN_CAP) { atomicAdd(&bar[XB_TMO], 1u); break; } }
    }
    nloc = mine > 0u ? mine : 1u; nx = cnt > 0u ? cnt : 1u;
}
DI void xcd_barrier(const XcdBarrier& b) {
    asm volatile("s_waitcnt vmcnt(0)" ::: "memory");
    __syncthreads();
    if (threadIdx.x == 0) {
        unsigned* bar = b.bar;
        __builtin_amdgcn_s_waitcnt(0);
        unsigned nloc = b.st[0], nx = b.st[1];
        if (nloc == 0u) { xcd_barrier_complete(bar, b.x, nloc, nx); b.st[0] = nloc; b.st[1] = nx; }
        const unsigned old = xb_add(&bar[XB_XSUB(b.x)], 1u);
        const unsigned gen = old / nloc;
        if (old + 1u == (gen + 1u) * nloc) {
            __builtin_amdgcn_fence(__ATOMIC_RELEASE, "agent");
            asm volatile("s_waitcnt vmcnt(0)" ::: "memory");
            const unsigned og = xb_add(&bar[XB_TOP], 1u);
            const unsigned tg = og / nx;
            if (og + 1u == (tg + 1u) * nx) xb_add(&bar[XB_TOPGEN], 1u);
            else XB_SPIN(xb_ld(&bar[XB_TOPGEN]) == tg, bar);
            __builtin_amdgcn_fence(__ATOMIC_ACQUIRE, "agent");
            xb_add(&bar[XB_XGEN(b.x)], 1u);
            asm volatile("s_waitcnt vmcnt(0)" ::: "memory");
        } else {
            XB_SPIN(xb_ld(&bar[XB_XGEN(b.x)]) == gen, bar);
            __builtin_amdgcn_fence(__ATOMIC_ACQUIRE, "agent");
            asm volatile("s_waitcnt vmcnt(0)" ::: "memory");
        }
    }
    __syncthreads();
}


#ifndef MK_PROBE
#define MK_PROBE 0
#endif
#define MK_TS -1
typedef unsigned short u16;
using bf16x8 = __attribute__((ext_vector_type(8))) short;
using f32x4  = __attribute__((ext_vector_type(4))) float;
using u32x4  = __attribute__((ext_vector_type(4))) unsigned;
using u32x2  = __attribute__((ext_vector_type(2))) unsigned;
typedef __attribute__((ext_vector_type(2))) __bf16 bf2_t;
#define MFMA16(a, b, c) __builtin_amdgcn_mfma_f32_16x16x32_bf16((a), (b), (c), 0, 0, 0)

constexpr int S_ = 16384, DM_ = 1024, NPAD_ = 7168;
constexpr int LDT = 64;
DI int swzA(int row) { return row & 7; }
DI int swzK(int row) { return (((row >> 3) & 3) << 1) | ((row >> 1) & 1); }
constexpr int TILE_ELEMS = 128 * LDT;
constexpr int CST = 132;
constexpr float LOG2E = 1.4426950408889634f;

template <int N> struct IC { static constexpr int value = N; };
DI int TID() { int t = threadIdx.x & 255; asm volatile("" : "+v"(t)); return t; }
DI int TEAM() { return __builtin_amdgcn_readfirstlane((int)(threadIdx.x >> 8)); }
DI unsigned pack2(float a, float b) { bf2_t v = {(__bf16)a, (__bf16)b}; return __builtin_bit_cast(unsigned, v); }
DI float bflo(unsigned u) { return __uint_as_float(u << 16); }
DI float bfhi(unsigned u) { return __uint_as_float(u & 0xffff0000u); }
DI u32x4 ld16(const u16* p) { return *(const u32x4*)p; }
DI bf16x8 ldf(const u16* p) { return *(const bf16x8*)p; }
DI u32x4 pack8(const float* v) { u32x4 r; r[0] = pack2(v[0], v[1]); r[1] = pack2(v[2], v[3]); r[2] = pack2(v[4], v[5]); r[3] = pack2(v[6], v[7]); return r; }
DI bf16x8 packf(f32x4 a, f32x4 b) { u32x4 r; r[0] = pack2(a[0], a[1]); r[1] = pack2(a[2], a[3]); r[2] = pack2(b[0], b[1]); r[3] = pack2(b[2], b[3]); return __builtin_bit_cast(bf16x8, r); }
DI float ex2(float x) { return __builtin_amdgcn_exp2f(x); }
DI float sigmoidf_(float x) { return 1.f / (1.f + __expf(-x)); }
#define DPP_U(v, ctrl) ((unsigned)__builtin_amdgcn_update_dpp(0, (int)(v), (ctrl), 0xf, 0xf, true))
DI unsigned wave_umax(unsigned v) {
    v = max(v, DPP_U(v, 0xB1));
    v = max(v, DPP_U(v, 0x4E));
    v = max(v, DPP_U(v, 0x141));
    v = max(v, DPP_U(v, 0x140));
    auto r = __builtin_amdgcn_permlane16_swap(v, v, false, false);
    v = max(r[0], r[1]);
    auto s = __builtin_amdgcn_permlane32_swap(v, v, false, false);
    v = max(s[0], s[1]);
    return (unsigned)__builtin_amdgcn_readfirstlane((int)v);
}
DI float qmax(float x) {
    unsigned u = __float_as_uint(x);
    auto r = __builtin_amdgcn_permlane16_swap(u, u, false, false);
    x = fmaxf(__uint_as_float(r[0]), __uint_as_float(r[1]));
    u = __float_as_uint(x);
    auto s = __builtin_amdgcn_permlane32_swap(u, u, false, false);
    return fmaxf(__uint_as_float(s[0]), __uint_as_float(s[1]));
}
DI float qsum(float x) {
    unsigned u = __float_as_uint(x);
    auto r = __builtin_amdgcn_permlane16_swap(u, u, false, false);
    x = __uint_as_float(r[0]) + __uint_as_float(r[1]);
    u = __float_as_uint(x);
    auto s = __builtin_amdgcn_permlane32_swap(u, u, false, false);
    return __uint_as_float(s[0]) + __uint_as_float(s[1]);
}
DI float wave_max(float v) {
#pragma unroll
    for (int o = 32; o >= 1; o >>= 1) v = fmaxf(v, __shfl_xor(v, o));
    return v;
}
DI float wave_sum(float v) {
#pragma unroll
    for (int o = 32; o >= 1; o >>= 1) v += __shfl_xor(v, o);
    return v;
}

struct Params {
    const float *x, *norm_pre, *w_in, *b_gate, *pe_k, *w1_k, *w2_k, *pe_v, *w1_v, *w2_v, *w_nsa_o, *w_ret_o, *w_out, *norm_post;
    float* out;
    unsigned* bar;
    u16 *WinT, *WnoT, *WroT, *WoutT, *W1T[2], *W2T[2];
    float* bpart;
    float2 *ropeN, *ropeR;
    u16 *H;
    u16 *Qn;
    u16 *Raw[2];
    u16 *Ks, *VsT, *Kw, *VwT;
    u16 *SZn;
    u16 *Qr, *Kr;
    u16 *KrT;
    u16 *VrT;
    u16 *SZr;
    u16 *Ma, *Mb;
    float* Gn;
    float* slab;
    u16 *Kc, *VcT;
    float* rowss;
    int use_cg; int probe;
};

struct GemmPre { u32x4 ra[4], rb[4]; };
DI void gemm128_prefetch(const u16* a0, size_t a_r32, const u16* b0, size_t b_r32, GemmPre& pre) {
#pragma unroll
    for (int i = 0; i < 4; ++i) { pre.ra[i] = ld16(a0 + i * a_r32); pre.rb[i] = ld16(b0 + i * b_r32); }
}
DI void gemm128_main(const u16* a0, size_t a_r32, int astep, const u16* b0, size_t b_r32, int bstep, int nk,
                     u16* lds, f32x4 (&acc)[4][4], const GemmPre* pre = nullptr) {
    const int tid = TID(), lane = tid & 63, w = tid >> 6;
    const int wr = w >> 1, wc = w & 1, lr = lane & 15, q = lane >> 4;
    const int wofs = (tid >> 3) * LDT + (((tid & 7) ^ swzA(tid >> 3)) << 3);
    u32x4 ra0[4], rb0[4], ra1[4], rb1[4];
    auto gl = [&](int kt, u32x4 (&ra)[4], u32x4 (&rb)[4]) {
        const int k = kt < nk ? kt : nk - 1;
        const u16* ap = a0 + (size_t)k * astep; const u16* bp = b0 + (size_t)k * bstep;
#pragma unroll
        for (int i = 0; i < 4; ++i) { ra[i] = ld16(ap + i * a_r32); rb[i] = ld16(bp + i * b_r32); }
    };
    auto st = [&](u16* buf, const u32x4 (&ra)[4], const u32x4 (&rb)[4]) {
#pragma unroll
        for (int i = 0; i < 4; ++i) {
            *(u32x4*)(buf + wofs + i * 32 * LDT) = ra[i];
            *(u32x4*)(buf + TILE_ELEMS + wofs + i * 32 * LDT) = rb[i];
        }
    };
    auto mm = [&](const u16* As) {
        const u16* Bs = As + TILE_ELEMS;
#pragma unroll
        for (int ks = 0; ks < 2; ++ks) {
            bf16x8 af[4], bfr[4];
#pragma unroll
            for (int t = 0; t < 4; ++t) {
                af[t]  = ldf(As + (64 * wr + 16 * t + lr) * LDT + (((ks * 4 + q) ^ (lr & 7)) << 3));
                bfr[t] = ldf(Bs + (64 * wc + 16 * t + lr) * LDT + (((ks * 4 + q) ^ (lr & 7)) << 3));
            }
#pragma unroll
            for (int ti = 0; ti < 4; ++ti)
#pragma unroll
                for (int tj = 0; tj < 4; ++tj) acc[ti][tj] = MFMA16(af[ti], bfr[tj], acc[ti][tj]);
        }
    };
    u16* buf0 = lds; u16* buf1 = lds + 2 * TILE_ELEMS;
    if (pre) {
#pragma unroll
        for (int i = 0; i < 4; ++i) { ra0[i] = pre->ra[i]; rb0[i] = pre->rb[i]; }
    } else gl(0, ra0, rb0);
    st(buf0, ra0, rb0);
    gl(1, ra1, rb1);
    __syncthreads();
    for (int kt = 0; kt < nk; kt += 2) {
        gl(kt + 2, ra0, rb0);
        __builtin_amdgcn_sched_barrier(0);
        mm(buf0);
        __builtin_amdgcn_sched_barrier(0);
        st(buf1, ra1, rb1);
        __syncthreads();
        gl(kt + 3, ra1, rb1);
        __builtin_amdgcn_sched_barrier(0);
        mm(buf1);
        __builtin_amdgcn_sched_barrier(0);
        st(buf0, ra0, rb0);
        __syncthreads();
    }
}
DI void gemm256_main(const u16* a0, size_t a_r64, const u16* b0, size_t b_r64, int nk, u16* lds, f32x4 (&acc)[8][4]) {
    int tid = threadIdx.x; asm volatile("" : "+v"(tid));
    const int lane = tid & 63, w = tid >> 6, wr = w >> 2, wc = w & 3, lr = lane & 15, q = lane >> 4;
    const int wofs = (tid >> 3) * 64 + (((tid & 7) ^ ((tid >> 3) & 7)) << 3);
    u32x4 ra[4], rb[4];
    auto gl = [&](int kt) {
        const int k = kt < nk ? kt : nk - 1;
#pragma unroll
        for (int i = 0; i < 4; ++i) { ra[i] = ld16(a0 + (size_t)k * 64 + i * a_r64); rb[i] = ld16(b0 + (size_t)k * 64 + i * b_r64); }
    };
    auto st = [&](u16* buf) {
#pragma unroll
        for (int i = 0; i < 4; ++i) { *(u32x4*)(buf + wofs + i * 4096) = ra[i]; *(u32x4*)(buf + 16384 + wofs + i * 4096) = rb[i]; }
    };
    auto ktile = [&](const u16* As, u16* nxt) {
        const u16* Bs = As + 16384;
        const int co0 = (q ^ (lr & 7)) << 3, co1 = ((4 + q) ^ (lr & 7)) << 3;
        bf16x8 b0f[4], b1f[4], a0f[8], a1f[8];
#pragma unroll
        for (int t = 0; t < 4; ++t) b0f[t] = ldf(Bs + (64 * wc + 16 * t + lr) * 64 + co0);
#pragma unroll
        for (int t = 0; t < 3; ++t) a0f[t] = ldf(As + (128 * wr + 16 * t + lr) * 64 + co0);
#pragma unroll
        for (int ti = 0; ti < 8; ++ti) {
            if (ti + 3 < 8) a0f[ti + 3] = ldf(As + (128 * wr + 16 * (ti + 3) + lr) * 64 + co0);
            if (ti == 5) { b1f[0] = ldf(Bs + (64 * wc + lr) * 64 + co1); b1f[1] = ldf(Bs + (64 * wc + 16 + lr) * 64 + co1); }
            if (ti == 6) { b1f[2] = ldf(Bs + (64 * wc + 32 + lr) * 64 + co1); b1f[3] = ldf(Bs + (64 * wc + 48 + lr) * 64 + co1); }
            if (ti == 7) { a1f[0] = ldf(As + (128 * wr + lr) * 64 + co1); a1f[1] = ldf(As + (128 * wr + 16 + lr) * 64 + co1); }
#pragma unroll
            for (int tj = 0; tj < 4; ++tj) acc[ti][tj] = MFMA16(a0f[ti], b0f[tj], acc[ti][tj]);
        }
#pragma unroll
        for (int ti = 0; ti < 8; ++ti) {
            if (ti + 2 < 8) a1f[ti + 2] = ldf(As + (128 * wr + 16 * (ti + 2) + lr) * 64 + co1);
#pragma unroll
            for (int tj = 0; tj < 4; ++tj) acc[ti][tj] = MFMA16(a1f[ti], b1f[tj], acc[ti][tj]);
        }
        st(nxt);
        __builtin_amdgcn_sched_group_barrier(0x100, 7, 0);
#pragma unroll
        for (int ti = 0; ti < 8; ++ti) {
            if (ti < 5) __builtin_amdgcn_sched_group_barrier(0x100, 1, 0);
            if (ti >= 5) __builtin_amdgcn_sched_group_barrier(0x100, 2, 0);
            __builtin_amdgcn_sched_group_barrier(0x008, 4, 0);
        }
#pragma unroll
        for (int ti = 0; ti < 8; ++ti) {
            if (ti < 6) __builtin_amdgcn_sched_group_barrier(0x100, 1, 0);
            __builtin_amdgcn_sched_group_barrier(0x008, 4, 0);
            __builtin_amdgcn_sched_group_barrier(0x200, 1, 0);
        }
    };
    gl(0);
    st(lds);
    __syncthreads();
    for (int kt = 0; kt < nk; ++kt) {
        u16* cur = lds + (kt & 1) * 32768;
        u16* nxt = lds + ((kt + 1) & 1) * 32768;
        gl(kt + 1);
        __builtin_amdgcn_sched_barrier(0);
        ktile(cur, nxt);
        __syncthreads();
    }
}
DI void zero_acc8(f32x4 (&acc)[8][4]) {
#pragma unroll
    for (int i = 0; i < 8; ++i)
#pragma unroll
        for (int j = 0; j < 4; ++j) acc[i][j] = f32x4{0.f, 0.f, 0.f, 0.f};
}
DI void stage_acc8(unsigned char* smem_all, int pass, const f32x4 (&acc)[8][4]) {
    const int tid = threadIdx.x, lane = tid & 63, w = tid >> 6, wr = w >> 2, wc = w & 3, lr = lane & 15, q = lane >> 4;
    if (wr != pass) return;
    float* cst = (float*)(smem_all + (wc >> 1) * 69632);
#pragma unroll
    for (int ti = 0; ti < 8; ++ti)
#pragma unroll
        for (int tj = 0; tj < 4; ++tj)
#pragma unroll
            for (int r = 0; r < 4; ++r) cst[(16 * ti + 4 * q + r) * CST + (wc & 1) * 64 + 16 * tj + lr] = acc[ti][tj][r];
}
DI void zero_acc(f32x4 (&acc)[4][4]) {
#pragma unroll
    for (int i = 0; i < 4; ++i)
#pragma unroll
        for (int j = 0; j < 4; ++j) acc[i][j] = f32x4{0.f, 0.f, 0.f, 0.f};
}
DI void stage_acc(float* cst, const f32x4 (&acc)[4][4]) {
    const int lane = TID() & 63, w = TID() >> 6;
    const int wr = w >> 1, wc = w & 1, lr = lane & 15, q = lane >> 4;
#pragma unroll
    for (int ti = 0; ti < 4; ++ti)
#pragma unroll
        for (int tj = 0; tj < 4; ++tj)
#pragma unroll
            for (int r = 0; r < 4; ++r)
                cst[(64 * wr + 16 * ti + 4 * q + r) * CST + 64 * wc + 16 * tj + lr] = acc[ti][tj][r];
}
template <typename F> DI void emit_rows(const float* cst, F f) {
#pragma unroll 4
    for (int i = 0; i < 8; ++i) {
        const int item = TID() + 256 * i, row = item >> 4, c8 = item & 15;
        const float4 a = *(const float4*)(cst + row * CST + c8 * 8);
        const float4 b = *(const float4*)(cst + row * CST + c8 * 8 + 4);
        float v[8] = {a.x, a.y, a.z, a.w, b.x, b.y, b.z, b.w};
        f(row, c8, v);
    }
}
template <typename F> DI void emit_cols(const float* cst, F f) {
#pragma unroll 4
    for (int i = 0; i < 8; ++i) {
        const int item = TID() + 256 * i, rest = item >> 6;
        const int col = (item & 15) + 16 * (rest & 7), r8 = ((item >> 4) & 3) + 4 * (rest >> 3);
        float v[8];
#pragma unroll
        for (int k = 0; k < 8; ++k) v[k] = cst[(r8 * 8 + k) * CST + col];
        f(col, r8, v);
    }
}


DI void transpose_tile(const float* src, int ldsrc, int k0, int n0, u16* dst, int lddst, int map_in, float* tl) {
    const int tid = TID();
    const int c = tid & 63;
    int oc = n0 + c;
    if (map_in) oc = (oc < 1280) ? oc : (oc < 6912 ? oc + 24 : (oc < 6936 ? oc - 6912 + 1280 : -1));
#pragma unroll
    for (int i = 0; i < 16; ++i) {
        const int r = (tid >> 6) + 4 * i;
        tl[r * 65 + c] = (oc >= 0) ? src[(size_t)(k0 + r) * ldsrc + oc] : 0.f;
    }
    __syncthreads();
    const int nl = tid >> 2, kc = (tid & 3) * 16;
    float v[16];
#pragma unroll
    for (int i = 0; i < 16; ++i) v[i] = tl[(kc + i) * 65 + nl];
    u16* d = dst + (size_t)(n0 + nl) * lddst + k0 + kc;
    *(u32x4*)d = pack8(v);
    *(u32x4*)(d + 8) = pack8(v + 8);
    __syncthreads();
}

DI void transpose_tile2(const float* src, int ldsrc, int k0, int n0, u16* dst, int lddst, int map_in, float* tl) {
    const int tid = TID();
    const int c = tid & 63;
    int oc = n0 + c;
    if (map_in) oc = (oc < 1280) ? oc : (oc < 6912 ? oc + 24 : (oc < 6936 ? oc - 6912 + 1280 : -1));
    float ld[32];
#pragma unroll
    for (int i = 0; i < 32; ++i) {
        const int r = (tid >> 6) + 4 * i;
        ld[i] = (oc >= 0) ? src[(size_t)(k0 + r) * ldsrc + oc] : 0.f;
    }
#pragma unroll
    for (int i = 0; i < 32; ++i) tl[((tid >> 6) + 4 * i) * 65 + c] = ld[i];
    __syncthreads();
    const int nl = tid >> 2, kc = (tid & 3) * 32;
    u16* d = dst + (size_t)(n0 + nl) * lddst + k0 + kc;
#pragma unroll
    for (int h = 0; h < 4; ++h) {
        float v[8];
#pragma unroll
        for (int i = 0; i < 8; ++i) v[i] = tl[(kc + 8 * h + i) * 65 + nl];
        *(u32x4*)(d + 8 * h) = pack8(v);
    }
    __syncthreads();
}

DI void p0_unit(const Params& p, int u, unsigned char* smem) {
    const int tid = TID(), lane = tid & 63, w = tid >> 6;
    float* tl = (float*)smem;
    if (u < 1800) {
        int t = u;
        if (t < 896) { transpose_tile2(p.w_in, 6936, (t & 7) * 128, (t >> 3) * 64, p.WinT, 1024, 1, tl); return; }
        t -= 896;
        if (t < 128) { transpose_tile(p.w_nsa_o, 1024, (t & 7) * 64, (t >> 3) * 64, p.WnoT, 512, 0, tl); return; }
        t -= 128;
        if (t < 256) { transpose_tile(p.w_ret_o, 1024, (t & 15) * 64, (t >> 4) * 64, p.WroT, 1024, 0, tl); return; }
        t -= 256;
        if (t < 256) { transpose_tile(p.w_out, 1024, (t & 15) * 64, (t >> 4) * 64, p.WoutT, 1024, 0, tl); return; }
        t -= 256;
        if (t < 128) { transpose_tile(p.w1_k, 256, (t & 31) * 64, (t >> 5) * 64, p.W1T[0], 2048, 0, tl); return; }
        t -= 128;
        if (t < 128) { transpose_tile(p.w1_v, 256, (t & 31) * 64, (t >> 5) * 64, p.W1T[1], 2048, 0, tl); return; }
        t -= 128;
        if (t < 4) { transpose_tile(p.w2_k, 64, t * 64, 0, p.W2T[0], 256, 0, tl); return; }
        t -= 4;
        transpose_tile(p.w2_v, 64, t * 64, 0, p.W2T[1], 256, 0, tl);
        return;
    }
    u -= 1800;
    if (u < 512) {
        float4 v[8][4]; float ss[8];
#pragma unroll
        for (int rr = 0; rr < 8; ++rr) {
            const float* xr = p.x + (size_t)(u * 32 + w * 8 + rr) * 1024;
#pragma unroll
            for (int i = 0; i < 4; ++i) { const f32x4 t4 = __builtin_nontemporal_load((const f32x4*)(xr + lane * 4 + 256 * i)); v[rr][i] = make_float4(t4[0], t4[1], t4[2], t4[3]); }
        }
        float4 g[4];
#pragma unroll
        for (int i = 0; i < 4; ++i) g[i] = *(const float4*)(p.norm_pre + lane * 4 + 256 * i);
#pragma unroll
        for (int rr = 0; rr < 8; ++rr) {
            float s = 0.f;
#pragma unroll
            for (int i = 0; i < 4; ++i) s += v[rr][i].x * v[rr][i].x + v[rr][i].y * v[rr][i].y + v[rr][i].z * v[rr][i].z + v[rr][i].w * v[rr][i].w;
            ss[rr] = wave_sum(s);
        }
#pragma unroll
        for (int rr = 0; rr < 8; ++rr) {
            const float rs = rsqrtf(ss[rr] * (1.f / 1024.f) + 1e-6f);
            u16* hr = p.H + (size_t)(u * 32 + w * 8 + rr) * 1024;
#pragma unroll
            for (int i = 0; i < 4; ++i) {
                u32x2 o; o[0] = pack2(v[rr][i].x * rs * g[i].x, v[rr][i].y * rs * g[i].y); o[1] = pack2(v[rr][i].z * rs * g[i].z, v[rr][i].w * rs * g[i].w);
                *(u32x2*)(hr + lane * 4 + 256 * i) = o;
            }
        }
        return;
    }
    u -= 512;
    if (u < 1024) {
        const int i = tid & 63;
        const float inv = 1.0f / powf(10000.0f, (float)i / 63.0f);
#pragma unroll
        for (int k = 0; k < 4; ++k) {
            const int e = u * 1024 + tid + 256 * k, pos = e >> 6;
            const float ang = (float)pos * inv;
            float sn, cs; sincosf(ang, &sn, &cs);
            p.ropeR[e] = make_float2(cs, sn);
        }
        return;
    }
    u -= 1024;
    if (u < 128) {
        const int i = tid & 7;
        const float inv = 1.0f / powf(500000.0f, (float)(2 * i) / 16.0f);
#pragma unroll
        for (int k = 0; k < 4; ++k) {
            const int e = u * 1024 + tid + 256 * k, pos = e >> 3;
            const float ang = (float)pos * inv;
            float sn, cs; sincosf(ang, &sn, &cs);
            p.ropeN[e] = make_float2(cs, sn);
        }
        return;
    }
    u -= 128;
    {
        const int kv = u >> 4, ch = u & 15;
        const float* pe = kv ? p.pe_v : p.pe_k;
        const float* w1 = kv ? p.w1_v : p.w1_k;
        float s = 0.f;
        for (int k = ch * 128; k < ch * 128 + 128; ++k) s += pe[k] * w1[(size_t)k * 256 + tid];
        p.bpart[(kv * 16 + ch) * 256 + tid] = s;
    }
}
constexpr int P0_UNITS = 1800 + 512 + 1024 + 128 + 32;

DI void p1_epi(const Params& p, float* cst, int mt, int nt) {
    const int tid = TID();
    const int tok0 = mt * 128;
    if (nt <= 4 || nt == 6 || nt == 8) {
#pragma unroll 2
        for (int i = 0; i < 8; ++i) {
            const int item = tid + 256 * i, row = item >> 4, hh = (item >> 3) & 1, ii = item & 7;
            float* px = cst + row * CST + hh * 64 + ii;
            const float x1 = px[0], x2 = px[8];
            const float2 cs = p.ropeN[(size_t)(tok0 + row) * 8 + ii];
            px[0] = x1 * cs.x - x2 * cs.y; px[8] = x2 * cs.x + x1 * cs.y;
        }
    } else if (nt >= 14 && nt <= 21) {
        const float sc = (nt >= 18) ? 0.08838834764831845f : 1.0f;
#pragma unroll 2
        for (int i = 0; i < 32; ++i) {
            const int item = tid + 256 * i, row = item >> 6, ii = item & 63;
            float* px = cst + row * CST + ii;
            const float x1 = px[0], x2 = px[64];
            const float2 cs = p.ropeR[(size_t)(tok0 + row) * 64 + ii];
            px[0] = (x1 * cs.x - x2 * cs.y) * sc; px[64] = (x2 * cs.x + x1 * cs.y) * sc;
        }
    }
    __syncthreads();
    if (nt <= 3) {
        emit_rows(cst, [&](int row, int c8, const float* v) { __builtin_nontemporal_store(pack8(v), (u32x4*)(p.Qn + (size_t)(tok0 + row) * 512 + nt * 128 + c8 * 8)); });
    } else if (nt == 4 || nt == 5) {
        u16* dst = (nt == 4) ? p.Raw[0] : p.Raw[1];
        emit_rows(cst, [&](int row, int c8, const float* v) { __builtin_nontemporal_store(pack8(v), (u32x4*)(dst + (size_t)(tok0 + row) * 128 + c8 * 8)); });
    } else if (nt == 6 || nt == 8) {
        u16* dst = (nt == 6) ? p.Ks : p.Kw;
        emit_rows(cst, [&](int row, int c8, const float* v) { __builtin_nontemporal_store(pack8(v), (u32x4*)(dst + ((size_t)(c8 >> 3) * S_ + tok0 + row) * 64 + (c8 & 7) * 8)); });
    } else if (nt == 7 || nt == 9) {
        u16* dst = (nt == 7) ? p.VsT : p.VwT;
        emit_cols(cst, [&](int col, int r8, const float* v) {
            const int g = col >> 6, d = col & 63, tk = tok0 + r8 * 8;
            __builtin_nontemporal_store(pack8(v), (u32x4*)(dst + (((size_t)g * 256 + (tk >> 6)) * 64 + d) * 64 + (tk & 63))); });
    } else if (nt <= 13) {
        emit_rows(cst, [&](int row, int c8, const float* v) {
            float o[8];
#pragma unroll
            for (int k = 0; k < 8; ++k) o[k] = v[k] * sigmoidf_(v[k]);
            __builtin_nontemporal_store(pack8(o), (u32x4*)(p.SZn + (size_t)(tok0 + row) * 512 + (nt - 10) * 128 + c8 * 8)); });
    } else if (nt <= 17) {
        const int h = nt - 14;
        emit_rows(cst, [&](int row, int c8, const float* v) { __builtin_nontemporal_store(pack8(v), (u32x4*)(p.Qr + ((size_t)h * S_ + tok0 + row) * 128 + c8 * 8)); });
    } else if (nt <= 21) {
        const int h = nt - 18;
        emit_rows(cst, [&](int row, int c8, const float* v) { __builtin_nontemporal_store(pack8(v), (u32x4*)(p.Kr + ((size_t)h * S_ + tok0 + row) * 128 + c8 * 8)); });
        const float lg = logf(1.0f - exp2f(-5.0f - (float)h));
        emit_cols(cst, [&](int col, int r8, const float* v) {
            float o[8];
#pragma unroll
            for (int k = 0; k < 8; ++k) o[k] = v[k] * __expf((float)(127 - (r8 * 8 + k)) * lg);
            __builtin_nontemporal_store(pack8(o), (u32x4*)(p.KrT + (((size_t)h * 128 + mt) * 128 + col) * 128 + r8 * 8)); });
    } else if (nt <= 29) {
        const int h = (nt - 22) >> 1, e0 = ((nt - 22) & 1) * 128;
        emit_cols(cst, [&](int col, int r8, const float* v) {
            __builtin_nontemporal_store(pack8(v), (u32x4*)(p.VrT + (((size_t)h * 128 + mt) * 256 + e0 + col) * 128 + r8 * 8)); });
    } else if (nt <= 37) {
        emit_rows(cst, [&](int row, int c8, const float* v) {
            float o[8];
#pragma unroll
            for (int k = 0; k < 8; ++k) o[k] = v[k] * sigmoidf_(v[k]);
            __builtin_nontemporal_store(pack8(o), (u32x4*)(p.SZr + (size_t)(tok0 + row) * 1024 + (nt - 30) * 128 + c8 * 8)); });
    } else if (nt <= 53) {
        u16* dst = (nt <= 45) ? p.Ma : p.Mb;
        const int c0 = ((nt <= 45) ? (nt - 38) : (nt - 46)) * 128;
        emit_rows(cst, [&](int row, int c8, const float* v) {
            float o[8];
#pragma unroll
            for (int k = 0; k < 8; ++k) o[k] = sigmoidf_(v[k]);
            __builtin_nontemporal_store(pack8(o), (u32x4*)(dst + (size_t)(tok0 + row) * 1024 + c0 + c8 * 8)); });
    } else if (nt == 54) {
#pragma unroll 2
        for (int i = 0; i < 12; ++i) {
            const int item = tid + 256 * i, row = item / 24, c = item - row * 24;
            p.Gn[(size_t)(tok0 + row) * 24 + c] = sigmoidf_(cst[row * CST + c] + p.b_gate[c]);
        }
    }
    __syncthreads();
}

DI void p1_tile256(const Params& p, int t, unsigned char* smem_all) {
    const int tid = threadIdx.x, team = TEAM();
    const int nt = t >> 6, mt = t & 63;
    f32x4 acc[8][4]; zero_acc8(acc);
    gemm256_main(p.H + (size_t)(mt * 256 + (tid >> 3)) * 1024 + (tid & 7) * 8, (size_t)64 * 1024,
                 p.WinT + (size_t)(nt * 256 + (tid >> 3)) * 1024 + (tid & 7) * 8, (size_t)64 * 1024, 16, (u16*)smem_all, acc);
    float* cst = (float*)(smem_all + team * 69632);
#pragma unroll
    for (int pass = 0; pass < 2; ++pass) {
        stage_acc8(smem_all, pass, acc);
        __syncthreads();
        p1_epi(p, cst, mt * 2 + pass, nt * 2 + team);
    }
}


DI void p2_unit(const Params& p, int u, unsigned char* smem) {
    const int tid = TID(), lane = tid & 63, w = tid >> 6;
    u16* lds = (u16*)smem; float* cst = (float*)smem;
    f32x4 acc[4][4]; zero_acc(acc);
    if (u < 256) {
        const int nt = u & 1, mt = (u >> 1) & 15, ks = (u >> 5) & 3, kv = u >> 7;
        const int R = mt * 128 + (tid >> 3), c = R >> 1, g = R & 1;
        const u16* a0 = (kv ? p.Raw[1] : p.Raw[0]) + (size_t)(16 * c + ks * 8) * 128 + g * 64 + (tid & 7) * 8;
        const u16* b0 = (kv ? p.W1T[1] : p.W1T[0]) + (size_t)(nt * 128 + (tid >> 3)) * 2048 + ks * 512 + (tid & 7) * 8;
        gemm128_main(a0, (size_t)16 * 16 * 128, 128, b0, (size_t)32 * 2048, 64, 8, lds, acc);
        const int wr = w >> 1, wc = w & 1, lr = lane & 15, q = lane >> 4;
        float* dst = p.slab + ((size_t)(ks * 2 + kv) * 2048 + mt * 128) * 256 + nt * 128;
#pragma unroll
        for (int ti = 0; ti < 4; ++ti)
#pragma unroll
            for (int tj = 0; tj < 4; ++tj)
#pragma unroll
                for (int r = 0; r < 4; ++r)
                    dst[(size_t)(64 * wr + 16 * ti + 4 * q + r) * 256 + 64 * wc + 16 * tj + lr] = acc[ti][tj][r];
        return;
    }
    const int v = u - 256, half = v & 1, ch = v >> 1, n = ch >> 2, h = ch & 3;
    const u16* a0 = p.VrT + (((size_t)h * 128 + n) * 256 + half * 128 + (tid >> 3)) * 128 + (tid & 7) * 8;
    const u16* b0 = p.KrT + (((size_t)h * 128 + n) * 128 + (tid >> 3)) * 128 + (tid & 7) * 8;
    gemm128_main(a0, (size_t)32 * 128, 64, b0, (size_t)32 * 128, 64, 2, lds, acc);
    stage_acc(cst, acc);
    __syncthreads();
    u16* dst = p.H + (((size_t)n * 4 + h) * 256 + half * 128) * 128;
    emit_rows(cst, [&](int row, int c8, const float* vv) { *(u32x4*)(dst + (size_t)row * 128 + c8 * 8) = pack8(vv); });
    __syncthreads();
}
constexpr int P2_UNITS = 256 + 1024;

DI float gelu_tanh(float x) {
    const float u = 0.7978845608028654f * (x + 0.044715f * x * x * x);
    const float t = 1.f - 2.f / (1.f + __expf(2.f * u));
    return 0.5f * x * (1.f + t);
}
DI void p3_unit(const Params& p, int u, unsigned char* smem) {
    const int tid = TID(), lane = tid & 63, w = tid >> 6;
    const int v = u, kv = v & 1, rt = v >> 1;
    float* bias = (float*)smem;
    {
        float s = 0.f;
#pragma unroll
        for (int i = 0; i < 16; ++i) s += p.bpart[(kv * 16 + i) * 256 + tid];
        bias[tid] = s;
    }
    __syncthreads();
    const int lr = lane & 15, q = lane >> 4;
    const int R = rt * 16 + lr;
    f32x4 acc = {0.f, 0.f, 0.f, 0.f};
#pragma unroll
    for (int ks = 0; ks < 8; ++ks) {
        const int k0 = ks * 32 + q * 8;
        float hv[8];
#pragma unroll
        for (int k = 0; k < 8; ++k) hv[k] = bias[k0 + k];
#pragma unroll
        for (int s = 0; s < 4; ++s) {
            const float* sp = p.slab + ((size_t)(s * 2 + kv) * 2048 + R) * 256 + k0;
            const float4 a = *(const float4*)sp, b = *(const float4*)(sp + 4);
            hv[0] += a.x; hv[1] += a.y; hv[2] += a.z; hv[3] += a.w; hv[4] += b.x; hv[5] += b.y; hv[6] += b.z; hv[7] += b.w;
        }
#pragma unroll
        for (int k = 0; k < 8; ++k) hv[k] = gelu_tanh(hv[k]);
        const bf16x8 af = __builtin_bit_cast(bf16x8, pack8(hv));
        const bf16x8 bfr = ldf((kv ? p.W2T[1] : p.W2T[0]) + (size_t)(16 * w + lr) * 256 + k0);
        acc = MFMA16(af, bfr, acc);
    }
    const int d = 16 * w + lr;
#pragma unroll
    for (int r = 0; r < 4; ++r) {
        const int Ro = rt * 16 + 4 * q + r, c = Ro >> 1, g = Ro & 1;
        const float val = (c < 1023) ? acc[r] : 0.f;
        const u16 bv = (u16)(pack2(val, 0.f) & 0xffffu);
        if (kv == 0) p.Kc[((size_t)g * 1024 + c) * 64 + d] = bv;
        else p.VcT[(((size_t)g * 16 + (c >> 6)) * 64 + d) * 64 + (c & 63)] = bv;
    }
    __syncthreads();
}
constexpr int P3_UNITS = 256;
DI void p3_scan(const Params& p, bool dry) {
    const int nfree = (int)gridDim.x - P3_UNITS / 2;
    const bool split = nfree >= 64;
    if (split && (int)blockIdx.x < P3_UNITS / 2) return;
    const int sb = split ? (int)blockIdx.x - P3_UNITS / 2 : (int)blockIdx.x, sn = split ? nfree : (int)gridDim.x;
    for (int t = sb * 512 + threadIdx.x; t < 65536; t += sn * 512) {
        const int idx = 2 * t, h = idx >> 15;
        const float dec = __expf(128.0f * logf(1.0f - exp2f(-5.0f - (float)h)));
        unsigned* base = (unsigned*)(p.H + idx);
        float r0 = 0.f, r1 = 0.f;
#pragma unroll 32
        for (int n = 0; n < 128; ++n) {
            unsigned* pp = base + (size_t)n * 65536;
            const unsigned kv = *pp;
            unsigned* wp = dry ? (unsigned*)p.rowss + (size_t)n * 512 + (t & 511) : pp;
            *wp = pack2(r0, r1);
            r0 = dec * r0 + bflo(kv); r1 = dec * r1 + bfhi(kv);
        }
    }
}

constexpr int IMPS = 260;
DI int NTID() { int t = threadIdx.x; asm volatile("" : "+v"(t)); return t; }
DI void nsa_load_tile(const u16* src, u32x4& r) {
    r = ld16(src + NTID() * 8);
}
DI void nsa_store_k(u16* dst, const u32x4& r) {
    const int c0 = NTID(), r0 = c0 >> 3;
    *(u32x4*)(dst + r0 * LDT + (((c0 & 7) ^ swzK(r0)) << 3)) = r;
}
DI void nsa_store_v(u16* dst, const u32x4& r) {
    const int c0 = NTID(), r0 = c0 >> 3;
    *(u32x4*)(dst + r0 * LDT + (((c0 & 7) ^ swzA(r0)) << 3)) = r;
}
DI void nsa_scores(const u16* Kt, const bf16x8 (&qf)[2][2], f32x4 (&s)[4][2]) {
    const int lane = NTID() & 63, lr = lane & 15, q = lane >> 4;
#pragma unroll
    for (int kt = 0; kt < 4; ++kt) {
        const int krow = 32 * (kt >> 1) + 8 * (lr >> 2) + 4 * (kt & 1) + (lr & 3);
        s[kt][0] = f32x4{0.f, 0.f, 0.f, 0.f}; s[kt][1] = f32x4{0.f, 0.f, 0.f, 0.f};
#pragma unroll
        for (int ks = 0; ks < 2; ++ks) {
            const bf16x8 kf = ldf(Kt + krow * LDT + (((ks * 4 + q) ^ swzK(krow)) << 3));
            s[kt][0] = MFMA16(kf, qf[0][ks], s[kt][0]);
            s[kt][1] = MFMA16(kf, qf[1][ks], s[kt][1]);
        }
    }
    __builtin_amdgcn_sched_group_barrier(0x100, 3, 0);
#pragma unroll
    for (int i = 0; i < 8; ++i) {
        __builtin_amdgcn_sched_group_barrier(0x008, 2, 0);
        if (i + 3 < 8) __builtin_amdgcn_sched_group_barrier(0x100, 1, 0);
    }
}
DI void nsa_pv(const u16* Vt, const f32x4 (&s)[4][2], f32x4 (&o)[4][2]) {
    const int lane = NTID() & 63, lr = lane & 15, q = lane >> 4;
#pragma unroll
    for (int ks2 = 0; ks2 < 2; ++ks2) {
        const bf16x8 pb0 = packf(s[2 * ks2][0], s[2 * ks2 + 1][0]);
        const bf16x8 pb1 = packf(s[2 * ks2][1], s[2 * ks2 + 1][1]);
#pragma unroll
        for (int dt = 0; dt < 4; ++dt) {
            const bf16x8 vf = ldf(Vt + (16 * dt + lr) * LDT + (((ks2 * 4 + q) ^ (lr & 7)) << 3));
            o[dt][0] = MFMA16(vf, pb0, o[dt][0]);
            o[dt][1] = MFMA16(vf, pb1, o[dt][1]);
        }
    }
    __builtin_amdgcn_sched_group_barrier(0x100, 3, 0);
#pragma unroll
    for (int i = 0; i < 8; ++i) {
        __builtin_amdgcn_sched_group_barrier(0x008, 2, 0);
        if (i + 3 < 8) __builtin_amdgcn_sched_group_barrier(0x100, 1, 0);
    }
}

DI void nsa_item(const Params& p, int tb, int g, unsigned char* smem) {
    u16* Kt = (u16*)smem;
    u16* Vt = Kt + 64 * LDT;
    float* imp = (float*)(smem + 2 * 64 * LDT * 2);
    int* sel = (int*)(smem + 83968);
    const int tid = NTID(), lane = tid & 63, w = tid >> 6, lr = lane & 15, q = lane >> 4;
    const int t0 = tb * 64, cur = tb;
    const float SC = 0.125f * LOG2E;
    const float NEG = -1e30f;

    bf16x8 qf[2][2];
    int tokL[2]; float gc[2], gs[2], gw[2];
#pragma unroll
    for (int rt = 0; rt < 2; ++rt) {
        tokL[rt] = t0 + 8 * w + 4 * rt + (lr >> 2);
        const int head = 4 * g + (lr & 3);
#pragma unroll
        for (int ks = 0; ks < 2; ++ks) qf[rt][ks] = ldf(p.Qn + (size_t)tokL[rt] * 512 + head * 64 + 32 * ks + 8 * q);
        const float* gp = p.Gn + (size_t)tokL[rt] * 24 + head * 3;
        gc[rt] = gp[0]; gs[rt] = gp[1]; gw[rt] = gp[2];
    }
    f32x4 tot[4][2];
#pragma unroll
    for (int dt = 0; dt < 4; ++dt) { tot[dt][0] = f32x4{0.f, 0.f, 0.f, 0.f}; tot[dt][1] = f32x4{0.f, 0.f, 0.f, 0.f}; }

    for (int rep = (MK_PROBE & 256) ? 0 : 1; rep < 2; ++rep) {
        float m[2] = {NEG, NEG}, l[2] = {0.f, 0.f};
        f32x4 o[4][2];
#pragma unroll
        for (int dt = 0; dt < 4; ++dt) { o[dt][0] = f32x4{0.f, 0.f, 0.f, 0.f}; o[dt][1] = f32x4{0.f, 0.f, 0.f, 0.f}; }
        const int kb_lo = (t0 > 511 ? t0 - 511 : 0) >> 6, kb_hi = cur;
        u32x4 rk, rv;
        nsa_load_tile(p.Kw + ((size_t)g * S_ + kb_lo * 64) * 64, rk);
        nsa_load_tile(p.VwT + ((size_t)g * 256 + kb_lo) * 4096, rv);
        for (int kb = kb_lo; kb <= kb_hi; ++kb) {
            __syncthreads();
            nsa_store_k(Kt, rk); nsa_store_v(Vt, rv);
            __syncthreads();
            if (kb < kb_hi) {
                nsa_load_tile(p.Kw + ((size_t)g * S_ + (kb + 1) * 64) * 64, rk);
                nsa_load_tile(p.VwT + ((size_t)g * 256 + kb + 1) * 4096, rv);
            }
            f32x4 s[4][2];
            nsa_scores(Kt, qf, s);
            const bool interior = (kb * 64 + 63 <= t0) && (kb * 64 > t0 + 63 - 512);
#pragma unroll
            for (int rt = 0; rt < 2; ++rt) {
                if (interior) {
                    float mx = NEG;
#pragma unroll
                    for (int kt = 0; kt < 4; ++kt) mx = fmaxf(fmaxf(mx, fmaxf(s[kt][rt][0], s[kt][rt][1])), fmaxf(s[kt][rt][2], s[kt][rt][3]));
                    mx *= SC;
                    mx = qmax(mx);
                    const float mn = fmaxf(m[rt], mx), alpha = ex2(m[rt] - mn);
                    float rs = 0.f;
#pragma unroll
                    for (int kt = 0; kt < 4; ++kt)
#pragma unroll
                        for (int r = 0; r < 4; ++r) { const float pv = ex2(fmaf(s[kt][rt][r], SC, -mn)); s[kt][rt][r] = pv; rs += pv; }
                    l[rt] = l[rt] * alpha + rs; m[rt] = mn;
#pragma unroll
                    for (int dt = 0; dt < 4; ++dt) o[dt][rt] *= alpha;
                    continue;
                }
                const int t = tokL[rt];
                float mx = NEG;
#pragma unroll
                for (int kt = 0; kt < 4; ++kt)
#pragma unroll
                    for (int r = 0; r < 4; ++r) {
                        const int key = kb * 64 + 32 * (kt >> 1) + 8 * q + 4 * (kt & 1) + r;
                        const bool ok = (key <= t) && (key > t - 512);
                        const float v = ok ? s[kt][rt][r] * SC : NEG;
                        s[kt][rt][r] = v; mx = fmaxf(mx, v);
                    }
                mx = qmax(mx);
                const float mn = fmaxf(m[rt], mx), alpha = ex2(m[rt] - mn);
                float rs = 0.f;
#pragma unroll
                for (int kt = 0; kt < 4; ++kt)
#pragma unroll
                    for (int r = 0; r < 4; ++r) {
                        const float v = s[kt][rt][r];
                        const float pv = (v > -1e29f) ? ex2(v - mn) : 0.f;
                        s[kt][rt][r] = pv; rs += pv;
                    }
                l[rt] = l[rt] * alpha + rs; m[rt] = mn;
#pragma unroll
                for (int dt = 0; dt < 4; ++dt) o[dt][rt] *= alpha;
            }
            nsa_pv(Vt, s, o);
        }
#pragma unroll
        for (int rt = 0; rt < 2; ++rt) {
            float lt = l[rt]; lt = qsum(lt);
            const float f = (rep == 1) ? gw[rt] / fmaxf(lt, 1e-37f) : 0.f;
#pragma unroll
            for (int dt = 0; dt < 4; ++dt) tot[dt][rt] += o[dt][rt] * f;
        }
    }

    for (int rep = (MK_PROBE & 512) ? 0 : 1; rep < 2; ++rep) {
        const int nct = (((t0 + 32) >> 4) >> 6) + 1;
        int cmaxv[2]; cmaxv[0] = (tokL[0] - 31) >> 4; cmaxv[1] = (tokL[1] - 31) >> 4;
        const int cfull = (t0 - 31) >> 4;
        float m[2] = {NEG, NEG}, l[2] = {0.f, 0.f};
        u32x4 rk, rv;
        nsa_load_tile(p.Kc + ((size_t)g * 1024) * 64, rk);
        for (int ct = 0; ct < nct; ++ct) {
            __syncthreads();
            nsa_store_k(Kt, rk);
            __syncthreads();
            if (ct + 1 < nct) nsa_load_tile(p.Kc + ((size_t)g * 1024 + (ct + 1) * 64) * 64, rk);
            f32x4 s[4][2];
            nsa_scores(Kt, qf, s);
#pragma unroll
            for (int rt = 0; rt < 2; ++rt) {
                if (ct * 64 + 63 <= cfull) {
                    float mx = NEG;
#pragma unroll
                    for (int kt = 0; kt < 4; ++kt) mx = fmaxf(fmaxf(mx, fmaxf(s[kt][rt][0], s[kt][rt][1])), fmaxf(s[kt][rt][2], s[kt][rt][3]));
                    mx *= SC;
                    mx = qmax(mx);
                    const float mn = fmaxf(m[rt], mx), alpha = ex2(m[rt] - mn);
                    float rs = 0.f;
#pragma unroll
                    for (int kt = 0; kt < 4; ++kt)
#pragma unroll
                        for (int r = 0; r < 4; ++r) rs += ex2(fmaf(s[kt][rt][r], SC, -mn));
                    l[rt] = l[rt] * alpha + rs; m[rt] = mn;
                    continue;
                }
                float mx = NEG;
#pragma unroll
                for (int kt = 0; kt < 4; ++kt)
#pragma unroll
                    for (int r = 0; r < 4; ++r) {
                        const int c = ct * 64 + 32 * (kt >> 1) + 8 * q + 4 * (kt & 1) + r;
                        const float v = (c <= cmaxv[rt]) ? s[kt][rt][r] * SC : NEG;
                        s[kt][rt][r] = v; mx = fmaxf(mx, v);
                    }
                mx = qmax(mx);
                const float mn = fmaxf(m[rt], mx), alpha = ex2(m[rt] - mn);
                float rs = 0.f;
#pragma unroll
                for (int kt = 0; kt < 4; ++kt)
#pragma unroll
                    for (int r = 0; r < 4; ++r) { const float v = s[kt][rt][r]; rs += (v > -1e29f) ? ex2(v - mn) : 0.f; }
                l[rt] = l[rt] * alpha + rs; m[rt] = mn;
            }
        }
        float linv[2];
#pragma unroll
        for (int rt = 0; rt < 2; ++rt) {
            float lt = l[rt]; lt = qsum(lt);
            linv[rt] = 1.f / fmaxf(lt, 1e-37f);
        }
        f32x4 o[4][2];
#pragma unroll
        for (int dt = 0; dt < 4; ++dt) { o[dt][0] = f32x4{0.f, 0.f, 0.f, 0.f}; o[dt][1] = f32x4{0.f, 0.f, 0.f, 0.f}; }
        float carry[2] = {0.f, 0.f};
        nsa_load_tile(p.Kc + ((size_t)g * 1024) * 64, rk);
        nsa_load_tile(p.VcT + ((size_t)g * 16) * 4096, rv);
        for (int ct = 0; ct < nct; ++ct) {
            __syncthreads();
            nsa_store_k(Kt, rk); nsa_store_v(Vt, rv);
            __syncthreads();
            if (ct + 1 < nct) {
                nsa_load_tile(p.Kc + ((size_t)g * 1024 + (ct + 1) * 64) * 64, rk);
                nsa_load_tile(p.VcT + ((size_t)g * 16 + ct + 1) * 4096, rv);
            }
            f32x4 s[4][2];
            nsa_scores(Kt, qf, s);
#pragma unroll
            for (int rt = 0; rt < 2; ++rt) {
                if (ct * 64 + 63 <= cfull) {
#pragma unroll
                    for (int kt = 0; kt < 4; ++kt)
#pragma unroll
                        for (int r = 0; r < 4; ++r) s[kt][rt][r] = ex2(fmaf(s[kt][rt][r], SC, -m[rt])) * linv[rt];
                } else {
#pragma unroll
                    for (int kt = 0; kt < 4; ++kt)
#pragma unroll
                        for (int r = 0; r < 4; ++r) {
                            const int c = ct * 64 + 32 * (kt >> 1) + 8 * q + 4 * (kt & 1) + r;
                            s[kt][rt][r] = (c <= cmaxv[rt]) ? ex2(s[kt][rt][r] * SC - m[rt]) * linv[rt] : 0.f;
                        }
                }
                const float up1 = __shfl_up(s[1][rt][3], 16), up3 = __shfl_up(s[3][rt][3], 16);
                const float w1 = __shfl(s[1][rt][3], lr + 48), w3 = __shfl(s[3][rt][3], lr + 48);
                float e[4];
                e[0] = s[0][rt][0] + s[0][rt][1] + s[0][rt][2] + s[0][rt][3] + (q > 0 ? up1 : carry[rt]);
                e[1] = s[1][rt][0] + s[1][rt][1] + s[1][rt][2] + s[1][rt][3] + s[0][rt][3];
                e[2] = s[2][rt][0] + s[2][rt][1] + s[2][rt][2] + s[2][rt][3] + (q > 0 ? up3 : w1);
                e[3] = s[3][rt][0] + s[3][rt][1] + s[3][rt][2] + s[3][rt][3] + s[2][rt][3];
                carry[rt] = w3;
#pragma unroll
                for (int kt = 0; kt < 4; ++kt) {
                    float ev = e[kt];
                    ev += __shfl_xor(ev, 1); ev += __shfl_xor(ev, 2);
                    if ((lr & 3) == 0) imp[(8 * w + 4 * rt + (lr >> 2)) * IMPS + ct * 16 + 8 * (kt >> 1) + 2 * q + (kt & 1)] = ev;
                }
            }
            nsa_pv(Vt, s, o);
        }
#pragma unroll
        for (int rt = 0; rt < 2; ++rt)
#pragma unroll
            for (int dt = 0; dt < 4; ++dt) tot[dt][rt] += o[dt][rt] * ((rep == 1) ? gc[rt] : 0.f);
    }
    __syncthreads();

    for (int rep = (MK_PROBE & 1024) ? 0 : 1; rep < 2; ++rep)
    for (int tk = 0; tk < 8; tk += 2) {
        const int tl0 = 8 * w + tk, tl1 = tl0 + 1;
        unsigned va[4], vb[4];
#pragma unroll
        for (int i = 0; i < 4; ++i) {
            const int j = lane + 64 * i;
            const bool cand = (j <= cur) && (j != 0) && (j != cur) && (j != cur - 1);
            va[i] = cand ? (__float_as_uint(imp[tl0 * IMPS + j]) + 1u) : 0u;
            vb[i] = cand ? (__float_as_uint(imp[tl1 * IMPS + j]) + 1u) : 0u;
        }
        int sela = -1, selb = -1;
        if (lane == 0) { sela = 0; selb = 0; }
        if (cur > 0 && lane == 1) { sela = cur; selb = cur; }
        if (cur > 1 && lane == 2) { sela = cur - 1; selb = cur - 1; }
        const int nforced = 1 + (cur > 0 ? 1 : 0) + (cur > 1 ? 1 : 0);
        auto take = [&](unsigned (&v)[4], unsigned wm) -> int {
            const unsigned long long b0 = __ballot(v[0] == wm);
            if (b0) { const int ow = __builtin_ctzll(b0); if (lane == ow) v[0] = 0u; return ow; }
            const unsigned long long b1 = __ballot(v[1] == wm);
            if (b1) { const int ow = __builtin_ctzll(b1); if (lane == ow) v[1] = 0u; return ow + 64; }
            const unsigned long long b2 = __ballot(v[2] == wm);
            if (b2) { const int ow = __builtin_ctzll(b2); if (lane == ow) v[2] = 0u; return ow + 128; }
            const unsigned long long b3 = __ballot(v[3] == wm);
            if (b3) { const int ow = __builtin_ctzll(b3); if (lane == ow) v[3] = 0u; return ow + 192; }
            return -1;
        };
        for (int it = nforced; it < 16; ++it) {
            const unsigned wma = wave_umax(max(max(va[0], va[1]), max(va[2], va[3])));
            const unsigned wmb = wave_umax(max(max(vb[0], vb[1]), max(vb[2], vb[3])));
            if ((wma | wmb) == 0u) break;
            if (wma) { const int js = take(va, wma); if (lane == it) sela = js; }
            if (wmb) { const int js = take(vb, wmb); if (lane == it) selb = js; }
        }
        if (lane < 16) { sel[tl0 * 16 + lane] = sela; sel[tl1 * 16 + lane] = selb; }
    }
    __syncthreads();

    {
        unsigned long long* bmask = (unsigned long long*)(sel + 64 * 16);
        int* blist = (int*)(bmask + 256);
        if (tid < 256) bmask[tid] = 0ull;
        __syncthreads();
        for (int e = tid; e < 1024; e += 512) { const int j = sel[e]; if (j >= 0) atomicOr(&bmask[j], 1ull << (e >> 4)); }
        __syncthreads();
        if (w == 0) {
            int base = 0;
#pragma unroll
            for (int i = 0; i < 4; ++i) {
                const int j = lane + 64 * i;
                const bool nz = bmask[j] != 0ull;
                const unsigned long long b = __ballot(nz);
                const int pre = __builtin_popcountll(b & ((1ull << lane) - 1ull));
                if (nz) blist[base + pre] = j;
                base += __builtin_popcountll(b);
            }
            if (lane == 0) sel[0] = base;
        }
        __syncthreads();
        const int nl = sel[0];
        for (int rep = (MK_PROBE & (2048 | 16384)) ? 0 : 1; rep < 2; ++rep) {
        u16* st0 = (u16*)smem;
        u16* st1 = (u16*)(smem + 32768);
        float m[2] = {NEG, NEG}, l[2] = {0.f, 0.f};
        f32x4 o[4][2];
#pragma unroll
        for (int dt = 0; dt < 4; ++dt) { o[dt][0] = f32x4{0.f, 0.f, 0.f, 0.f}; o[dt][1] = f32x4{0.f, 0.f, 0.f, 0.f}; }
        u32x4 RA[4], RB[4];
        auto gloadS = [&](int st, u32x4 (&R)[4]) {
            const int j0 = blist[min(2 * st, nl - 1)], j1 = blist[min(2 * st + 1, nl - 1)];
            nsa_load_tile(p.Ks + ((size_t)g * S_ + (size_t)j0 * 64) * 64, R[0]);
            nsa_load_tile(p.VsT + ((size_t)g * 256 + j0) * 4096, R[1]);
            nsa_load_tile(p.Ks + ((size_t)g * S_ + (size_t)j1 * 64) * 64, R[2]);
            nsa_load_tile(p.VsT + ((size_t)g * 256 + j1) * 4096, R[3]);
        };
        auto storeS = [&](u16* stg, const u32x4 (&R)[4]) {
            nsa_store_k(stg, R[0]); nsa_store_v(stg + 4096, R[1]); nsa_store_k(stg + 8192, R[2]); nsa_store_v(stg + 12288, R[3]);
        };
        auto sel_rt = [&](auto RT, const u16* Kb, const u16* Vb, int j, unsigned long long mk) {
            constexpr int rt = decltype(RT)::value;
            f32x4 s[4];
#pragma unroll
            for (int kt = 0; kt < 4; ++kt) {
                const int krow = 32 * (kt >> 1) + 8 * (lr >> 2) + 4 * (kt & 1) + (lr & 3);
                s[kt] = f32x4{0.f, 0.f, 0.f, 0.f};
#pragma unroll
                for (int ks = 0; ks < 2; ++ks) s[kt] = MFMA16(ldf(Kb + krow * LDT + (((ks * 4 + q) ^ swzK(krow)) << 3)), qf[rt][ks], s[kt]);
            }
            __builtin_amdgcn_sched_group_barrier(0x100, 4, 0);
#pragma unroll
            for (int i = 0; i < 8; ++i) {
                __builtin_amdgcn_sched_group_barrier(0x008, 1, 0);
                if (i + 4 < 8) __builtin_amdgcn_sched_group_barrier(0x100, 1, 0);
            }
            const bool mine = ((mk >> (8 * w + 4 * rt + (lr >> 2))) & 1ull) != 0ull;
            float mx = NEG;
            if (j == cur) {
                const int dlim = mine ? (tokL[rt] - j * 64 - 8 * q) : -1;
#pragma unroll
                for (int kt = 0; kt < 4; ++kt)
#pragma unroll
                    for (int r = 0; r < 4; ++r) {
                        const float v = (32 * (kt >> 1) + 4 * (kt & 1) + r <= dlim) ? s[kt][r] * SC : NEG;
                        s[kt][r] = v; mx = fmaxf(mx, v);
                    }
                mx = qmax(mx);
                const float mn = fmaxf(m[rt], mx), alpha = ex2(m[rt] - mn);
                float rs = 0.f;
#pragma unroll
                for (int kt = 0; kt < 4; ++kt)
#pragma unroll
                    for (int r = 0; r < 4; ++r) {
                        const float v = s[kt][r];
                        const float pv = (v > -1e29f) ? ex2(v - mn) : 0.f;
                        s[kt][r] = pv; rs += pv;
                    }
                l[rt] = l[rt] * alpha + rs; m[rt] = mn;
#pragma unroll
                for (int dt = 0; dt < 4; ++dt) o[dt][rt] *= alpha;
            } else {
#pragma unroll
                for (int kt = 0; kt < 4; ++kt) mx = fmaxf(fmaxf(mx, fmaxf(s[kt][0], s[kt][1])), fmaxf(s[kt][2], s[kt][3]));
                mx = mine ? mx * SC : NEG;
                mx = qmax(mx);
                const float mn = fmaxf(m[rt], mx), alpha = ex2(m[rt] - mn);
                const float nb = mine ? -mn : NEG;
                float rs = 0.f;
#pragma unroll
                for (int kt = 0; kt < 4; ++kt)
#pragma unroll
                    for (int r = 0; r < 4; ++r) { const float pv = ex2(fmaf(s[kt][r], SC, nb)); s[kt][r] = pv; rs += pv; }
                l[rt] = l[rt] * alpha + rs; m[rt] = mn;
#pragma unroll
                for (int dt = 0; dt < 4; ++dt) o[dt][rt] *= alpha;
            }
#pragma unroll
            for (int ks2 = 0; ks2 < 2; ++ks2) {
                const bf16x8 pb = packf(s[2 * ks2], s[2 * ks2 + 1]);
#pragma unroll
                for (int dt = 0; dt < 4; ++dt) o[dt][rt] = MFMA16(ldf(Vb + (16 * dt + lr) * LDT + (((ks2 * 4 + q) ^ (lr & 7)) << 3)), pb, o[dt][rt]);
            }
            __builtin_amdgcn_sched_group_barrier(0x100, 4, 0);
#pragma unroll
            for (int i = 0; i < 8; ++i) {
                __builtin_amdgcn_sched_group_barrier(0x008, 1, 0);
                if (i + 4 < 8) __builtin_amdgcn_sched_group_barrier(0x100, 1, 0);
            }
        };
        auto compute = [&](const u16* Kb, const u16* Vb, int j) {
            if ((MK_PROBE & 16384) && rep == 0) return;
            const unsigned long long mk = bmask[j];
            const unsigned wb = (unsigned)(mk >> (8 * w)) & 0xffu;
            if (wb & 0x0fu) sel_rt(IC<0>{}, Kb, Vb, j, mk);
            if (wb & 0xf0u) sel_rt(IC<1>{}, Kb, Vb, j, mk);
        };
        auto computeS = [&](const u16* stg, int st) {
            compute(stg, stg + 4096, blist[2 * st]);
            if (2 * st + 1 < nl) compute(stg + 8192, stg + 12288, blist[2 * st + 1]);
        };
        const int nst = (nl + 1) >> 1;
        const int nstm = nst;
        gloadS(0, RA);
        storeS(st0, RA);
        gloadS(1, RB);
        __syncthreads();
        for (int st = 0; st < nstm; st += 2) {
            gloadS(st + 2, RA);
            if (st < nst) computeS(st0, st);
            storeS(st1, RB);
            __syncthreads();
            gloadS(st + 3, RB);
            if (st + 1 < nst) computeS(st1, st + 1);
            storeS(st0, RA);
            __syncthreads();
        }
#pragma unroll
        for (int rt = 0; rt < 2; ++rt) {
            float lt = l[rt]; lt = qsum(lt);
            const float f = (rep == 1) ? gs[rt] / fmaxf(lt, 1e-37f) : 0.f;
#pragma unroll
            for (int dt = 0; dt < 4; ++dt) tot[dt][rt] += o[dt][rt] * f;
        }
        __syncthreads();
        }
    }

#pragma unroll
    for (int rt = 0; rt < 2; ++rt) {
        const int head = 4 * g + (lr & 3);
#pragma unroll
        for (int dt = 0; dt < 4; ++dt) {
            const size_t off = (size_t)tokL[rt] * 512 + head * 64 + 16 * dt + 4 * q;
            const u32x2 z = *(const u32x2*)(p.SZn + off);
            u32x2 o2;
            o2[0] = pack2(tot[dt][rt][0] * bflo(z[0]), tot[dt][rt][1] * bfhi(z[0]));
            o2[1] = pack2(tot[dt][rt][2] * bflo(z[1]), tot[dt][rt][3] * bfhi(z[1]));
            *(u32x2*)(p.Qn + off) = o2;
        }
    }
    __syncthreads();
}


DI void ret_item(const Params& p, int n, int h, bool dowrite) {
    const int lane = TID() & 63, w = TID() >> 6, lr = lane & 15, q = lane >> 4;
    const float lg2 = logf(1.0f - exp2f(-5.0f - (float)h)) * LOG2E;
    const u16* rbase = p.H + (((size_t)n * 4 + h) * 256) * 128;
    const u16* kbase = p.Kr + ((size_t)h * S_ + n * 128) * 128;
    const u16* vbase = p.VrT + (((size_t)h * 128 + n) * 256) * 128;
    const u16* rlane = rbase + lr * 128 + 8 * q;
    const u16* vlane = vbase + lr * 128 + 8 * q;
#pragma unroll 1
    for (int it = 0; it < 2; ++it) {
        const int i = 32 * w + 16 * it + lr;
        bf16x8 qf[4];
#pragma unroll
        for (int ks = 0; ks < 4; ++ks) qf[ks] = ldf(p.Qr + ((size_t)h * S_ + n * 128 + i) * 128 + 32 * ks + 8 * q);
        f32x4 acc[16];
#pragma unroll
        for (int et = 0; et < 16; ++et) acc[et] = f32x4{0.f, 0.f, 0.f, 0.f};
#pragma unroll
        for (int et = 0; et < 16; ++et) {
            const u16* pe = rlane + et * 16 * 128; asm volatile("" : "+v"(pe));
#pragma unroll
            for (int ks = 0; ks < 4; ++ks) acc[et] = MFMA16(ldf(pe + 32 * ks), qf[ks], acc[et]);
        }
        {
            const float qd = ex2((float)(i + 1) * lg2);
#pragma unroll
            for (int et = 0; et < 16; ++et) acc[et] *= qd;
        }
        for (int jk = 0; jk <= w; ++jk) {
            f32x4 s[2];
#pragma unroll
            for (int jj = 0; jj < 2; ++jj) {
                const int krow = 32 * jk + 8 * (lr >> 2) + 4 * jj + (lr & 3);
                s[jj] = f32x4{0.f, 0.f, 0.f, 0.f};
#pragma unroll
                for (int ks = 0; ks < 4; ++ks) s[jj] = MFMA16(ldf(kbase + (size_t)krow * 128 + 32 * ks + 8 * q), qf[ks], s[jj]);
            }
#pragma unroll
            for (int jj = 0; jj < 2; ++jj)
#pragma unroll
                for (int r = 0; r < 4; ++r) {
                    const int j = 32 * jk + 8 * q + 4 * jj + r;
                    s[jj][r] = (i >= j) ? s[jj][r] * ex2((float)(i - j) * lg2) : 0.f;
                }
            const bf16x8 pb = packf(s[0], s[1]);
#pragma unroll
            for (int et = 0; et < 16; ++et) {
                const u16* pe = vlane + et * 16 * 128 + 32 * jk; asm volatile("" : "+v"(pe));
                acc[et] = MFMA16(ldf(pe), pb, acc[et]);
            }
        }
        float sm = 0.f;
#pragma unroll
        for (int et = 0; et < 16; ++et) sm += acc[et][0] + acc[et][1] + acc[et][2] + acc[et][3];
        sm = qsum(sm);
        const float mu = sm * (1.f / 256.f);
        float vs = 0.f;
#pragma unroll
        for (int et = 0; et < 16; ++et)
#pragma unroll
            for (int r = 0; r < 4; ++r) { const float d = acc[et][r] - mu; vs += d * d; }
        vs = qsum(vs);
        const float rs = rsqrtf(vs * (1.f / 256.f) + 1e-6f);
        u16* zlane = p.SZr + ((size_t)n * 128 + i) * 1024 + h * 256 + 4 * q;
#pragma unroll
        for (int et = 0; et < 16; ++et) {
            u16* zp = zlane + 16 * et; asm volatile("" : "+v"(zp));
            const u32x2 z = *(const u32x2*)zp;
            u32x2 o2;
            o2[0] = pack2((acc[et][0] - mu) * rs * bflo(z[0]), (acc[et][1] - mu) * rs * bfhi(z[0]));
            o2[1] = pack2((acc[et][2] - mu) * rs * bflo(z[1]), (acc[et][3] - mu) * rs * bfhi(z[1]));
            if (dowrite) *(u32x2*)zp = o2;
        }
    }
}

DI void p5_tile(const Params& p, int t, unsigned char* smem_all) {
    const int tid = threadIdx.x, team = TEAM();
    const int nt = t >> 6, mt = t & 63;
    u16* Mg = p.Qr;
    const float* cst = (const float*)(smem_all + team * 69632);
    f32x4 acc[8][4];
    zero_acc8(acc);
    gemm256_main(p.Qn + (size_t)(mt * 256 + (tid >> 3)) * 512 + (tid & 7) * 8, (size_t)64 * 512,
                 p.WnoT + (size_t)(nt * 256 + (tid >> 3)) * 512 + (tid & 7) * 8, (size_t)64 * 512, 8, (u16*)smem_all, acc);
#pragma unroll
    for (int pass = 0; pass < 2; ++pass) {
        stage_acc8(smem_all, pass, acc);
        __syncthreads();
        const int tok0 = mt * 256 + pass * 128, c0 = (nt * 2 + team) * 128;
        emit_rows(cst, [&](int row, int c8, const float* v) {
            const u32x4 gm = ld16(p.Ma + (size_t)(tok0 + row) * 1024 + c0 + c8 * 8);
            float o[8];
            o[0] = v[0] * bflo(gm[0]); o[1] = v[1] * bfhi(gm[0]); o[2] = v[2] * bflo(gm[1]); o[3] = v[3] * bfhi(gm[1]);
            o[4] = v[4] * bflo(gm[2]); o[5] = v[5] * bfhi(gm[2]); o[6] = v[6] * bflo(gm[3]); o[7] = v[7] * bfhi(gm[3]);
            *(u32x4*)(Mg + (size_t)(tok0 + row) * 1024 + c0 + c8 * 8) = pack8(o); });
        __syncthreads();
    }
    zero_acc8(acc);
    gemm256_main(p.SZr + (size_t)(mt * 256 + (tid >> 3)) * 1024 + (tid & 7) * 8, (size_t)64 * 1024,
                 p.WroT + (size_t)(nt * 256 + (tid >> 3)) * 1024 + (tid & 7) * 8, (size_t)64 * 1024, 16, (u16*)smem_all, acc);
#pragma unroll
    for (int pass = 0; pass < 2; ++pass) {
        stage_acc8(smem_all, pass, acc);
        __syncthreads();
        const int tok0 = mt * 256 + pass * 128, c0 = (nt * 2 + team) * 128;
        emit_rows(cst, [&](int row, int c8, const float* v) {
            u16* mp = Mg + (size_t)(tok0 + row) * 1024 + c0 + c8 * 8;
            const u32x4 gm = ld16(p.Mb + (size_t)(tok0 + row) * 1024 + c0 + c8 * 8);
            const u32x4 ya = ld16(mp);
            float o[8];
            o[0] = bflo(ya[0]) + v[0] * bflo(gm[0]); o[1] = bfhi(ya[0]) + v[1] * bfhi(gm[0]); o[2] = bflo(ya[1]) + v[2] * bflo(gm[1]); o[3] = bfhi(ya[1]) + v[3] * bfhi(gm[1]);
            o[4] = bflo(ya[2]) + v[4] * bflo(gm[2]); o[5] = bfhi(ya[2]) + v[5] * bfhi(gm[2]); o[6] = bflo(ya[3]) + v[6] * bflo(gm[3]); o[7] = bfhi(ya[3]) + v[7] * bfhi(gm[3]);
            *(u32x4*)mp = pack8(o); });
        __syncthreads();
    }
}

DI void p6_tile(const Params& p, int t, unsigned char* smem_all) {
    const int tid = threadIdx.x, team = TEAM();
    const int nt = t >> 6, mt = t & 63;
    const u16* Mg = p.Qr; u16* Y2 = p.VrT;
    f32x4 acc[8][4]; zero_acc8(acc);
    gemm256_main(Mg + (size_t)(mt * 256 + (tid >> 3)) * 1024 + (tid & 7) * 8, (size_t)64 * 1024,
                 p.WoutT + (size_t)(nt * 256 + (tid >> 3)) * 1024 + (tid & 7) * 8, (size_t)64 * 1024, 16, (u16*)smem_all, acc);
    const float* cst = (const float*)(smem_all + team * 69632);
#pragma unroll
    for (int pass = 0; pass < 2; ++pass) {
        stage_acc8(smem_all, pass, acc);
        __syncthreads();
        const int tok0 = mt * 256 + pass * 128, nt128 = nt * 2 + team;
        emit_rows(cst, [&](int row, int c8, const float* v) {
            *(u32x4*)(Y2 + (size_t)(tok0 + row) * 1024 + nt128 * 128 + c8 * 8) = pack8(v);
            float ss = 0.f;
#pragma unroll
            for (int k = 0; k < 8; ++k) ss += v[k] * v[k];
            ss += __shfl_xor(ss, 1); ss += __shfl_xor(ss, 2); ss += __shfl_xor(ss, 4); ss += __shfl_xor(ss, 8);
            if (c8 == 0) p.rowss[(size_t)(tok0 + row) * 8 + nt128] = ss; });
        __syncthreads();
    }
}

DI void p7_all(const Params& p) {
    const u16* Y2 = p.VrT;
    const size_t n4 = (size_t)S_ * 256;
    for (size_t i = (size_t)blockIdx.x * 512 + threadIdx.x; i < n4; i += (size_t)gridDim.x * 512) {
        const size_t row = i >> 8; const int c4 = (int)(i & 255);
        const float4 a = *(const float4*)(p.rowss + row * 8), b = *(const float4*)(p.rowss + row * 8 + 4);
        const float ss = ((a.x + a.y) + (a.z + a.w)) + ((b.x + b.y) + (b.z + b.w));
        const float rs = rsqrtf(ss * (1.f / 1024.f) + 1e-6f);
        const float4 xv = *(const float4*)(p.x + i * 4);
        const float4 gv = *(const float4*)(p.norm_post + c4 * 4);
        const u32x2 y = *(const u32x2*)(Y2 + i * 4);
        float4 o;
        o.x = xv.x + bflo(y[0]) * rs * gv.x; o.y = xv.y + bfhi(y[0]) * rs * gv.y;
        o.z = xv.z + bflo(y[1]) * rs * gv.z; o.w = xv.w + bfhi(y[1]) * rs * gv.w;
        *(float4*)(p.out + i * 4) = o;
    }
}

#ifndef MK_PROBE
#define MK_PROBE 0
#endif
constexpr size_t al256(size_t x) { return (x + 255) & ~(size_t)255; }
constexpr size_t O_BAR   = 0;
constexpr size_t O_WINT  = O_BAR   + 16384;
constexpr size_t O_WNOT  = O_WINT  + al256((size_t)NPAD_ * 1024 * 2);
constexpr size_t O_WROT  = O_WNOT  + (size_t)1024 * 512 * 2;
constexpr size_t O_WOUTT = O_WROT  + (size_t)1024 * 1024 * 2;
constexpr size_t O_W1T0  = O_WOUTT + (size_t)1024 * 1024 * 2;
constexpr size_t O_W1T1  = O_W1T0  + (size_t)256 * 2048 * 2;
constexpr size_t O_W2T0  = O_W1T1  + (size_t)256 * 2048 * 2;
constexpr size_t O_W2T1  = O_W2T0  + (size_t)64 * 256 * 2;
constexpr size_t O_BPART = O_W2T1  + (size_t)64 * 256 * 2;
constexpr size_t O_ROPEN = O_BPART + (size_t)2 * 16 * 256 * 4;
constexpr size_t O_ROPER = O_ROPEN + (size_t)S_ * 8 * 8;
constexpr size_t O_H     = O_ROPER + (size_t)S_ * 64 * 8;
constexpr size_t O_QN    = O_H     + (size_t)S_ * 1024 * 2;
constexpr size_t O_RAW0  = O_QN    + (size_t)S_ * 512 * 2;
constexpr size_t O_RAW1  = O_RAW0  + (size_t)S_ * 128 * 2;
constexpr size_t O_KS    = O_RAW1  + (size_t)S_ * 128 * 2;
constexpr size_t O_VST   = O_KS    + (size_t)2 * S_ * 64 * 2;
constexpr size_t O_KW    = O_VST   + (size_t)2 * S_ * 64 * 2;
constexpr size_t O_VWT   = O_KW    + (size_t)2 * S_ * 64 * 2;
constexpr size_t O_SZN   = O_VWT   + (size_t)2 * S_ * 64 * 2;
constexpr size_t O_QR    = O_SZN   + (size_t)S_ * 512 * 2;
constexpr size_t O_KR    = O_QR    + (size_t)4 * S_ * 128 * 2;
constexpr size_t O_KRT   = O_KR    + (size_t)4 * S_ * 128 * 2;
constexpr size_t O_VRT   = O_KRT   + (size_t)4 * S_ * 128 * 2;
constexpr size_t O_SZR   = O_VRT   + (size_t)4 * S_ * 256 * 2;
constexpr size_t O_GN    = O_SZR   + (size_t)S_ * 1024 * 2;
constexpr size_t O_SLAB  = O_GN    + (size_t)S_ * 24 * 4;
constexpr size_t O_KC    = O_SLAB  + (size_t)4 * 2 * 2048 * 256 * 4;
constexpr size_t O_VCT   = O_KC    + (size_t)2 * 1024 * 64 * 2;
constexpr size_t O_ROWSS = O_VCT   + (size_t)2 * 1024 * 64 * 2;
constexpr size_t WS_BYTES = O_ROWSS + (size_t)S_ * 8 * 4;

struct KArgs {
    const float *x, *norm_pre, *w_in, *b_gate, *pe_k, *w1_k, *w2_k, *pe_v, *w1_v, *w2_v, *w_nsa_o, *w_ret_o, *w_out, *norm_post;
    float* out; char* ws; int use_cg; int probe;
};

__global__ void __launch_bounds__(512, 2) fwd_megakernel(KArgs ka) {
    Params p;
    p.x = ka.x; p.norm_pre = ka.norm_pre; p.w_in = ka.w_in; p.b_gate = ka.b_gate; p.pe_k = ka.pe_k; p.w1_k = ka.w1_k; p.w2_k = ka.w2_k;
    p.pe_v = ka.pe_v; p.w1_v = ka.w1_v; p.w2_v = ka.w2_v; p.w_nsa_o = ka.w_nsa_o; p.w_ret_o = ka.w_ret_o; p.w_out = ka.w_out; p.norm_post = ka.norm_post;
    p.out = ka.out; p.use_cg = ka.use_cg; p.probe = ka.probe;
    {
        char* ws = ka.ws;
        p.bar = (unsigned*)(ws + O_BAR);
        p.WinT = (u16*)(ws + O_WINT); p.WnoT = (u16*)(ws + O_WNOT); p.WroT = (u16*)(ws + O_WROT); p.WoutT = (u16*)(ws + O_WOUTT);
        p.W1T[0] = (u16*)(ws + O_W1T0); p.W1T[1] = (u16*)(ws + O_W1T1); p.W2T[0] = (u16*)(ws + O_W2T0); p.W2T[1] = (u16*)(ws + O_W2T1);
        p.bpart = (float*)(ws + O_BPART); p.ropeN = (float2*)(ws + O_ROPEN); p.ropeR = (float2*)(ws + O_ROPER);
        p.H = (u16*)(ws + O_H); p.Qn = (u16*)(ws + O_QN); p.Raw[0] = (u16*)(ws + O_RAW0); p.Raw[1] = (u16*)(ws + O_RAW1);
        p.Ks = (u16*)(ws + O_KS); p.VsT = (u16*)(ws + O_VST); p.Kw = (u16*)(ws + O_KW); p.VwT = (u16*)(ws + O_VWT);
        p.SZn = (u16*)(ws + O_SZN); p.Qr = (u16*)(ws + O_QR); p.Kr = (u16*)(ws + O_KR); p.KrT = (u16*)(ws + O_KRT); p.VrT = (u16*)(ws + O_VRT);
        p.SZr = (u16*)(ws + O_SZR); p.Gn = (float*)(ws + O_GN); p.slab = (float*)(ws + O_SLAB); p.Kc = (u16*)(ws + O_KC); p.VcT = (u16*)(ws + O_VCT);
        p.rowss = (float*)(ws + O_ROWSS);
        p.Ma = (u16*)ka.out; p.Mb = (u16*)ka.out + (size_t)S_ * 1024;
    }
    __shared__ __attribute__((aligned(16))) unsigned char smem_all[2 * 69632];
    __shared__ int xch[2];
    const int team = TEAM();
    unsigned char* smem = smem_all + team * 69632;
    __shared__ uint4 xb_words;
    if (threadIdx.x == 0) xb_words = make_uint4(0u, 0u, 0u, 0u);
    __syncthreads();
    XcdBarrier b = xcd_barrier_post(p.bar, (volatile LAS unsigned*)&xb_words);
    const int G = gridDim.x, B = blockIdx.x;
    __shared__ unsigned long long ts[12]; int tsn = 1;
    if (MK_TS >= 0 && threadIdx.x == 0) ts[0] = __builtin_amdgcn_s_memrealtime();
    if (MK_TS == 201 && threadIdx.x == 0) atomicMax((unsigned long long*)(p.bar + 66), ~(unsigned long long)__builtin_amdgcn_s_memrealtime());
#define GRID_SYNC() do { if (p.use_cg) cg::this_grid().sync(); else { xcd_barrier(b); if (MK_PROBE & 32768) xcd_barrier(b); } if (MK_TS >= 0 && threadIdx.x == 0) ts[tsn++] = __builtin_amdgcn_s_memrealtime(); } while (0)

    for (int u = 2 * B + team; u < P0_UNITS; u += 2 * G) { if (u >= 896 && u < 1536) continue; p0_unit(p, u, smem); }
    GRID_SYNC();
    for (int t = B; t < 28 * 64; t += G) p1_tile256(p, t, smem_all);
    GRID_SYNC();
    if (G == 256) {
        const int T = 2 * B + team;
        if (T < 256) { p2_unit(p, T, smem); p2_unit(p, 256 + 768 + T, smem); }
        else { for (int k = 0; k < 3; ++k) p2_unit(p, 256 + 3 * (T - 256) + k, smem); }
    } else {
        for (int u = 2 * B + team; u < P2_UNITS; u += 2 * G) p2_unit(p, u, smem);
    }
    for (int u = 896 + 2 * B + team; u < 1536; u += 2 * G) p0_unit(p, u, smem);
    GRID_SYNC();
    for (int u = 2 * B + team; u < P3_UNITS; u += 2 * G) p3_unit(p, u, smem);
    p3_scan(p, false);
    GRID_SYNC();
    for (int i = B; i < 512; i += G) {
        const int r = i / G, k = i - r * G;
        nsa_item(p, (r & 1) ? (k >> 1) : 255 - (k >> 1), k & 1, smem_all);
    }
    for (int u = 2 * B + team; u < 512; u += 2 * G) ret_item(p, u >> 2, u & 3, true);
    GRID_SYNC();
    for (int t = B; t < 256; t += G) p5_tile(p, t, smem_all);
    GRID_SYNC();
    for (int t = B; t < 256; t += G) p6_tile(p, t, smem_all);
    GRID_SYNC();
    p7_all(p);
    if (MK_TS >= 0) {
        GRID_SYNC();
        __syncthreads();
        if (B == 0) {
            const unsigned long long d = (MK_TS == 201) ? (ts[0] - ~__hip_atomic_load((unsigned long long*)(p.bar + 66), __ATOMIC_RELAXED, __HIP_MEMORY_SCOPE_AGENT)) / 4ull : (MK_TS == 200) ? (ts[8] - ts[0]) / 16ull : (MK_TS >= 100) ? 10000ull : (ts[(MK_TS + 1) % 12] - ts[MK_TS % 12]) / 4ull;
            const int K = (int)(d > 60000ull ? 60000ull : d);
            for (int i = threadIdx.x; i < K; i += 512) p.out[(size_t)i * 64 + 7] += 0.2f;
        }
    }
}

extern "C" void kernel_launch(void* const* d_in, const int* in_sizes, int n_in, void* d_out, int out_size,
                              void* d_ws, size_t ws_size, hipStream_t stream) {
    static int grid_blocks = 0;
    if (!grid_blocks) {
        int dev = 0, cus = 0, per_cu = 0;
        (void)hipGetDevice(&dev);
        (void)hipDeviceGetAttribute(&cus, hipDeviceAttributeMultiprocessorCount, dev);
        (void)hipOccupancyMaxActiveBlocksPerMultiprocessor(&per_cu, fwd_megakernel, 512, 0);
        if (per_cu > 1) per_cu = 1;
        if (per_cu < 1) per_cu = 1;
        grid_blocks = cus * per_cu;
    }
    KArgs ka{};
    ka.x = (const float*)d_in[0]; ka.norm_pre = (const float*)d_in[1]; ka.w_in = (const float*)d_in[2]; ka.b_gate = (const float*)d_in[3];
    ka.pe_k = (const float*)d_in[4]; ka.w1_k = (const float*)d_in[5]; ka.w2_k = (const float*)d_in[6];
    ka.pe_v = (const float*)d_in[7]; ka.w1_v = (const float*)d_in[8]; ka.w2_v = (const float*)d_in[9];
    ka.w_nsa_o = (const float*)d_in[10]; ka.w_ret_o = (const float*)d_in[11]; ka.w_out = (const float*)d_in[12]; ka.norm_post = (const float*)d_in[13];
    ka.out = (float*)d_out; ka.ws = (char*)d_ws; ka.use_cg = 0; ka.probe = MK_PROBE;
    if (WS_BYTES > ws_size) { fprintf(stderr, "workspace too small: need %zu have %zu\n", (size_t)WS_BYTES, ws_size); return; }
    (void)hipMemsetAsync(d_ws, 0, XCD_BAR_WORDS * 4, stream);
    void* args[] = {&ka};
    hipError_t e = hipLaunchCooperativeKernel((void*)fwd_megakernel, dim3(grid_blocks), dim3(512), args, 0, stream);
    if (e != hipSuccess) fprintf(stderr, "cooperative launch failed: %s (grid %d)\n", hipGetErrorString(e), grid_blocks);
}
```
